# Optimizing an MI355X kernel written in HIP

```python
import jax
import jax.numpy as jnp
from jax import lax

D_MODEL = 2048
BATCH = 2
SEQ = 4096
DEPTH = 4

CHUNK = 64
Q_BLOCK = 128
EPS = 1e-6

DN_QK_HEADS = 16
DN_V_HEADS = 32
DN_HEAD_DIM = 128
DN_QK_DIM = DN_QK_HEADS * DN_HEAD_DIM
DN_V_DIM = DN_V_HEADS * DN_HEAD_DIM
DN_CONV_DIM = 2 * DN_QK_DIM + DN_V_DIM
CONV_K = 4

FOX_HEADS = 16
FOX_HEAD_DIM = 128
FOX_DIM = FOX_HEADS * FOX_HEAD_DIM

N_BRANCH = 2
FFN_HIDDEN = -(-8 * D_MODEL // (3 * 256)) * 256

IN_SIZES = (DN_CONV_DIM, DN_V_DIM, DN_V_HEADS, DN_V_HEADS, 3 * FOX_DIM, FOX_HEADS, N_BRANCH * D_MODEL)
N_IN = sum(IN_SIZES)
IN_OFFSETS = tuple(sum(IN_SIZES[:i + 1]) for i in range(len(IN_SIZES) - 1))

kernel_name = 'hybrid_deltanet_fox_adaln_block'


def rmsnorm(x, gain):
    xf = x.astype(jnp.float32)
    y = xf * lax.rsqrt(jnp.mean(xf * xf, axis=-1, keepdims=True) + EPS)
    return (y * gain.astype(jnp.float32)).astype(x.dtype)


def l2norm(x):
    return x * lax.rsqrt(jnp.sum(x * x, axis=-1, keepdims=True) + EPS)


def causal_short_conv(u, w):
    t = u.shape[1]
    up = jnp.pad(u, ((0, 0), (CONV_K - 1, 0), (0, 0)))
    out = up[:, 0:t, :] * w[:, 0]
    for j in range(1, CONV_K):
        out = out + up[:, j:j + t, :] * w[:, j]
    return out


def chunk_gated_delta_rule(q, k, v, g, beta):
    b, t, h, dk = q.shape
    dv = v.shape[-1]
    n = t // CHUNK
    f32 = jnp.float32
    q = l2norm(q.astype(f32)) * dk ** -0.5
    k = l2norm(k.astype(f32))
    v = v.astype(f32)

    def blocks(a):
        return a.reshape(b, n, CHUNK, h, -1).transpose(0, 3, 1, 2, 4)

    q, k, v = blocks(q), blocks(k), blocks(v)
    beta = beta.astype(f32).reshape(b, n, CHUNK, h).transpose(0, 3, 1, 2)
    gc = jnp.cumsum(g.astype(f32).reshape(b, n, CHUNK, h).transpose(0, 3, 1, 2), axis=-1)
    causal = jnp.tril(jnp.ones((CHUNK, CHUNK), dtype=bool))
    strict = jnp.tril(jnp.ones((CHUNK, CHUNK), dtype=bool), -1)
    decay = jnp.exp(jnp.where(causal, gc[..., :, None] - gc[..., None, :], -jnp.inf))
    k_beta = k * beta[..., None]
    v_beta = v * beta[..., None]
    lower = jnp.where(strict, jnp.einsum('bhncd,bhnsd->bhncs', k_beta, k) * decay, 0.0)
    a_mat = lower + jnp.eye(CHUNK, dtype=f32)
    u = lax.linalg.triangular_solve(a_mat, v_beta, left_side=True, lower=True, unit_diagonal=True)
    w = lax.linalg.triangular_solve(a_mat, k_beta * jnp.exp(gc)[..., None], left_side=True, lower=True,
                                    unit_diagonal=True)
    attn = jnp.einsum('bhncd,bhnsd->bhncs', q, k) * decay

    def step(state, xs):
        q_i, k_i, u_i, w_i, attn_i, gc_i = xs
        v_new = u_i - jnp.einsum('bhcd,bhde->bhce', w_i, state)
        o = (jnp.einsum('bhcd,bhde->bhce', q_i * jnp.exp(gc_i)[..., None], state)
             + jnp.einsum('bhcs,bhse->bhce', attn_i, v_new))
        g_last = gc_i[..., -1]
        state = (state * jnp.exp(g_last)[..., None, None]
                 + jnp.einsum('bhcd,bhce->bhde', k_i * jnp.exp(g_last[..., None] - gc_i)[..., None], v_new))
        return state, o

    xs = tuple(jnp.moveaxis(a, 2, 0) for a in (q, k, u, w, attn, gc))
    _, o = lax.scan(step, jnp.zeros((b, h, dk, dv), f32), xs)
    return o.transpose(1, 0, 3, 2, 4).reshape(b, t, h, dv)


def forgetting_attention(q, k, v, log_f):
    b, t, h, d = q.shape
    f32 = jnp.float32
    q, k, v = q.astype(f32), k.astype(f32), v.astype(f32)
    cum_f = jnp.cumsum(log_f.astype(f32), axis=1)
    nb = t // Q_BLOCK
    qb = q.reshape(b, nb, Q_BLOCK, h, d).transpose(1, 0, 3, 2, 4)
    fq = cum_f.reshape(b, nb, Q_BLOCK, h).transpose(1, 0, 3, 2)
    fk = cum_f.transpose(0, 2, 1)
    pos_k = jnp.arange(t)
    scale = d ** -0.5

    def block(args):
        i, q_i, f_i = args
        s = jnp.einsum('bhqd,bkhd->bhqk', q_i, k) * scale + f_i[..., None] - fk[:, :, None, :]
        pos_q = i * Q_BLOCK + jnp.arange(Q_BLOCK)
        s = jnp.where(pos_k[None, :] <= pos_q[:, None], s, -jnp.inf)
        p = jax.nn.softmax(s, axis=-1)
        return jnp.einsum('bhqk,bkhd->bqhd', p, v)

    o = lax.map(block, (jnp.arange(nb), qb, fq))
    return o.transpose(1, 0, 2, 3, 4).reshape(b, t, h, d)


def hybrid_mixer(h, w_in, conv_w, a_log, dt_bias, norm_w, f_bias, w_br_dn, w_br_fox, w_out):
    b, t, _ = h.shape
    f32 = jnp.float32
    proj = h @ w_in
    dn_qkv, dn_z, dn_b, dn_a, fox_qkv, fox_f, merge = jnp.split(proj, IN_OFFSETS, axis=-1)

    dn_qkv = jax.nn.silu(causal_short_conv(dn_qkv, conv_w))
    q, k, v = jnp.split(dn_qkv, (DN_QK_DIM, 2 * DN_QK_DIM), axis=-1)
    rep = DN_V_HEADS // DN_QK_HEADS
    q = jnp.repeat(q.reshape(b, t, DN_QK_HEADS, DN_HEAD_DIM), rep, axis=2)
    k = jnp.repeat(k.reshape(b, t, DN_QK_HEADS, DN_HEAD_DIM), rep, axis=2)
    v = v.reshape(b, t, DN_V_HEADS, DN_HEAD_DIM)
    beta = jax.nn.sigmoid(dn_b.astype(f32))
    g = -jnp.exp(a_log.astype(f32)) * jax.nn.softplus(dn_a.astype(f32) + dt_bias.astype(f32))
    o_dn = chunk_gated_delta_rule(q, k, v, g, beta)
    z = dn_z.reshape(b, t, DN_V_HEADS, DN_HEAD_DIM).astype(f32)
    o_dn = rmsnorm(o_dn, norm_w) * jax.nn.silu(z)
    y_dn = o_dn.reshape(b, t, DN_V_DIM).astype(h.dtype) @ w_br_dn

    fq, fk, fv = jnp.split(fox_qkv, 3, axis=-1)
    shp = (b, t, FOX_HEADS, FOX_HEAD_DIM)
    log_f = jax.nn.log_sigmoid(fox_f.astype(f32) + f_bias.astype(f32))
    o_fox = forgetting_attention(fq.reshape(shp), fk.reshape(shp), fv.reshape(shp), log_f)
    y_fox = o_fox.reshape(b, t, FOX_DIM).astype(h.dtype) @ w_br_fox

    gate_dn, gate_fox = jnp.split(jax.nn.sigmoid(merge), N_BRANCH, axis=-1)
    return (gate_dn * y_dn + gate_fox * y_fox) @ w_out


def swiglu(h, w_gate, w_up, w_down):
    return (jax.nn.silu(h @ w_gate) * (h @ w_up)) @ w_down


def setup_inputs(seed: int = 0) -> dict:
    key = jax.random.key(seed)
    ks = jax.random.split(key, 20)
    L, D, F = DEPTH, D_MODEL, FFN_HIDDEN
    f32 = jnp.float32

    def nrm(k, shape, fan_in):
        return jax.random.normal(k, shape, f32) * fan_in ** -0.5

    x = jax.random.normal(ks[0], (BATCH, SEQ, D), f32)
    c = jax.random.normal(ks[1], (BATCH, D), f32)
    w_ada = nrm(ks[2], (L, D, 6 * D), D)
    b_ada = 0.02 * jax.random.normal(ks[3], (L, 6 * D), f32)
    norm_gains = 1.0 + 0.05 * jax.random.normal(ks[4], (L, 4, D), f32)
    w_in = nrm(ks[5], (L, D, N_IN), D)
    dn_conv = nrm(ks[6], (L, DN_CONV_DIM, CONV_K), CONV_K)
    dn_a_log = jnp.log(jax.random.uniform(ks[7], (L, DN_V_HEADS), f32, 1.0, 16.0))
    dt = jnp.exp(jax.random.uniform(ks[8], (L, DN_V_HEADS), f32, jnp.log(1e-3), jnp.log(1e-1)))
    dn_dt_bias = dt + jnp.log(-jnp.expm1(-dt))
    dn_norm_w = 1.0 + 0.05 * jax.random.normal(ks[9], (L, DN_HEAD_DIM), f32)
    fox_f_bias = jax.random.uniform(ks[10], (L, FOX_HEADS), f32, 1.0, 4.0)
    w_branch_dn = nrm(ks[11], (L, DN_V_DIM, D), DN_V_DIM)
    w_branch_fox = nrm(ks[12], (L, FOX_DIM, D), FOX_DIM)
    w_out = nrm(ks[13], (L, D, D), D)
    w_gate = nrm(ks[14], (L, D, F), D)
    w_up = nrm(ks[15], (L, D, F), D)
    w_down = nrm(ks[16], (L, F, D), F)
    return {'x': x, 'c': c, 'w_ada': w_ada, 'b_ada': b_ada, 'norm_gains': norm_gains, 'w_in': w_in,
            'dn_conv': dn_conv, 'dn_a_log': dn_a_log, 'dn_dt_bias': dn_dt_bias, 'dn_norm_w': dn_norm_w,
            'fox_f_bias': fox_f_bias, 'w_branch_dn': w_branch_dn, 'w_branch_fox': w_branch_fox,
            'w_out': w_out, 'w_gate': w_gate, 'w_up': w_up, 'w_down': w_down}


def reference(x, c, w_ada, b_ada, norm_gains, w_in, dn_conv, dn_a_log, dn_dt_bias, dn_norm_w,
              fox_f_bias, w_branch_dn, w_branch_fox, w_out, w_gate, w_up, w_down):
    cond = jax.nn.silu(c)
    for l in range(DEPTH):
        mod = (cond @ w_ada[l] + b_ada[l])[:, None, :]
        shift_m, scale_m, gate_m, shift_f, scale_f, gate_f = jnp.split(mod, 6, axis=-1)
        h = rmsnorm(x, norm_gains[l, 0]) * (1.0 + scale_m) + shift_m
        y = hybrid_mixer(h, w_in[l], dn_conv[l], dn_a_log[l], dn_dt_bias[l], dn_norm_w[l],
                         fox_f_bias[l], w_branch_dn[l], w_branch_fox[l], w_out[l])
        x = x + gate_m * rmsnorm(y, norm_gains[l, 1])
        h = rmsnorm(x, norm_gains[l, 2]) * (1.0 + scale_f) + shift_f
        y = swiglu(h, w_gate[l], w_up[l], w_down[l])
        x = x + gate_f * rmsnorm(y, norm_gains[l, 3])
    return x
```

```cpp
#include <hip/hip_runtime.h>
#include <cstdio>
#include <cstdint>

constexpr int D = 2048, NB = 2, T = 4096, M = NB * T, DEPTH = 4;
constexpr int HD = 128, DN_VH = 32, DN_CONV = 8192;
constexpr int FOXH = 16;
constexpr int FF = 5632;
constexpr int NIN = 22608;
constexpr int SRC_B = 12288, SRC_A = 12320, SRC_FQKV = 12352, SRC_F = 18496, SRC_MERGE = 18512;
constexpr int NBIG = 22528;
constexpr int NSM = 80;
constexpr float EPS = 1e-6f;

typedef unsigned short bf16;
typedef float f32x4 __attribute__((ext_vector_type(4)));
typedef unsigned u32x4 __attribute__((ext_vector_type(4)));
typedef unsigned u32x2 __attribute__((ext_vector_type(2)));
#define LAS __attribute__((address_space(3)))

__device__ __forceinline__ float bf_lo(unsigned w) { return __uint_as_float(w << 16); }
__device__ __forceinline__ float bf_hi(unsigned w) { return __uint_as_float(w & 0xffff0000u); }
__device__ __forceinline__ float bf2f(bf16 h) { return __uint_as_float(((unsigned)h) << 16); }
__device__ __forceinline__ unsigned f2bf(float f) { unsigned u = __float_as_uint(f); return (u + 0x7fffu + ((u >> 16) & 1u)) >> 16; }
__device__ __forceinline__ unsigned pk2(float lo, float hi) { return f2bf(lo) | (f2bf(hi) << 16); }
__device__ __forceinline__ float fsigmoid(float x) { return __builtin_amdgcn_rcpf(1.0f + __expf(-x)); }
__device__ __forceinline__ float fsilu(float x) { return x * fsigmoid(x); }
__device__ __forceinline__ float wave_sum(float v) {
#pragma unroll
    for (int o = 1; o < 64; o <<= 1) v += __shfl_xor(v, o);
    return v;
}
namespace pg8 {
#define PG8_LAS __attribute__((address_space(3)))
typedef unsigned short bf16_t;
typedef short bf16x8 __attribute__((ext_vector_type(8)));
typedef float f32x4 __attribute__((ext_vector_type(4)));
typedef unsigned u32x4 __attribute__((ext_vector_type(4)));
constexpr int BM = 256, BK = 64, HALF = 128, HTB = HALF * BK * 2  , STAGE_BYTES = 8 * HTB, NXCD = 8, WGM = 8;

__host__ __device__ __forceinline__ int lds_byte(int r, int c) { const int st = (r >> 4) * 2 + (c >> 5), rr = r & 15, cc = c & 31, ob = rr * 64 + cc * 2; return st * 1024 + (ob ^ (((ob >> 9) & 1) << 5)); }
__host__ __device__ __forceinline__ void stage_rc(int b, int& R, int& C) { const int st = b / 1024, sb = b % 1024, swz = sb ^ (((sb >> 9) & 1) << 5); R = (st >> 1) * 16 + swz / 64; C = (st & 1) * 32 + (swz % 64) / 2; }
__host__ __device__ __forceinline__ int perm32(int rho) { const int n = rho >> 4, i = rho & 15; return 8 * (i >> 2) + 4 * n + (i & 3); }

struct Unit { int pm, pn; };
struct Gemm { const bf16_t* A; const bf16_t* Bt; int M, N, K, pad; };

struct StaticOrder {
    int nM, nN, nwg, G, c;
    __host__ __device__ void init(int M, int N, int G_, int c_) { nM = M / BM; nN = N / BM; nwg = nM * nN; G = G_; c = c_; }
    __host__ __device__ bool next(int i, Unit& u) const {
        const long L = (long)i * G + c; if (L >= nwg) return false;
        int wgid = (int)L; { const int q = nwg / NXCD, r = nwg % NXCD, xcd = wgid % NXCD, off = wgid / NXCD; wgid = (xcd < r ? xcd * (q + 1) : r * (q + 1) + (xcd - r) * q) + off; }
        const int nig = WGM * nN, gid = wgid / nig, fm = gid * WGM, gsz = (nM - fm) < WGM ? (nM - fm) : WGM;
        u.pm = fm + ((wgid % nig) % gsz); u.pn = (wgid % nig) / gsz; return true;
    }
    __device__ __forceinline__ void a_ready(const Unit&) const {}
    __device__ __forceinline__ void done(const Unit&) const {}
};

__device__ __forceinline__ unsigned cvt_pk_bf16(float lo, float hi) { unsigned r; asm volatile("v_cvt_pk_bf16_f32 %0, %1, %2" : "=v"(r) : "v"(lo), "v"(hi)); return r; }
__device__ __forceinline__ float e_sigmoid(float x) { return __builtin_amdgcn_rcpf(1.0f + __expf(-x)); }

struct EpiF32 {
    static constexpr bool PERM = false, AFTER_DRAIN = false;
    float* C; int ldc, pad;
    __device__ __forceinline__ void operator()(const f32x4 (&acc)[2][2][4][2], const Unit& u, int wr, int wc, int fr, int fq) const {
        const int row0 = u.pm * BM + wr * 64 + fr, col0 = u.pn * BM + wc * 32 + 4 * fq;
#pragma unroll
        for (int ai = 0; ai < 2; ++ai)
#pragma unroll
            for (int m = 0; m < 4; ++m) { float* rowp = C + (size_t)(row0 + ai * HALF + m * 16) * ldc + col0;
#pragma unroll
                for (int bj = 0; bj < 2; ++bj)
#pragma unroll
                    for (int n = 0; n < 2; ++n) *(f32x4*)(rowp + bj * HALF + n * 16) = acc[ai][bj][m][n]; }
    }
};
struct EpiInProj {
    static constexpr bool PERM = true, AFTER_DRAIN = false;
    bf16_t *dnraw, *z, *fqkv, *mg;
    __device__ __forceinline__ void operator()(const f32x4 (&acc)[2][2][4][2], const Unit& u, int wr, int wc, int fr, int fq) const {
        const int pn = u.pn; bf16_t* base; int ldc, colt, act;
        if (pn < 32) { base = dnraw; ldc = 8192; colt = pn * BM; act = 0; }
        else if (pn < 48) { base = z; ldc = 4096; colt = (pn - 32) * BM; act = 1; }
        else if (pn < 72) { base = fqkv; ldc = 6144; colt = (pn - 48) * BM; act = 0; }
        else { base = mg; ldc = 4096; colt = (pn - 72) * BM; act = 2; }
        const int row0 = u.pm * BM + wr * 64 + fr, col0 = colt + wc * 32 + 8 * fq;
#pragma unroll
        for (int ai = 0; ai < 2; ++ai)
#pragma unroll
            for (int m = 0; m < 4; ++m) { bf16_t* rowp = base + (size_t)(row0 + ai * HALF + m * 16) * ldc + col0;
#pragma unroll
                for (int bj = 0; bj < 2; ++bj) { f32x4 v0 = acc[ai][bj][m][0], v1 = acc[ai][bj][m][1];
                    if (act == 1) {
#pragma unroll
                        for (int j = 0; j < 4; ++j) { v0[j] = v0[j] * e_sigmoid(v0[j]); v1[j] = v1[j] * e_sigmoid(v1[j]); } }
                    if (act == 2) {
#pragma unroll
                        for (int j = 0; j < 4; ++j) { v0[j] = e_sigmoid(v0[j]); v1[j] = e_sigmoid(v1[j]); } }
                    u32x4 w; w.x = cvt_pk_bf16(v0[0], v0[1]); w.y = cvt_pk_bf16(v0[2], v0[3]); w.z = cvt_pk_bf16(v1[0], v1[1]); w.w = cvt_pk_bf16(v1[2], v1[3]);
                    *(u32x4*)(rowp + bj * HALF) = w; } }
    }
};
struct EpiMerge {
    static constexpr bool PERM = true, AFTER_DRAIN = false;
    const float* ydn; const bf16_t* mg; bf16_t* mm;
    __device__ __forceinline__ void operator()(const f32x4 (&acc)[2][2][4][2], const Unit& u, int wr, int wc, int fr, int fq) const {
        const int row0 = u.pm * BM + wr * 64 + fr, col0 = u.pn * BM + wc * 32 + 8 * fq;
#pragma unroll
        for (int ai = 0; ai < 2; ++ai)
#pragma unroll
            for (int m = 0; m < 4; ++m) { const size_t row = (size_t)(row0 + ai * HALF + m * 16);
#pragma unroll
                for (int bj = 0; bj < 2; ++bj) { const int col = col0 + bj * HALF;
                    const f32x4 y0 = *(const f32x4*)(ydn + row * 2048 + col), y1 = *(const f32x4*)(ydn + row * 2048 + col + 4);
                    const u32x4 gd = *(const u32x4*)(mg + row * 4096 + col), gf = *(const u32x4*)(mg + row * 4096 + 2048 + col);
                    const f32x4 a0 = acc[ai][bj][m][0], a1 = acc[ai][bj][m][1];
                    float o[8];
                    o[0] = __uint_as_float(gd.x << 16) * y0[0] + __uint_as_float(gf.x << 16) * a0[0];
                    o[1] = __uint_as_float(gd.x & 0xffff0000u) * y0[1] + __uint_as_float(gf.x & 0xffff0000u) * a0[1];
                    o[2] = __uint_as_float(gd.y << 16) * y0[2] + __uint_as_float(gf.y << 16) * a0[2];
                    o[3] = __uint_as_float(gd.y & 0xffff0000u) * y0[3] + __uint_as_float(gf.y & 0xffff0000u) * a0[3];
                    o[4] = __uint_as_float(gd.z << 16) * y1[0] + __uint_as_float(gf.z << 16) * a1[0];
                    o[5] = __uint_as_float(gd.z & 0xffff0000u) * y1[1] + __uint_as_float(gf.z & 0xffff0000u) * a1[1];
                    o[6] = __uint_as_float(gd.w << 16) * y1[2] + __uint_as_float(gf.w << 16) * a1[2];
                    o[7] = __uint_as_float(gd.w & 0xffff0000u) * y1[3] + __uint_as_float(gf.w & 0xffff0000u) * a1[3];
                    u32x4 w; w.x = cvt_pk_bf16(o[0], o[1]); w.y = cvt_pk_bf16(o[2], o[3]); w.z = cvt_pk_bf16(o[4], o[5]); w.w = cvt_pk_bf16(o[6], o[7]);
                    *(u32x4*)(mm + row * 2048 + col) = w; } }
    }
};
struct EpiSwiGLU {
    static constexpr bool PERM = true, AFTER_DRAIN = false;
    bf16_t* hid; int ldc, pad;
    __device__ __forceinline__ void operator()(const f32x4 (&acc)[2][2][4][2], const Unit& u, int wr, int wc, int fr, int fq) const {
        const int row0 = u.pm * BM + wr * 64 + fr, col0 = u.pn * HALF + wc * 32 + 8 * fq;
#pragma unroll
        for (int ai = 0; ai < 2; ++ai)
#pragma unroll
            for (int m = 0; m < 4; ++m) { bf16_t* rowp = hid + (size_t)(row0 + ai * HALF + m * 16) * ldc + col0;
                const f32x4 g0 = acc[ai][0][m][0], g1 = acc[ai][0][m][1], u0 = acc[ai][1][m][0], u1 = acc[ai][1][m][1];
                float o[8];
#pragma unroll
                for (int j = 0; j < 4; ++j) { o[j] = g0[j] * e_sigmoid(g0[j]) * u0[j]; o[4 + j] = g1[j] * e_sigmoid(g1[j]) * u1[j]; }
                u32x4 w; w.x = cvt_pk_bf16(o[0], o[1]); w.y = cvt_pk_bf16(o[2], o[3]); w.z = cvt_pk_bf16(o[4], o[5]); w.w = cvt_pk_bf16(o[6], o[7]);
                *(u32x4*)rowp = w; }
    }
};

template <class Epi, class Sched, bool ALIGN_EPI = false, bool SP2 = false>
__device__ __forceinline__ void gemm_phase(PG8_LAS unsigned char* lds, const Gemm g, const Sched& S, const Epi& E) {
    const int tid = threadIdx.x, wid = __builtin_amdgcn_readfirstlane(tid >> 6), lane = tid & 63, wr = wid >> 2, wc = wid & 3, fr = lane & 15, fq = lane >> 4;
    const int K = g.K, nt = K / BK;
    unsigned voffA[2], voffB[2];
#pragma unroll
    for (int i = 0; i < 2; ++i) { int R, C; stage_rc(tid * 16 + i * 8192, R, C); const int Rb = Epi::PERM ? ((R & ~31) + perm32(R & 31)) : R;
        voffA[i] = (unsigned)(R * K + C) * 2u; voffB[i] = (unsigned)(Rb * K + C) * 2u; }
    const size_t kstep = (size_t)(BK * 2);
    const size_t hstep = (size_t)HALF * K * 2;
    const size_t tstep = 2 * hstep;
    const unsigned ldsw = (unsigned)wid * 1024u;
    const int aoff = lds_byte(wr * 64 + fr, fq * 8), boff = lds_byte(wc * 32 + fr, fq * 8);
#define PG8_SA(b, h) (((b) * 2 + (h)) * HTB)
#define PG8_SB(b, h) ((4 + (b) * 2 + (h)) * HTB)
#define PG8_STAGE(bufoff, gbase, voff) do { _Pragma("unroll") for (int _i = 0; _i < 2; ++_i) \
        __builtin_amdgcn_global_load_lds((const unsigned*)((const char*)(gbase) + (voff)[_i]), (PG8_LAS unsigned*)(lds + (bufoff) + ldsw + _i * 8192), 16, 0, 0); } while (0)
#define PG8_LDA(dst, b, h) do { _Pragma("unroll") for (int m = 0; m < 4; ++m) _Pragma("unroll") for (int k = 0; k < 2; ++k) dst[m][k] = *(const PG8_LAS bf16x8*)(lds + PG8_SA(b, h) + aoff + m * 2048 + k * 1024); } while (0)
#define PG8_LDB(dst, b, h) do { _Pragma("unroll") for (int n = 0; n < 2; ++n) _Pragma("unroll") for (int k = 0; k < 2; ++k) dst[n][k] = *(const PG8_LAS bf16x8*)(lds + PG8_SB(b, h) + boff + n * 2048 + k * 1024); } while (0)
#define PG8_MMA(ai, bj, At, Bt) do { __builtin_amdgcn_s_setprio(1); _Pragma("unroll") for (int m = 0; m < 4; ++m) _Pragma("unroll") for (int n = 0; n < 2; ++n) _Pragma("unroll") for (int k = 0; k < 2; ++k) \
        acc[ai][bj][m][n] = __builtin_amdgcn_mfma_f32_16x16x32_bf16(Bt[n][k], At[m][k], acc[ai][bj][m][n], 0, 0, 0); __builtin_amdgcn_s_setprio(0); } while (0)
#define PG8_WAIT_V(n) asm volatile("s_waitcnt vmcnt(" #n ")" ::: "memory")
#define PG8_WAIT_L(n) asm volatile("s_waitcnt lgkmcnt(" #n ")" ::: "memory")
#define PG8_BAR __builtin_amdgcn_s_barrier()
#define PG8_SCHED __builtin_amdgcn_sched_barrier(0)
    Unit cur, nxt; int ui = 0;
    if (!S.next(0, cur)) return;
    f32x4 acc[2][2][4][2];
#pragma unroll
    for (int a = 0; a < 2; ++a)
#pragma unroll
        for (int b = 0; b < 2; ++b)
#pragma unroll
            for (int m = 0; m < 4; ++m)
#pragma unroll
                for (int n = 0; n < 2; ++n) acc[a][b][m][n] = (f32x4){0.f, 0.f, 0.f, 0.f};
    bf16x8 At[4][2], B0[2][2], B1[2][2];
    const char* cA = (const char*)g.A + (size_t)cur.pm * tstep; const char* cB = (const char*)g.Bt + (size_t)cur.pn * tstep;
    S.a_ready(cur);
    if constexpr (SP2) {
        PG8_STAGE(PG8_SB(0, 0), cB, voffB); PG8_STAGE(PG8_SB(0, 1), cB + hstep, voffB); PG8_STAGE(PG8_SA(0, 0), cA, voffA); PG8_STAGE(PG8_SA(0, 1), cA + hstep, voffA);
        if (wr == 1) PG8_BAR;
        PG8_WAIT_V(2); PG8_BAR;
        PG8_STAGE(PG8_SB(1, 0), cB + kstep, voffB); PG8_STAGE(PG8_SA(1, 0), cA + kstep, voffA); PG8_STAGE(PG8_SB(1, 1), cB + hstep + kstep, voffB);
        PG8_WAIT_V(6); PG8_BAR;
    } else {
        PG8_STAGE(PG8_SB(0, 0), cB, voffB); PG8_STAGE(PG8_SA(0, 0), cA, voffA); PG8_STAGE(PG8_SB(0, 1), cB + hstep, voffB); PG8_STAGE(PG8_SA(0, 1), cA + hstep, voffA);
        if (wr == 1) PG8_BAR;
        PG8_WAIT_V(4); PG8_BAR;
        PG8_STAGE(PG8_SB(1, 0), cB + kstep, voffB); PG8_STAGE(PG8_SA(1, 0), cA + kstep, voffA); PG8_STAGE(PG8_SB(1, 1), cB + hstep + kstep, voffB);
        PG8_WAIT_V(6); PG8_BAR;
    }
    for (;;) {
        const bool has_next = S.next(ui + 1, nxt);
        const char* nA = has_next ? (const char*)g.A + (size_t)nxt.pm * tstep : cA; const char* nB = has_next ? (const char*)g.Bt + (size_t)nxt.pn * tstep : cB;
        for (int t = 0; t < nt; t += 2) {
            const bool last = (t == nt - 2);
            const char* a1 = cA + (size_t)(t + 1) * kstep;
            const char* a2 = last ? nA : cA + (size_t)(t + 2) * kstep; const char* b2 = last ? nB : cB + (size_t)(t + 2) * kstep;
            const char* a3 = a2 + kstep; const char* b3 = b2 + kstep;
            if (last && has_next) S.a_ready(nxt);
            if constexpr (SP2) {
            PG8_LDB(B0, 0, 0); PG8_LDB(B1, 0, 1); PG8_SCHED; PG8_LDA(At, 0, 0); PG8_STAGE(PG8_SA(1, 1), a1 + hstep, voffA);
            PG8_WAIT_V(8); PG8_WAIT_L(0); PG8_BAR; PG8_MMA(0, 0, At, B0); PG8_MMA(0, 1, At, B1); PG8_BAR; PG8_SCHED;
            PG8_LDA(At, 0, 1); PG8_STAGE(PG8_SB(0, 0), b2, voffB); PG8_STAGE(PG8_SB(0, 1), b2 + hstep, voffB); PG8_STAGE(PG8_SA(0, 0), a2, voffA);
            PG8_WAIT_V(8); PG8_WAIT_L(0); PG8_BAR; PG8_MMA(1, 0, At, B0); PG8_MMA(1, 1, At, B1); PG8_BAR; PG8_SCHED;
            PG8_LDB(B0, 1, 0); PG8_LDB(B1, 1, 1); PG8_SCHED; PG8_LDA(At, 1, 0); PG8_STAGE(PG8_SA(0, 1), a2 + hstep, voffA);
            PG8_WAIT_V(8); PG8_WAIT_L(0); PG8_BAR; PG8_MMA(0, 0, At, B0); PG8_MMA(0, 1, At, B1); PG8_BAR; PG8_SCHED;
            PG8_LDA(At, 1, 1); PG8_STAGE(PG8_SB(1, 0), b3, voffB); PG8_STAGE(PG8_SB(1, 1), b3 + hstep, voffB); PG8_STAGE(PG8_SA(1, 0), a3, voffA);
            PG8_WAIT_V(8); PG8_WAIT_L(0); PG8_BAR; PG8_MMA(1, 0, At, B0); PG8_MMA(1, 1, At, B1); PG8_BAR; PG8_SCHED;
            } else {
            PG8_LDB(B0, 0, 0); PG8_SCHED; PG8_LDA(At, 0, 0); PG8_STAGE(PG8_SA(1, 1), a1 + hstep, voffA);
            PG8_WAIT_L(8); PG8_BAR; PG8_WAIT_L(0); PG8_MMA(0, 0, At, B0); PG8_BAR; PG8_SCHED;
            PG8_LDB(B1, 0, 1); PG8_STAGE(PG8_SB(0, 0), b2, voffB);
            PG8_BAR; PG8_WAIT_L(0); PG8_MMA(0, 1, At, B1); PG8_BAR;
            PG8_LDA(At, 0, 1); PG8_STAGE(PG8_SA(0, 0), a2, voffA);
            PG8_BAR; PG8_WAIT_L(0); PG8_MMA(1, 0, At, B0); PG8_BAR; PG8_SCHED;
            PG8_STAGE(PG8_SB(0, 1), b2 + hstep, voffB);
            PG8_WAIT_V(6); PG8_BAR; PG8_MMA(1, 1, At, B1); PG8_BAR;
            PG8_LDB(B0, 1, 0); PG8_SCHED; PG8_LDA(At, 1, 0); PG8_STAGE(PG8_SA(0, 1), a2 + hstep, voffA);
            PG8_WAIT_L(8); PG8_BAR; PG8_WAIT_L(0); PG8_MMA(0, 0, At, B0); PG8_BAR; PG8_SCHED;
            PG8_LDB(B1, 1, 1); PG8_STAGE(PG8_SB(1, 0), b3, voffB);
            PG8_BAR; PG8_WAIT_L(0); PG8_MMA(0, 1, At, B1); PG8_BAR;
            PG8_LDA(At, 1, 1); PG8_STAGE(PG8_SA(1, 0), a3, voffA);
            PG8_BAR; PG8_WAIT_L(0); PG8_MMA(1, 0, At, B0); PG8_BAR; PG8_SCHED;
            PG8_STAGE(PG8_SB(1, 1), b3 + hstep, voffB);
            PG8_WAIT_V(6); PG8_BAR; PG8_MMA(1, 1, At, B1); PG8_BAR;
            }
        }
        if constexpr (ALIGN_EPI) { if (wr == 0) PG8_BAR; }
        if constexpr (!Epi::AFTER_DRAIN) { E(acc, cur, wr, wc, fr, fq); S.done(cur); }
        if (!has_next) break;
#pragma unroll
        for (int a = 0; a < 2; ++a)
#pragma unroll
            for (int b = 0; b < 2; ++b)
#pragma unroll
                for (int m = 0; m < 4; ++m)
#pragma unroll
                    for (int n = 0; n < 2; ++n) acc[a][b][m][n] = (f32x4){0.f, 0.f, 0.f, 0.f};
        cur = nxt; cA = nA; cB = nB; ++ui;
        if constexpr (ALIGN_EPI) { if (wr == 1) PG8_BAR; }
    }
    PG8_WAIT_V(0);
    if constexpr (!ALIGN_EPI) { if (wr == 0) PG8_BAR; }
    PG8_BAR;
    if constexpr (Epi::AFTER_DRAIN) { E.fused(acc, cur, wr, wc, fr, fq, lds, wid, lane); S.done(cur); }
#undef PG8_SA
#undef PG8_SB
#undef PG8_STAGE
#undef PG8_LDA
#undef PG8_LDB
#undef PG8_MMA
#undef PG8_WAIT_V
#undef PG8_WAIT_L
#undef PG8_BAR
#undef PG8_SCHED
}
}

template <class Epi> __global__ __launch_bounds__(512, 2) void k_gemm(pg8::Gemm g, Epi E) {
    extern __shared__ __attribute__((aligned(16))) unsigned char shm[];
    pg8::StaticOrder S; S.init(g.M, g.N, (int)gridDim.x, (int)blockIdx.x);
    pg8::gemm_phase<Epi, pg8::StaticOrder, true, true>((LAS unsigned char*)shm, g, S, E);
}

__device__ __forceinline__ void transpose_item(const float* W, int ldw, int k0, int c0, bf16* WT, int K, int r0, LAS float* scr, int lane) {
#pragma unroll 8
    for (int i = 0; i < 32; ++i) { const int kk = 2 * i + (lane >> 5); scr[kk * 33 + (lane & 31)] = W[(size_t)(k0 + kk) * ldw + c0 + (lane & 31)]; }
    asm volatile("s_waitcnt lgkmcnt(0)" ::: "memory");
    const int c = lane & 7;
#pragma unroll
    for (int j = 0; j < 4; ++j) { const int n = (lane >> 3) + 8 * j; const LAS float* s = scr + (8 * c) * 33 + n;
        u32x4 o; o.x = pk2(s[0 * 33], s[1 * 33]); o.y = pk2(s[2 * 33], s[3 * 33]); o.z = pk2(s[4 * 33], s[5 * 33]); o.w = pk2(s[6 * 33], s[7 * 33]);
        *(u32x4*)(WT + (size_t)(r0 + n) * K + k0 + 8 * c) = o; }
    asm volatile("s_waitcnt lgkmcnt(0)" ::: "memory");
}
__device__ __forceinline__ void map_rows(int mode, int nb  , int& c0, int& r0) {
    const int n0 = nb * 32;
    if (mode == 0) { c0 = n0; r0 = n0; }
    else if (mode == 1) { r0 = n0; c0 = n0 < 12288 ? n0 : (n0 < 18432 ? SRC_FQKV + (n0 - 12288) : SRC_MERGE + (n0 - 18432)); }
    else { c0 = n0; r0 = (n0 >> 7) * 256 + (n0 & 127) + (mode == 3 ? 128 : 0); }
}
__global__ __launch_bounds__(256) void k_transpose(const float* W, int K, int ldw, int ncols  , bf16* WT, int mode) {
    __shared__ float scr_all[4][64 * 33];
    const int wave = threadIdx.x >> 6, lane = threadIdx.x & 63;
    LAS float* scr = (LAS float*)scr_all[wave];
    const int nblk = ncols / 32, nitems = (K / 64) * nblk;
    for (int it = blockIdx.x * 4 + wave; it < nitems; it += gridDim.x * 4) {
        const int kb = it / nblk, nb = it % nblk; int c0, r0; map_rows(mode, nb, c0, r0);
        transpose_item(W, ldw, kb * 64, c0, WT, K, r0, scr, lane);
    }
}
__global__ void k_wsmall(const float* w_in, float* wsm) {
    const int idx = blockIdx.x * blockDim.x + threadIdx.x;
    if (idx >= DEPTH * D * NSM) return;
    const int j = idx % NSM, k = (idx / NSM) % D, l = idx / (NSM * D);
    const int sc = j < 32 ? SRC_B + j : (j < 64 ? SRC_A + (j - 32) : SRC_F + (j - 64));
    wsm[((size_t)l * NSM + j) * D + k] = w_in[((size_t)l * D + k) * NIN + sc];
}
__global__ __launch_bounds__(256) void k_adaln(const float* c, const float* w_ada, const float* b_ada, float* mod) {
    __shared__ float cond[2][D]; __shared__ float red[4][2][64];
    const int l = blockIdx.y, n = blockIdx.x * 64 + (threadIdx.x & 63), ty = threadIdx.x >> 6;
    for (int i = threadIdx.x; i < 2 * D; i += 256) { const float v = c[i]; cond[i / D][i % D] = fsilu(v); }
    __syncthreads();
    const float* w = w_ada + (size_t)l * D * (6 * D) + n;
    float a0 = 0.f, a1 = 0.f;
#pragma unroll 8
    for (int k = ty * 512; k < ty * 512 + 512; ++k) { const float wv = w[(size_t)k * (6 * D)]; a0 += cond[0][k] * wv; a1 += cond[1][k] * wv; }
    red[ty][0][threadIdx.x & 63] = a0; red[ty][1][threadIdx.x & 63] = a1;
    __syncthreads();
    if (threadIdx.x < 128) { const int b = threadIdx.x >> 6, tx = threadIdx.x & 63, nn = blockIdx.x * 64 + tx;
        mod[((size_t)l * 2 + b) * (6 * D) + nn] = b_ada[(size_t)l * 6 * D + nn] + red[0][b][tx] + red[1][b][tx] + red[2][b][tx] + red[3][b][tx]; }
}

struct RowArgs { const float* xin; float* x; const float* Y; const float* gy; const float* gate; const float* gn; const float* scale; const float* shift; bf16* H; const float* wsm; float* baf; int has_y, has_h, has_small, pad; };
__global__ __launch_bounds__(256) void k_rowpass(RowArgs a) {
    const int lane = threadIdx.x & 63, m = blockIdx.x * 4 + (threadIdx.x >> 6), b = m / T;
    const size_t ro = (size_t)m * D; const int mo = b * 6 * D;
    f32x4 v[8];
#pragma unroll
    for (int i = 0; i < 8; ++i) v[i] = *(const f32x4*)(a.xin + ro + 4 * lane + 256 * i);
    if (a.has_y) {
        f32x4 y[8]; float ss = 0.f;
#pragma unroll
        for (int i = 0; i < 8; ++i) { y[i] = *(const f32x4*)(a.Y + ro + 4 * lane + 256 * i); ss += (y[i][0] * y[i][0] + y[i][1] * y[i][1]) + (y[i][2] * y[i][2] + y[i][3] * y[i][3]); }
        const float r = rsqrtf(wave_sum(ss) * (1.0f / D) + EPS);
#pragma unroll
        for (int i = 0; i < 8; ++i) { const int c = 4 * lane + 256 * i; const f32x4 g = *(const f32x4*)(a.gy + c), gt = *(const f32x4*)(a.gate + mo + c);
            v[i] = v[i] + gt * (y[i] * r * g); }
    }
#pragma unroll
    for (int i = 0; i < 8; ++i) *(f32x4*)(a.x + ro + 4 * lane + 256 * i) = v[i];
    if (!a.has_h) return;
    float ss = 0.f;
#pragma unroll
    for (int i = 0; i < 8; ++i) ss += (v[i][0] * v[i][0] + v[i][1] * v[i][1]) + (v[i][2] * v[i][2] + v[i][3] * v[i][3]);
    const float r = rsqrtf(wave_sum(ss) * (1.0f / D) + EPS);
#pragma unroll
    for (int i = 0; i < 8; ++i) { const int c = 4 * lane + 256 * i; const f32x4 g = *(const f32x4*)(a.gn + c), sc = *(const f32x4*)(a.scale + mo + c), sh = *(const f32x4*)(a.shift + mo + c);
        v[i] = v[i] * r * g * (sc + 1.0f) + sh;
        u32x2 w; w.x = pk2(v[i][0], v[i][1]); w.y = pk2(v[i][2], v[i][3]); *(u32x2*)(a.H + ro + c) = w; }
    if (!a.has_small) return;
    float keep0 = 0.f, keep1 = 0.f;
    for (int j = 0; j < NSM; ++j) { const float* wr = a.wsm + (size_t)j * D; float p = 0.f;
#pragma unroll
        for (int i = 0; i < 8; ++i) { const f32x4 w = *(const f32x4*)(wr + 4 * lane + 256 * i); p += (v[i][0] * w[0] + v[i][1] * w[1]) + (v[i][2] * w[2] + v[i][3] * w[3]); }
        p = wave_sum(p);
        if (j < 64) { if (lane == j) keep0 = p; } else { if (lane == j - 64) keep1 = p; } }
    a.baf[(size_t)m * NSM + lane] = keep0;
    if (lane < 16) a.baf[(size_t)m * NSM + 64 + lane] = keep1;
}

__global__ __launch_bounds__(256) void k_conv(const bf16* raw, const float* convw  , bf16* dnc) {
    const int lane = threadIdx.x & 63, gw = blockIdx.x * 4 + (threadIdx.x >> 6);
    const int hv = gw & 63, m = gw >> 6, t = m % T, c = hv * 128 + 2 * lane;
    const f32x4 w0 = *(const f32x4*)(convw + (size_t)c * 4), w1 = *(const f32x4*)(convw + (size_t)c * 4 + 4);
    float a0 = 0.f, a1 = 0.f;
#pragma unroll
    for (int j = 0; j < 4; ++j) { const int tt = t - 3 + j; if (tt >= 0) { const unsigned u = *(const unsigned*)(raw + (size_t)(m - 3 + j) * DN_CONV + c); a0 += w0[j] * bf_lo(u); a1 += w1[j] * bf_hi(u); } }
    a0 = fsilu(a0); a1 = fsilu(a1);
    if (hv < 32) { const float ss = wave_sum(a0 * a0 + a1 * a1); float r = rsqrtf(ss + EPS); if (hv < 16) r *= 0.08838834764831845f; a0 *= r; a1 *= r; }
    *(unsigned*)(dnc + (size_t)m * DN_CONV + c) = pk2(a0, a1);
}
__device__ __forceinline__ float softplus_f(float x) { return fmaxf(x, 0.f) + log1pf(__expf(-fabsf(x))); }
__global__ void k_gates(const float* baf, const float* a_log, const float* dt_bias, const float* f_bias, float* beta, float* g, float* logf) {
    const int idx = blockIdx.x * blockDim.x + threadIdx.x; if (idx >= M * NSM) return;
    const int m = idx / NSM, j = idx % NSM; const float v = baf[idx];
    if (j < 32) beta[(size_t)m * 32 + j] = 1.0f / (1.0f + expf(-v));
    else if (j < 64) { const int h = j - 32; g[(size_t)m * 32 + h] = -expf(a_log[h]) * softplus_f(v + dt_bias[h]); }
    else { const int h = j - 64; logf[(size_t)m * 16 + h] = -softplus_f(-(v + f_bias[h])); }
}
__global__ __launch_bounds__(64) void k_fcum(const float* logf, float* fc) {
    const int lane = threadIdx.x, bh = blockIdx.x, b = bh / FOXH, h = bh % FOXH; float carry = 0.f;
    for (int t0 = 0; t0 < T; t0 += 64) { float v = logf[(size_t)(b * T + t0 + lane) * 16 + h];
#pragma unroll
        for (int o = 1; o < 64; o <<= 1) { const float u = __shfl_up(v, o); if (lane >= o) v += u; }
        v += carry; fc[(size_t)bh * T + t0 + lane] = v; carry = __shfl(v, 63); }
}
__global__ __launch_bounds__(256) void k_dn_naive(const bf16* dnc, const float* g, const float* beta, float* o) {
    const int lane = threadIdx.x & 63, gw = blockIdx.x * 4 + (threadIdx.x >> 6);
    const int j = gw & 127, hv = (gw >> 7) & 31, b = gw >> 12, hq = hv >> 1;
    float s0 = 0.f, s1 = 0.f;
#pragma unroll 4
    for (int t = 0; t < T; ++t) { const size_t m = (size_t)b * T + t; const bf16* row = dnc + m * DN_CONV;
        const unsigned qu = *(const unsigned*)(row + hq * 128 + 2 * lane), ku = *(const unsigned*)(row + 2048 + hq * 128 + 2 * lane);
        const float vv = bf2f(row[4096 + hv * 128 + j]), gg = g[m * 32 + hv], be = beta[m * 32 + hv];
        const float q0 = bf_lo(qu), q1 = bf_hi(qu), k0 = bf_lo(ku), k1 = bf_hi(ku), eg = __expf(gg);
        s0 *= eg; s1 *= eg;
        float dk = s0 * k0 + s1 * k1, dq = s0 * q0 + s1 * q1, kq = k0 * q0 + k1 * q1;
#pragma unroll
        for (int of = 1; of < 64; of <<= 1) { dk += __shfl_xor(dk, of); dq += __shfl_xor(dq, of); kq += __shfl_xor(kq, of); }
        const float cc = be * (vv - dk);
        s0 += cc * k0; s1 += cc * k1;
        if (lane == 0) o[m * 4096 + hv * 128 + j] = dq + cc * kq; }
}
__global__ __launch_bounds__(256) void k_dn_norm(const float* o, const float* norm_w, const bf16* zs, bf16* odn) {
    const int lane = threadIdx.x & 63, gw = blockIdx.x * 4 + (threadIdx.x >> 6); const size_t off = (size_t)gw * 128 + 2 * lane;
    const float a0 = o[off], a1 = o[off + 1]; const float r = rsqrtf(wave_sum(a0 * a0 + a1 * a1) * (1.0f / 128.0f) + EPS);
    const unsigned zu = *(const unsigned*)(zs + off);
    *(unsigned*)(odn + off) = pk2(a0 * r * norm_w[2 * lane] * bf_lo(zu), a1 * r * norm_w[2 * lane + 1] * bf_hi(zu));
}
__global__ __launch_bounds__(256) void k_fox_naive(const bf16* fqkv, const float* fc, bf16* ofox) {
    const int lane = threadIdx.x & 63, gw = blockIdx.x * 4 + (threadIdx.x >> 6);
    const int h = gw & 15, t = (T - 1) - ((gw >> 4) % T), b = gw / (16 * T);
    const size_t m = (size_t)b * T + t;
    const unsigned qu = *(const unsigned*)(fqkv + m * 6144 + h * 128 + 2 * lane);
    const float q0 = bf_lo(qu) * 0.08838834764831845f, q1 = bf_hi(qu) * 0.08838834764831845f;
    const float* fch = fc + (size_t)(b * FOXH + h) * T; const float ft = fch[t];
    float mx = -1e30f, l = 0.f, o0 = 0.f, o1 = 0.f;
#pragma unroll 4
    for (int s = 0; s <= t; ++s) { const bf16* row = fqkv + ((size_t)b * T + s) * 6144 + h * 128 + 2 * lane;
        const unsigned ku = *(const unsigned*)(row + 2048), vu = *(const unsigned*)(row + 4096);
        float d = q0 * bf_lo(ku) + q1 * bf_hi(ku);
#pragma unroll
        for (int of = 1; of < 64; of <<= 1) d += __shfl_xor(d, of);
        d += ft - fch[s];
        const float mn = fmaxf(mx, d), al = __expf(mx - mn), p = __expf(d - mn);
        l = l * al + p; o0 = o0 * al + p * bf_lo(vu); o1 = o1 * al + p * bf_hi(vu); mx = mn; }
    const float il = 1.0f / l;
    *(unsigned*)(ofox + m * 2048 + h * 128 + 2 * lane) = pk2(o0 * il, o1 * il);
}

constexpr size_t MiB = 1u << 20;
static size_t ws_alloc(size_t& cur, size_t bytes) { const size_t o = cur; cur += (bytes + 255) & ~(size_t)255; return o; }
template <class Epi> static void launch_gemm(const bf16* A, const bf16* Bt, int Mm, int Nn, int Kk, const Epi& E, hipStream_t st) {
    static bool attr = false; if (!attr) { (void)hipFuncSetAttribute((const void*)k_gemm<Epi>, hipFuncAttributeMaxDynamicSharedMemorySize, pg8::STAGE_BYTES); attr = true; }
    pg8::Gemm g{A, Bt, Mm, Nn, Kk};
    hipLaunchKernelGGL((k_gemm<Epi>), dim3(256), dim3(512), pg8::STAGE_BYTES, st, g, E);
}
extern "C" void kernel_launch(void* const* d_in, const int* in_sizes, int n_in, void* d_out, int out_size, void* d_ws, size_t ws_size, hipStream_t stream) {
    const float* x_in = (const float*)d_in[0]; const float* c_in = (const float*)d_in[1]; const float* w_ada = (const float*)d_in[2]; const float* b_ada = (const float*)d_in[3];
    const float* gains = (const float*)d_in[4]; const float* w_in = (const float*)d_in[5]; const float* dn_conv = (const float*)d_in[6]; const float* a_log = (const float*)d_in[7];
    const float* dt_bias = (const float*)d_in[8]; const float* dn_norm_w = (const float*)d_in[9]; const float* f_bias = (const float*)d_in[10]; const float* w_brdn = (const float*)d_in[11];
    const float* w_brfox = (const float*)d_in[12]; const float* w_out = (const float*)d_in[13]; const float* w_gate = (const float*)d_in[14]; const float* w_up = (const float*)d_in[15]; const float* w_down = (const float*)d_in[16];
    float* xres = (float*)d_out;
    unsigned char* ws = (unsigned char*)d_ws; size_t cur = 0;
    bf16* Win_t = (bf16*)(ws + ws_alloc(cur, (size_t)DEPTH * NBIG * D * 2));
    bf16* Wbrdn_t = (bf16*)(ws + ws_alloc(cur, (size_t)DEPTH * D * 4096 * 2));
    bf16* Wbrfox_t = (bf16*)(ws + ws_alloc(cur, (size_t)DEPTH * D * D * 2));
    bf16* Wout_t = (bf16*)(ws + ws_alloc(cur, (size_t)DEPTH * D * D * 2));
    bf16* Wgu_t = (bf16*)(ws + ws_alloc(cur, (size_t)DEPTH * 2 * FF * D * 2));
    bf16* Wdown_t = (bf16*)(ws + ws_alloc(cur, (size_t)DEPTH * D * FF * 2));
    float* WSM = (float*)(ws + ws_alloc(cur, (size_t)DEPTH * NSM * D * 4));
    float* MOD = (float*)(ws + ws_alloc(cur, (size_t)DEPTH * 2 * 6 * D * 4));
    bf16* H = (bf16*)(ws + ws_alloc(cur, (size_t)M * D * 2));
    bf16* DNRAW = (bf16*)(ws + ws_alloc(cur, (size_t)M * 8192 * 2));
    bf16* DNC = (bf16*)(ws + ws_alloc(cur, (size_t)M * 8192 * 2));
    bf16* ZS = (bf16*)(ws + ws_alloc(cur, (size_t)M * 4096 * 2));
    bf16* FQKV = (bf16*)(ws + ws_alloc(cur, (size_t)M * 6144 * 2));
    bf16* MG = (bf16*)(ws + ws_alloc(cur, (size_t)M * 4096 * 2));
    float* BAF = (float*)(ws + ws_alloc(cur, (size_t)M * NSM * 4));
    float* BETA = (float*)(ws + ws_alloc(cur, (size_t)M * 32 * 4));
    float* GG = (float*)(ws + ws_alloc(cur, (size_t)M * 32 * 4));
    float* LOGF = (float*)(ws + ws_alloc(cur, (size_t)M * 16 * 4));
    float* FC = (float*)(ws + ws_alloc(cur, (size_t)M * 16 * 4));
    float* ODNRAW = (float*)(ws + ws_alloc(cur, (size_t)M * 4096 * 4));
    bf16* ODN = (bf16*)(ws + ws_alloc(cur, (size_t)M * 4096 * 2));
    bf16* OFOX = (bf16*)(ws + ws_alloc(cur, (size_t)M * 2048 * 2));
    float* YDN = (float*)(ws + ws_alloc(cur, (size_t)M * D * 4));
    bf16* MM = (bf16*)(ws + ws_alloc(cur, (size_t)M * D * 2));
    float* Y = (float*)(ws + ws_alloc(cur, (size_t)M * D * 4));
    bf16* HID = (bf16*)(ws + ws_alloc(cur, (size_t)M * FF * 2));
    if (n_in != 17 || out_size != M * D || cur > ws_size) { fprintf(stderr, "kernel_launch: bad shapes / workspace (need %zu, have %zu)\n", cur, ws_size); return; }

    for (int l = 0; l < DEPTH; ++l) {
        hipLaunchKernelGGL(k_transpose, dim3(1024), dim3(256), 0, stream, w_in + (size_t)l * D * NIN, D, NIN, NBIG, Win_t + (size_t)l * NBIG * D, 1);
        hipLaunchKernelGGL(k_transpose, dim3(1024), dim3(256), 0, stream, w_brdn + (size_t)l * 4096 * D, 4096, D, D, Wbrdn_t + (size_t)l * D * 4096, 0);
        hipLaunchKernelGGL(k_transpose, dim3(1024), dim3(256), 0, stream, w_brfox + (size_t)l * D * D, D, D, D, Wbrfox_t + (size_t)l * D * D, 0);
        hipLaunchKernelGGL(k_transpose, dim3(1024), dim3(256), 0, stream, w_out + (size_t)l * D * D, D, D, D, Wout_t + (size_t)l * D * D, 0);
        hipLaunchKernelGGL(k_transpose, dim3(1024), dim3(256), 0, stream, w_gate + (size_t)l * D * FF, D, FF, FF, Wgu_t + (size_t)l * 2 * FF * D, 2);
        hipLaunchKernelGGL(k_transpose, dim3(1024), dim3(256), 0, stream, w_up + (size_t)l * D * FF, D, FF, FF, Wgu_t + (size_t)l * 2 * FF * D, 3);
        hipLaunchKernelGGL(k_transpose, dim3(1024), dim3(256), 0, stream, w_down + (size_t)l * FF * D, FF, D, D, Wdown_t + (size_t)l * D * FF, 0);
    }
    hipLaunchKernelGGL(k_wsmall, dim3((DEPTH * D * NSM + 255) / 256), dim3(256), 0, stream, w_in, WSM);
    hipLaunchKernelGGL(k_adaln, dim3(6 * D / 64, DEPTH), dim3(256), 0, stream, c_in, w_ada, b_ada, MOD);

    for (int l = 0; l < DEPTH; ++l) {
        const float* mod = MOD + (size_t)l * 2 * 6 * D; const float* gl = gains + (size_t)l * 4 * D;
        if (l == 0) { RowArgs a{}; a.xin = x_in; a.x = xres; a.gn = gl; a.scale = mod + 1 * D; a.shift = mod; a.H = H; a.wsm = WSM; a.baf = BAF; a.has_y = 0; a.has_h = 1; a.has_small = 1;
            hipLaunchKernelGGL(k_rowpass, dim3(M / 4), dim3(256), 0, stream, a); }
        { pg8::EpiInProj E{DNRAW, ZS, FQKV, MG}; launch_gemm(H, Win_t + (size_t)l * NBIG * D, M, NBIG, D, E, stream); }
        hipLaunchKernelGGL(k_conv, dim3(M * 64 / 4), dim3(256), 0, stream, DNRAW, dn_conv + (size_t)l * 8192 * 4, DNC);
        hipLaunchKernelGGL(k_gates, dim3((M * NSM + 255) / 256), dim3(256), 0, stream, BAF, a_log + l * 32, dt_bias + l * 32, f_bias + l * 16, BETA, GG, LOGF);
        hipLaunchKernelGGL(k_fcum, dim3(NB * FOXH), dim3(64), 0, stream, LOGF, FC);
        hipLaunchKernelGGL(k_dn_naive, dim3(NB * 32 * 128 / 4), dim3(256), 0, stream, DNC, GG, BETA, ODNRAW);
        hipLaunchKernelGGL(k_dn_norm, dim3(M * 32 / 4), dim3(256), 0, stream, ODNRAW, dn_norm_w + l * 128, ZS, ODN);
        hipLaunchKernelGGL(k_fox_naive, dim3(NB * FOXH * T / 4), dim3(256), 0, stream, FQKV, FC, OFOX);
        { pg8::EpiF32 E{YDN, D}; launch_gemm(ODN, Wbrdn_t + (size_t)l * D * 4096, M, D, 4096, E, stream); }
        { pg8::EpiMerge E{YDN, MG, MM}; launch_gemm(OFOX, Wbrfox_t + (size_t)l * D * D, M, D, D, E, stream); }
        { pg8::EpiF32 E{Y, D}; launch_gemm(MM, Wout_t + (size_t)l * D * D, M, D, D, E, stream); }
        { RowArgs a{}; a.xin = xres; a.x = xres; a.Y = Y; a.gy = gl + 1 * D; a.gate = mod + 2 * D; a.gn = gl + 2 * D; a.scale = mod + 4 * D; a.shift = mod + 3 * D; a.H = H; a.has_y = 1; a.has_h = 1; a.has_small = 0;
            hipLaunchKernelGGL(k_rowpass, dim3(M / 4), dim3(256), 0, stream, a); }
        { pg8::EpiSwiGLU E{HID, FF}; launch_gemm(H, Wgu_t + (size_t)l * 2 * FF * D, M, 2 * FF, D, E, stream); }
        { pg8::EpiF32 E{Y, D}; launch_gemm(HID, Wdown_t + (size_t)l * D * FF, M, D, FF, E, stream); }
        { RowArgs a{}; a.xin = xres; a.x = xres; a.Y = Y; a.gy = gl + 3 * D; a.gate = mod + 5 * D; a.has_y = 1;
            if (l + 1 < DEPTH) { const float* mod2 = MOD + (size_t)(l + 1) * 2 * 6 * D; const float* gl2 = gains + (size_t)(l + 1) * 4 * D;
                a.gn = gl2; a.scale = mod2 + 1 * D; a.shift = mod2; a.H = H; a.wsm = WSM + (size_t)(l + 1) * NSM * D; a.baf = BAF; a.has_h = 1; a.has_small = 1; }
            hipLaunchKernelGGL(k_rowpass, dim3(M / 4), dim3(256), 0, stream, a); }
    }
}
```

```cpp
#include <hip/hip_runtime.h>
#include <cstdio>
#include <cstdint>

constexpr int D = 2048, NB = 2, T = 4096, M = NB * T, DEPTH = 4;
constexpr int HD = 128, DN_VH = 32, DN_CONV = 8192;
constexpr int FOXH = 16;
constexpr int FF = 5632;
constexpr int NIN = 22608;
constexpr int SRC_B = 12288, SRC_A = 12320, SRC_FQKV = 12352, SRC_F = 18496, SRC_MERGE = 18512;
constexpr int NBIG = 22528;
constexpr int NSM = 80;
constexpr float EPS = 1e-6f;

typedef unsigned short bf16;
typedef float f32x4 __attribute__((ext_vector_type(4)));
typedef unsigned u32x4 __attribute__((ext_vector_type(4)));
typedef unsigned u32x2 __attribute__((ext_vector_type(2)));
#define LAS __attribute__((address_space(3)))

__device__ __forceinline__ float bf_lo(unsigned w) { return __uint_as_float(w << 16); }
__device__ __forceinline__ float bf_hi(unsigned w) { return __uint_as_float(w & 0xffff0000u); }
__device__ __forceinline__ float bf2f(bf16 h) { return __uint_as_float(((unsigned)h) << 16); }
__device__ __forceinline__ unsigned f2bf(float f) { unsigned u = __float_as_uint(f); return (u + 0x7fffu + ((u >> 16) & 1u)) >> 16; }
__device__ __forceinline__ unsigned pk2(float lo, float hi) { return f2bf(lo) | (f2bf(hi) << 16); }
__device__ __forceinline__ float fsigmoid(float x) { return __builtin_amdgcn_rcpf(1.0f + __expf(-x)); }
__device__ __forceinline__ float fsilu(float x) { return x * fsigmoid(x); }
__device__ __forceinline__ float wave_sum(float v) {
#pragma unroll
    for (int o = 1; o < 64; o <<= 1) v += __shfl_xor(v, o);
    return v;
}
namespace pg8 {
#define PG8_LAS __attribute__((address_space(3)))
typedef unsigned short bf16_t;
typedef short bf16x8 __attribute__((ext_vector_type(8)));
typedef float f32x4 __attribute__((ext_vector_type(4)));
typedef unsigned u32x4 __attribute__((ext_vector_type(4)));
constexpr int BM = 256, BK = 64, HALF = 128, HTB = HALF * BK * 2  , STAGE_BYTES = 8 * HTB, NXCD = 8, WGM = 8;

__host__ __device__ __forceinline__ int lds_byte(int r, int c) { const int st = (r >> 4) * 2 + (c >> 5), rr = r & 15, cc = c & 31, ob = rr * 64 + cc * 2; return st * 1024 + (ob ^ (((ob >> 9) & 1) << 5)); }
__host__ __device__ __forceinline__ void stage_rc(int b, int& R, int& C) { const int st = b / 1024, sb = b % 1024, swz = sb ^ (((sb >> 9) & 1) << 5); R = (st >> 1) * 16 + swz / 64; C = (st & 1) * 32 + (swz % 64) / 2; }
__host__ __device__ __forceinline__ int perm32(int rho) { const int n = rho >> 4, i = rho & 15; return 8 * (i >> 2) + 4 * n + (i & 3); }

struct Unit { int pm, pn; };
struct Gemm { const bf16_t* A; const bf16_t* Bt; int M, N, K, pad; };

struct StaticOrder {
    int nM, nN, nwg, G, c;
    __host__ __device__ void init(int M, int N, int G_, int c_) { nM = M / BM; nN = N / BM; nwg = nM * nN; G = G_; c = c_; }
    __host__ __device__ bool next(int i, Unit& u) const {
        const long L = (long)i * G + c; if (L >= nwg) return false;
        int wgid = (int)L; { const int q = nwg / NXCD, r = nwg % NXCD, xcd = wgid % NXCD, off = wgid / NXCD; wgid = (xcd < r ? xcd * (q + 1) : r * (q + 1) + (xcd - r) * q) + off; }
        const int nig = WGM * nN, gid = wgid / nig, fm = gid * WGM, gsz = (nM - fm) < WGM ? (nM - fm) : WGM;
        u.pm = fm + ((wgid % nig) % gsz); u.pn = (wgid % nig) / gsz; return true;
    }
    __device__ __forceinline__ void a_ready(const Unit&) const {}
    __device__ __forceinline__ void done(const Unit&) const {}
};

__device__ __forceinline__ unsigned cvt_pk_bf16(float lo, float hi) { unsigned r; asm volatile("v_cvt_pk_bf16_f32 %0, %1, %2" : "=v"(r) : "v"(lo), "v"(hi)); return r; }
__device__ __forceinline__ float e_sigmoid(float x) { return __builtin_amdgcn_rcpf(1.0f + __expf(-x)); }

struct EpiF32 {
    static constexpr bool PERM = false, AFTER_DRAIN = false;
    float* C; int ldc, pad;
    __device__ __forceinline__ void operator()(const f32x4 (&acc)[2][2][4][2], const Unit& u, int wr, int wc, int fr, int fq) const {
        const int row0 = u.pm * BM + wr * 64 + fr, col0 = u.pn * BM + wc * 32 + 4 * fq;
#pragma unroll
        for (int ai = 0; ai < 2; ++ai)
#pragma unroll
            for (int m = 0; m < 4; ++m) { float* rowp = C + (size_t)(row0 + ai * HALF + m * 16) * ldc + col0;
#pragma unroll
                for (int bj = 0; bj < 2; ++bj)
#pragma unroll
                    for (int n = 0; n < 2; ++n) *(f32x4*)(rowp + bj * HALF + n * 16) = acc[ai][bj][m][n]; }
    }
};
struct EpiInProj {
    static constexpr bool PERM = true, AFTER_DRAIN = false;
    bf16_t *dnraw, *z, *fqkv, *mg;
    __device__ __forceinline__ void operator()(const f32x4 (&acc)[2][2][4][2], const Unit& u, int wr, int wc, int fr, int fq) const {
        const int pn = u.pn; bf16_t* base; int ldc, colt, act;
        if (pn < 32) { base = dnraw; ldc = 8192; colt = pn * BM; act = 0; }
        else if (pn < 48) { base = z; ldc = 4096; colt = (pn - 32) * BM; act = 1; }
        else if (pn < 72) { base = fqkv; ldc = 6144; colt = (pn - 48) * BM; act = 0; }
        else { base = mg; ldc = 4096; colt = (pn - 72) * BM; act = 2; }
        const int row0 = u.pm * BM + wr * 64 + fr, col0 = colt + wc * 32 + 8 * fq;
#pragma unroll
        for (int ai = 0; ai < 2; ++ai)
#pragma unroll
            for (int m = 0; m < 4; ++m) { bf16_t* rowp = base + (size_t)(row0 + ai * HALF + m * 16) * ldc + col0;
#pragma unroll
                for (int bj = 0; bj < 2; ++bj) { f32x4 v0 = acc[ai][bj][m][0], v1 = acc[ai][bj][m][1];
                    if (act == 1) {
#pragma unroll
                        for (int j = 0; j < 4; ++j) { v0[j] = v0[j] * e_sigmoid(v0[j]); v1[j] = v1[j] * e_sigmoid(v1[j]); } }
                    if (act == 2) {
#pragma unroll
                        for (int j = 0; j < 4; ++j) { v0[j] = e_sigmoid(v0[j]); v1[j] = e_sigmoid(v1[j]); } }
                    u32x4 w; w.x = cvt_pk_bf16(v0[0], v0[1]); w.y = cvt_pk_bf16(v0[2], v0[3]); w.z = cvt_pk_bf16(v1[0], v1[1]); w.w = cvt_pk_bf16(v1[2], v1[3]);
                    *(u32x4*)(rowp + bj * HALF) = w; } }
    }
};
struct EpiMerge {
    static constexpr bool PERM = true, AFTER_DRAIN = false;
    const float* ydn; const bf16_t* mg; bf16_t* mm;
    __device__ __forceinline__ void operator()(const f32x4 (&acc)[2][2][4][2], const Unit& u, int wr, int wc, int fr, int fq) const {
        const int row0 = u.pm * BM + wr * 64 + fr, col0 = u.pn * BM + wc * 32 + 8 * fq;
#pragma unroll
        for (int ai = 0; ai < 2; ++ai)
#pragma unroll
            for (int m = 0; m < 4; ++m) { const size_t row = (size_t)(row0 + ai * HALF + m * 16);
#pragma unroll
                for (int bj = 0; bj < 2; ++bj) { const int col = col0 + bj * HALF;
                    const f32x4 y0 = *(const f32x4*)(ydn + row * 2048 + col), y1 = *(const f32x4*)(ydn + row * 2048 + col + 4);
                    const u32x4 gd = *(const u32x4*)(mg + row * 4096 + col), gf = *(const u32x4*)(mg + row * 4096 + 2048 + col);
                    const f32x4 a0 = acc[ai][bj][m][0], a1 = acc[ai][bj][m][1];
                    float o[8];
                    o[0] = __uint_as_float(gd.x << 16) * y0[0] + __uint_as_float(gf.x << 16) * a0[0];
                    o[1] = __uint_as_float(gd.x & 0xffff0000u) * y0[1] + __uint_as_float(gf.x & 0xffff0000u) * a0[1];
                    o[2] = __uint_as_float(gd.y << 16) * y0[2] + __uint_as_float(gf.y << 16) * a0[2];
                    o[3] = __uint_as_float(gd.y & 0xffff0000u) * y0[3] + __uint_as_float(gf.y & 0xffff0000u) * a0[3];
                    o[4] = __uint_as_float(gd.z << 16) * y1[0] + __uint_as_float(gf.z << 16) * a1[0];
                    o[5] = __uint_as_float(gd.z & 0xffff0000u) * y1[1] + __uint_as_float(gf.z & 0xffff0000u) * a1[1];
                    o[6] = __uint_as_float(gd.w << 16) * y1[2] + __uint_as_float(gf.w << 16) * a1[2];
                    o[7] = __uint_as_float(gd.w & 0xffff0000u) * y1[3] + __uint_as_float(gf.w & 0xffff0000u) * a1[3];
                    u32x4 w; w.x = cvt_pk_bf16(o[0], o[1]); w.y = cvt_pk_bf16(o[2], o[3]); w.z = cvt_pk_bf16(o[4], o[5]); w.w = cvt_pk_bf16(o[6], o[7]);
                    *(u32x4*)(mm + row * 2048 + col) = w; } }
    }
};
struct EpiSwiGLU {
    static constexpr bool PERM = true, AFTER_DRAIN = false;
    bf16_t* hid; int ldc, pad;
    __device__ __forceinline__ void operator()(const f32x4 (&acc)[2][2][4][2], const Unit& u, int wr, int wc, int fr, int fq) const {
        const int row0 = u.pm * BM + wr * 64 + fr, col0 = u.pn * HALF + wc * 32 + 8 * fq;
#pragma unroll
        for (int ai = 0; ai < 2; ++ai)
#pragma unroll
            for (int m = 0; m < 4; ++m) { bf16_t* rowp = hid + (size_t)(row0 + ai * HALF + m * 16) * ldc + col0;
                const f32x4 g0 = acc[ai][0][m][0], g1 = acc[ai][0][m][1], u0 = acc[ai][1][m][0], u1 = acc[ai][1][m][1];
                float o[8];
#pragma unroll
                for (int j = 0; j < 4; ++j) { o[j] = g0[j] * e_sigmoid(g0[j]) * u0[j]; o[4 + j] = g1[j] * e_sigmoid(g1[j]) * u1[j]; }
                u32x4 w; w.x = cvt_pk_bf16(o[0], o[1]); w.y = cvt_pk_bf16(o[2], o[3]); w.z = cvt_pk_bf16(o[4], o[5]); w.w = cvt_pk_bf16(o[6], o[7]);
                *(u32x4*)rowp = w; }
    }
};

template <class Epi, class Sched, bool ALIGN_EPI = false, bool SP2 = false>
__device__ __forceinline__ void gemm_phase(PG8_LAS unsigned char* lds, const Gemm g, const Sched& S, const Epi& E) {
    int tid_ = threadIdx.x; asm volatile("" : "+v"(tid_)); const int tid = tid_, wid = __builtin_amdgcn_readfirstlane(tid >> 6), lane = tid & 63, wr = wid >> 2, wc = wid & 3, fr = lane & 15, fq = lane >> 4;
    const int K = g.K, nt = K / BK;
    unsigned voffA[2], voffB[2];
#pragma unroll
    for (int i = 0; i < 2; ++i) { int R, C; stage_rc(tid * 16 + i * 8192, R, C); const int Rb = Epi::PERM ? ((R & ~31) + perm32(R & 31)) : R;
        voffA[i] = (unsigned)(R * K + C) * 2u; voffB[i] = (unsigned)(Rb * K + C) * 2u; }
    const size_t kstep = (size_t)(BK * 2);
    const size_t hstep = (size_t)HALF * K * 2;
    const size_t tstep = 2 * hstep;
    const unsigned ldsw = (unsigned)wid * 1024u;
    const int aoff = lds_byte(wr * 64 + fr, fq * 8), boff = lds_byte(wc * 32 + fr, fq * 8);
#define PG8_SA(b, h) (((b) * 2 + (h)) * HTB)
#define PG8_SB(b, h) ((4 + (b) * 2 + (h)) * HTB)
#define PG8_STAGE(bufoff, gbase, voff) do { _Pragma("unroll") for (int _i = 0; _i < 2; ++_i) \
        __builtin_amdgcn_global_load_lds((const unsigned*)((const char*)(gbase) + (voff)[_i]), (PG8_LAS unsigned*)(lds + (bufoff) + ldsw + _i * 8192), 16, 0, 0); } while (0)
#define PG8_LDA(dst, b, h) do { _Pragma("unroll") for (int m = 0; m < 4; ++m) _Pragma("unroll") for (int k = 0; k < 2; ++k) dst[m][k] = *(const PG8_LAS bf16x8*)(lds + PG8_SA(b, h) + aoff + m * 2048 + k * 1024); } while (0)
#define PG8_LDB(dst, b, h) do { _Pragma("unroll") for (int n = 0; n < 2; ++n) _Pragma("unroll") for (int k = 0; k < 2; ++k) dst[n][k] = *(const PG8_LAS bf16x8*)(lds + PG8_SB(b, h) + boff + n * 2048 + k * 1024); } while (0)
#define PG8_MMA(ai, bj, At, Bt) do { __builtin_amdgcn_s_setprio(1); _Pragma("unroll") for (int m = 0; m < 4; ++m) _Pragma("unroll") for (int n = 0; n < 2; ++n) _Pragma("unroll") for (int k = 0; k < 2; ++k) \
        acc[ai][bj][m][n] = __builtin_amdgcn_mfma_f32_16x16x32_bf16(Bt[n][k], At[m][k], acc[ai][bj][m][n], 0, 0, 0); __builtin_amdgcn_s_setprio(0); } while (0)
#define PG8_WAIT_V(n) asm volatile("s_waitcnt vmcnt(" #n ")" ::: "memory")
#define PG8_WAIT_L(n) asm volatile("s_waitcnt lgkmcnt(" #n ")" ::: "memory")
#define PG8_BAR __builtin_amdgcn_s_barrier()
#define PG8_SCHED __builtin_amdgcn_sched_barrier(0)
    Unit cur, nxt; int ui = 0;
    if (!S.next(0, cur)) return;
    f32x4 acc[2][2][4][2];
#pragma unroll
    for (int a = 0; a < 2; ++a)
#pragma unroll
        for (int b = 0; b < 2; ++b)
#pragma unroll
            for (int m = 0; m < 4; ++m)
#pragma unroll
                for (int n = 0; n < 2; ++n) acc[a][b][m][n] = (f32x4){0.f, 0.f, 0.f, 0.f};
    bf16x8 At[4][2], B0[2][2], B1[2][2];
    const char* cA = (const char*)g.A + (size_t)cur.pm * tstep; const char* cB = (const char*)g.Bt + (size_t)cur.pn * tstep;
    S.a_ready(cur);
    if constexpr (SP2) {
        PG8_STAGE(PG8_SB(0, 0), cB, voffB); PG8_STAGE(PG8_SB(0, 1), cB + hstep, voffB); PG8_STAGE(PG8_SA(0, 0), cA, voffA); PG8_STAGE(PG8_SA(0, 1), cA + hstep, voffA);
        if (wr == 1) PG8_BAR;
        PG8_WAIT_V(2); PG8_BAR;
        PG8_STAGE(PG8_SB(1, 0), cB + kstep, voffB); PG8_STAGE(PG8_SA(1, 0), cA + kstep, voffA); PG8_STAGE(PG8_SB(1, 1), cB + hstep + kstep, voffB);
        PG8_WAIT_V(6); PG8_BAR;
    } else {
        PG8_STAGE(PG8_SB(0, 0), cB, voffB); PG8_STAGE(PG8_SA(0, 0), cA, voffA); PG8_STAGE(PG8_SB(0, 1), cB + hstep, voffB); PG8_STAGE(PG8_SA(0, 1), cA + hstep, voffA);
        if (wr == 1) PG8_BAR;
        PG8_WAIT_V(4); PG8_BAR;
        PG8_STAGE(PG8_SB(1, 0), cB + kstep, voffB); PG8_STAGE(PG8_SA(1, 0), cA + kstep, voffA); PG8_STAGE(PG8_SB(1, 1), cB + hstep + kstep, voffB);
        PG8_WAIT_V(6); PG8_BAR;
    }
    for (;;) {
        const bool has_next = S.next(ui + 1, nxt);
        const char* nA = has_next ? (const char*)g.A + (size_t)nxt.pm * tstep : cA; const char* nB = has_next ? (const char*)g.Bt + (size_t)nxt.pn * tstep : cB;
        for (int t = 0; t < nt; t += 2) {
            const bool last = (t == nt - 2);
            const char* a1 = cA + (size_t)(t + 1) * kstep;
            const char* a2 = last ? nA : cA + (size_t)(t + 2) * kstep; const char* b2 = last ? nB : cB + (size_t)(t + 2) * kstep;
            const char* a3 = a2 + kstep; const char* b3 = b2 + kstep;
            if (last && has_next) S.a_ready(nxt);
            if constexpr (SP2) {
            PG8_LDB(B0, 0, 0); PG8_LDB(B1, 0, 1); PG8_SCHED; PG8_LDA(At, 0, 0); PG8_STAGE(PG8_SA(1, 1), a1 + hstep, voffA);
            PG8_WAIT_V(8); PG8_WAIT_L(0); PG8_BAR; PG8_MMA(0, 0, At, B0); PG8_MMA(0, 1, At, B1); PG8_BAR; PG8_SCHED;
            PG8_LDA(At, 0, 1); PG8_STAGE(PG8_SB(0, 0), b2, voffB); PG8_STAGE(PG8_SB(0, 1), b2 + hstep, voffB); PG8_STAGE(PG8_SA(0, 0), a2, voffA);
            PG8_WAIT_V(8); PG8_WAIT_L(0); PG8_BAR; PG8_MMA(1, 0, At, B0); PG8_MMA(1, 1, At, B1); PG8_BAR; PG8_SCHED;
            PG8_LDB(B0, 1, 0); PG8_LDB(B1, 1, 1); PG8_SCHED; PG8_LDA(At, 1, 0); PG8_STAGE(PG8_SA(0, 1), a2 + hstep, voffA);
            PG8_WAIT_V(8); PG8_WAIT_L(0); PG8_BAR; PG8_MMA(0, 0, At, B0); PG8_MMA(0, 1, At, B1); PG8_BAR; PG8_SCHED;
            PG8_LDA(At, 1, 1); PG8_STAGE(PG8_SB(1, 0), b3, voffB); PG8_STAGE(PG8_SB(1, 1), b3 + hstep, voffB); PG8_STAGE(PG8_SA(1, 0), a3, voffA);
            PG8_WAIT_V(8); PG8_WAIT_L(0); PG8_BAR; PG8_MMA(1, 0, At, B0); PG8_MMA(1, 1, At, B1); PG8_BAR; PG8_SCHED;
            } else {
            PG8_LDB(B0, 0, 0); PG8_SCHED; PG8_LDA(At, 0, 0); PG8_STAGE(PG8_SA(1, 1), a1 + hstep, voffA);
            PG8_WAIT_L(8); PG8_BAR; PG8_WAIT_L(0); PG8_MMA(0, 0, At, B0); PG8_BAR; PG8_SCHED;
            PG8_LDB(B1, 0, 1); PG8_STAGE(PG8_SB(0, 0), b2, voffB);
            PG8_BAR; PG8_WAIT_L(0); PG8_MMA(0, 1, At, B1); PG8_BAR;
            PG8_LDA(At, 0, 1); PG8_STAGE(PG8_SA(0, 0), a2, voffA);
            PG8_BAR; PG8_WAIT_L(0); PG8_MMA(1, 0, At, B0); PG8_BAR; PG8_SCHED;
            PG8_STAGE(PG8_SB(0, 1), b2 + hstep, voffB);
            PG8_WAIT_V(6); PG8_BAR; PG8_MMA(1, 1, At, B1); PG8_BAR;
            PG8_LDB(B0, 1, 0); PG8_SCHED; PG8_LDA(At, 1, 0); PG8_STAGE(PG8_SA(0, 1), a2 + hstep, voffA);
            PG8_WAIT_L(8); PG8_BAR; PG8_WAIT_L(0); PG8_MMA(0, 0, At, B0); PG8_BAR; PG8_SCHED;
            PG8_LDB(B1, 1, 1); PG8_STAGE(PG8_SB(1, 0), b3, voffB);
            PG8_BAR; PG8_WAIT_L(0); PG8_MMA(0, 1, At, B1); PG8_BAR;
            PG8_LDA(At, 1, 1); PG8_STAGE(PG8_SA(1, 0), a3, voffA);
            PG8_BAR; PG8_WAIT_L(0); PG8_MMA(1, 0, At, B0); PG8_BAR; PG8_SCHED;
            PG8_STAGE(PG8_SB(1, 1), b3 + hstep, voffB);
            PG8_WAIT_V(6); PG8_BAR; PG8_MMA(1, 1, At, B1); PG8_BAR;
            }
        }
        if constexpr (ALIGN_EPI) { if (wr == 0) PG8_BAR; }
        if constexpr (!Epi::AFTER_DRAIN) { E(acc, cur, wr, wc, fr, fq); S.done(cur); }
        if (!has_next) break;
#pragma unroll
        for (int a = 0; a < 2; ++a)
#pragma unroll
            for (int b = 0; b < 2; ++b)
#pragma unroll
                for (int m = 0; m < 4; ++m)
#pragma unroll
                    for (int n = 0; n < 2; ++n) acc[a][b][m][n] = (f32x4){0.f, 0.f, 0.f, 0.f};
        cur = nxt; cA = nA; cB = nB; ++ui;
        if constexpr (ALIGN_EPI) { if (wr == 1) PG8_BAR; }
    }
    PG8_WAIT_V(0);
    if constexpr (!ALIGN_EPI) { if (wr == 0) PG8_BAR; }
    PG8_BAR;
    if constexpr (Epi::AFTER_DRAIN) { E.fused(acc, cur, wr, wc, fr, fq, lds, wid, lane); S.done(cur); }
#undef PG8_SA
#undef PG8_SB
#undef PG8_STAGE
#undef PG8_LDA
#undef PG8_LDB
#undef PG8_MMA
#undef PG8_WAIT_V
#undef PG8_WAIT_L
#undef PG8_BAR
#undef PG8_SCHED
}
}
#define XB_TMO      128
#define XB_XCNT(j)  (256  + 64 * (j))
#define XB_XSUB(j)  (1280 + 64 * (j))
#define XB_XGEN(j)  (2304 + 64 * (j))
#define XB_TOP      3328
#define XB_TOPGEN   3392
#define XCD_BAR_WORDS 3456
#define XB_SPIN_CAP (1u << 21)


__device__ __forceinline__ unsigned xb_ld(unsigned* p)              { return __hip_atomic_load(p, __ATOMIC_RELAXED, __HIP_MEMORY_SCOPE_AGENT); }
__device__ __forceinline__ unsigned xb_add(unsigned* p, unsigned v) { return __hip_atomic_fetch_add(p, v, __ATOMIC_RELAXED, __HIP_MEMORY_SCOPE_AGENT); }
__device__ __forceinline__ unsigned xb_xcc_id() { return (unsigned)__builtin_amdgcn_s_getreg((3 << 11) | 20) & 0xFu; }
#define XB_SPIN(cond, bar) do { unsigned _sp = 0; while (cond) { __builtin_amdgcn_s_sleep(1); \
    if ((++_sp & 255u) == 0u) { if (xb_ld(&(bar)[XB_TMO])) break; if (_sp > XB_SPIN_CAP) { atomicAdd(&(bar)[XB_TMO], 1u); break; } } } } while (0)

struct XcdBarrier {
    unsigned* bar; unsigned x;
    volatile LAS unsigned* st;
};

__device__ __forceinline__ XcdBarrier xcd_barrier_post(unsigned* bar, volatile LAS unsigned* st) {
    XcdBarrier b; b.bar = bar; b.x = xb_xcc_id(); b.st = st;
    if (threadIdx.x == 0) (void)xb_add(&bar[XB_XCNT(b.x)], 1u);
    return b;
}
__device__ __forceinline__ void xcd_barrier_complete(unsigned* bar, unsigned x, unsigned& nloc, unsigned& nx) {
    const unsigned G = gridDim.x * gridDim.y * gridDim.z;
    unsigned sum, cnt, mine, sp = 0u;
    for (;;) {
        sum = 0u; cnt = 0u; mine = 0u;
#pragma unroll
        for (unsigned j = 0; j < 16; ++j) { const unsigned c = xb_ld(&bar[XB_XCNT(j)]); sum += c; cnt += (c > 0u) ? 1u : 0u; mine = (j == x) ? c : mine; }
        if (sum == G) break;
        __builtin_amdgcn_s_sleep(1);
        if ((++sp & 255u) == 0u) { if (xb_ld(&bar[XB_TMO])) break; if (sp > XB_SPIN_CAP) { atomicAdd(&bar[XB_TMO], 1u); break; } }
    }
    nloc = mine > 0u ? mine : 1u; nx = cnt > 0u ? cnt : 1u;
}

__device__ __forceinline__ void xcd_barrier(const XcdBarrier& b) {
    asm volatile("s_waitcnt vmcnt(0)" ::: "memory");
    __syncthreads();
    if (threadIdx.x == 0) {
        unsigned* bar = b.bar;
        __builtin_amdgcn_s_waitcnt(0);
        unsigned nloc = b.st[0], nx = b.st[1];
        if (nloc == 0u) { xcd_barrier_complete(bar, b.x, nloc, nx); b.st[0] = nloc; b.st[1] = nx; }
        const unsigned old = xb_add(&bar[XB_XSUB(b.x)], 1u);
        const unsigned gen = old / nloc;
        if (old + 1u == (gen + 1u) * nloc) {
            __builtin_amdgcn_fence(__ATOMIC_RELEASE, "agent");
            asm volatile("s_waitcnt vmcnt(0)" ::: "memory");
            const unsigned og = xb_add(&bar[XB_TOP], 1u);
            const unsigned tg = og / nx;
            if (og + 1u == (tg + 1u) * nx) xb_add(&bar[XB_TOPGEN], 1u);
            else XB_SPIN(xb_ld(&bar[XB_TOPGEN]) == tg, bar);
            __builtin_amdgcn_fence(__ATOMIC_ACQUIRE, "agent");
            xb_add(&bar[XB_XGEN(b.x)], 1u);
            asm volatile("s_waitcnt vmcnt(0)" ::: "memory");
        } else {
            XB_SPIN(xb_ld(&bar[XB_XGEN(b.x)]) == gen, bar);
            __builtin_amdgcn_fence(__ATOMIC_ACQUIRE, "agent");
            asm volatile("s_waitcnt vmcnt(0)" ::: "memory");
        }
    }
    __syncthreads();
}

struct Ctx { LAS unsigned char* lds; int tid, lane, wave, gw, NW, G; };

__device__ __forceinline__ void transpose_item(const float* W, int ldw, int k0, int c0, bf16* WT, int K, int r0, LAS float* scr, int lane) {
#pragma unroll 8
    for (int i = 0; i < 32; ++i) { const int kk = 2 * i + (lane >> 5); scr[kk * 33 + (lane & 31)] = W[(size_t)(k0 + kk) * ldw + c0 + (lane & 31)]; }
    asm volatile("s_waitcnt lgkmcnt(0)" ::: "memory");
    const int c = lane & 7;
#pragma unroll
    for (int j = 0; j < 4; ++j) { const int n = (lane >> 3) + 8 * j; const LAS float* s = scr + (8 * c) * 33 + n;
        u32x4 o; o.x = pk2(s[0 * 33], s[1 * 33]); o.y = pk2(s[2 * 33], s[3 * 33]); o.z = pk2(s[4 * 33], s[5 * 33]); o.w = pk2(s[6 * 33], s[7 * 33]);
        *(u32x4*)(WT + (size_t)(r0 + n) * K + k0 + 8 * c) = o; }
    asm volatile("s_waitcnt lgkmcnt(0)" ::: "memory");
}
__device__ __forceinline__ void map_rows(int mode, int nb, int& c0, int& r0) {
    const int n0 = nb * 32;
    if (mode == 0) { c0 = n0; r0 = n0; }
    else if (mode == 1) { r0 = n0; c0 = n0 < 12288 ? n0 : (n0 < 18432 ? SRC_FQKV + (n0 - 12288) : SRC_MERGE + (n0 - 18432)); }
    else { c0 = n0; r0 = (n0 >> 7) * 256 + (n0 & 127) + (mode == 3 ? 128 : 0); }
}
__device__ __forceinline__ void ph_transpose(const Ctx& c, const float* W, int K, int ldw, int ncols, bf16* WT, int mode) {
    LAS float* scr = (LAS float*)(c.lds + c.wave * 16384); int lane = c.lane; asm volatile("" : "+v"(lane));
    const int nblk = ncols / 32, nitems = (K / 64) * nblk;
    for (int it = c.gw; it < nitems; it += c.NW) { const int kb = it / nblk, nb = it % nblk; int c0, r0; map_rows(mode, nb, c0, r0);
        transpose_item(W, ldw, kb * 64, c0, WT, K, r0, scr, lane); }
}
__device__ __forceinline__ void ph_wsmall(const Ctx& c, const float* w_in, float* wsm) {
    int lane = c.lane; asm volatile("" : "+v"(lane));
    for (int idx = c.gw * 64 + lane; idx < DEPTH * D * NSM; idx += c.NW * 64) {
        const int j = idx % NSM, k = (idx / NSM) % D, l = idx / (NSM * D);
        const int sc = j < 32 ? SRC_B + j : (j < 64 ? SRC_A + (j - 32) : SRC_F + (j - 64));
        wsm[((size_t)l * NSM + j) * D + k] = w_in[((size_t)l * D + k) * NIN + sc]; }
}
__device__ __forceinline__ void ph_adaln(const Ctx& c, const float* cin, const float* w_ada, const float* b_ada, float* mod) {
    LAS float* cond = (LAS float*)c.lds;
    LAS float* red = (LAS float*)(c.lds + 16384);
    int tid = c.tid; asm volatile("" : "+v"(tid)); const int lane = tid & 63;
    for (int i = tid; i < 2 * D; i += 512) cond[i] = fsilu(cin[i]);
    __syncthreads();
    const int ntask = DEPTH * (6 * D / 64);
    for (int task = blockIdx.x; task < ntask; task += c.G) {
        const int l = task / (6 * D / 64), n = (task % (6 * D / 64)) * 64 + lane;
        const float* w = w_ada + (size_t)l * D * (6 * D) + n; float a0 = 0.f, a1 = 0.f;
#pragma unroll 8
        for (int k = c.wave * 256; k < c.wave * 256 + 256; ++k) { const float wv = w[(size_t)k * (6 * D)]; a0 += cond[k] * wv; a1 += cond[D + k] * wv; }
        red[(c.wave * 2 + 0) * 64 + lane] = a0; red[(c.wave * 2 + 1) * 64 + lane] = a1;
        __syncthreads();
        if (tid < 128) { const int b = tid >> 6; float s = b_ada[(size_t)l * 6 * D + n];
#pragma unroll
            for (int w8 = 0; w8 < 8; ++w8) s += red[(w8 * 2 + b) * 64 + lane];
            mod[((size_t)l * 2 + b) * (6 * D) + n] = s; }
        __syncthreads();
    }
}

struct RowArgs { const float* xin; float* x; const float* Y; const float* gy; const float* gate; const float* gn; const float* scale; const float* shift; bf16* H; const float* wsm; float* baf; int has_y, has_h, has_small; };
__device__ __forceinline__ void ph_rowpass(const Ctx& c, const RowArgs& a) {
    int lane = c.lane; asm volatile("" : "+v"(lane));
    for (int m = c.gw; m < M; m += c.NW) {
        const int b = m / T; const size_t ro = (size_t)m * D; const int mo = b * 6 * D;
        f32x4 v[8];
#pragma unroll
        for (int i = 0; i < 8; ++i) v[i] = *(const f32x4*)(a.xin + ro + 4 * lane + 256 * i);
        if (a.has_y) {
            f32x4 y[8]; float ss = 0.f;
#pragma unroll
            for (int i = 0; i < 8; ++i) { y[i] = *(const f32x4*)(a.Y + ro + 4 * lane + 256 * i); ss += (y[i][0] * y[i][0] + y[i][1] * y[i][1]) + (y[i][2] * y[i][2] + y[i][3] * y[i][3]); }
            const float r = rsqrtf(wave_sum(ss) * (1.0f / D) + EPS);
#pragma unroll
            for (int i = 0; i < 8; ++i) { const int cc = 4 * lane + 256 * i; const f32x4 g = *(const f32x4*)(a.gy + cc), gt = *(const f32x4*)(a.gate + mo + cc);
                v[i] = v[i] + gt * (y[i] * r * g); }
        }
#pragma unroll
        for (int i = 0; i < 8; ++i) *(f32x4*)(a.x + ro + 4 * lane + 256 * i) = v[i];
        if (!a.has_h) continue;
        float ss = 0.f;
#pragma unroll
        for (int i = 0; i < 8; ++i) ss += (v[i][0] * v[i][0] + v[i][1] * v[i][1]) + (v[i][2] * v[i][2] + v[i][3] * v[i][3]);
        const float r = rsqrtf(wave_sum(ss) * (1.0f / D) + EPS);
#pragma unroll
        for (int i = 0; i < 8; ++i) { const int cc = 4 * lane + 256 * i; const f32x4 g = *(const f32x4*)(a.gn + cc), sc = *(const f32x4*)(a.scale + mo + cc), sh = *(const f32x4*)(a.shift + mo + cc);
            v[i] = v[i] * r * g * (sc + 1.0f) + sh;
            u32x2 w; w.x = pk2(v[i][0], v[i][1]); w.y = pk2(v[i][2], v[i][3]); *(u32x2*)(a.H + ro + cc) = w; }
        if (!a.has_small) continue;
        float keep0 = 0.f, keep1 = 0.f;
        for (int j = 0; j < NSM; ++j) { const float* wr = a.wsm + (size_t)j * D; float p = 0.f;
#pragma unroll
            for (int i = 0; i < 8; ++i) { const f32x4 w = *(const f32x4*)(wr + 4 * lane + 256 * i); p += (v[i][0] * w[0] + v[i][1] * w[1]) + (v[i][2] * w[2] + v[i][3] * w[3]); }
            p = wave_sum(p);
            if (j < 64) { if (lane == j) keep0 = p; } else { if (lane == j - 64) keep1 = p; } }
        a.baf[(size_t)m * NSM + lane] = keep0;
        if (lane < 16) a.baf[(size_t)m * NSM + 64 + lane] = keep1;
    }
}

__device__ __forceinline__ void ph_conv(const Ctx& c, const bf16* raw, const float* convw  , bf16* dnc) {
    int lane = c.lane; asm volatile("" : "+v"(lane));
    for (int gw = c.gw; gw < M * 64; gw += c.NW) {
        const int hv = gw & 63, m = gw >> 6, t = m % T, ch = hv * 128 + 2 * lane;
        const f32x4 w0 = *(const f32x4*)(convw + (size_t)ch * 4), w1 = *(const f32x4*)(convw + (size_t)ch * 4 + 4);
        float a0 = 0.f, a1 = 0.f;
#pragma unroll
        for (int j = 0; j < 4; ++j) { const int tt = t - 3 + j; if (tt >= 0) { const unsigned u = *(const unsigned*)(raw + (size_t)(m - 3 + j) * DN_CONV + ch); a0 += w0[j] * bf_lo(u); a1 += w1[j] * bf_hi(u); } }
        a0 = fsilu(a0); a1 = fsilu(a1);
        if (hv < 32) { const float ss = wave_sum(a0 * a0 + a1 * a1); float r = rsqrtf(ss + EPS); if (hv < 16) r *= 0.08838834764831845f; a0 *= r; a1 *= r; }
        *(unsigned*)(dnc + (size_t)m * DN_CONV + ch) = pk2(a0, a1);
    }
}
__device__ __forceinline__ float softplus_f(float x) { return fmaxf(x, 0.f) + log1pf(__expf(-fabsf(x))); }
__device__ __forceinline__ void ph_gates(const Ctx& c, const float* baf, const float* a_log, const float* dt_bias, const float* f_bias, float* beta, float* g, float* logf) {
    int lane = c.lane; asm volatile("" : "+v"(lane));
    for (int idx = c.gw * 64 + lane; idx < M * NSM; idx += c.NW * 64) {
        const int m = idx / NSM, j = idx % NSM; const float v = baf[idx];
        if (j < 32) beta[(size_t)m * 32 + j] = 1.0f / (1.0f + expf(-v));
        else if (j < 64) { const int h = j - 32; g[(size_t)m * 32 + h] = -expf(a_log[h]) * softplus_f(v + dt_bias[h]); }
        else { const int h = j - 64; logf[(size_t)m * 16 + h] = -softplus_f(-(v + f_bias[h])); } }
}
__device__ __forceinline__ void ph_fcum(const Ctx& c, const float* logf, float* fc) {
    int lane = c.lane; asm volatile("" : "+v"(lane));
    for (int bh = c.gw; bh < NB * FOXH; bh += c.NW) { const int b = bh / FOXH, h = bh % FOXH; float carry = 0.f;
        for (int t0 = 0; t0 < T; t0 += 64) { float v = logf[(size_t)(b * T + t0 + lane) * 16 + h];
#pragma unroll
            for (int o = 1; o < 64; o <<= 1) { const float u = __shfl_up(v, o); if (lane >= o) v += u; }
            v += carry; fc[(size_t)bh * T + t0 + lane] = v; carry = __shfl(v, 63); } }
}
__device__ __forceinline__ void ph_dn_naive(const Ctx& c, const bf16* dnc, const float* g, const float* beta, float* o) {
    int lane = c.lane; asm volatile("" : "+v"(lane));
    for (int gw = c.gw; gw < NB * 32 * 128; gw += c.NW) {
        const int j = gw & 127, hv = (gw >> 7) & 31, b = gw >> 12, hq = hv >> 1;
        float s0 = 0.f, s1 = 0.f;
#pragma unroll 4
        for (int t = 0; t < T; ++t) { const size_t m = (size_t)b * T + t; const bf16* row = dnc + m * DN_CONV;
            const unsigned qu = *(const unsigned*)(row + hq * 128 + 2 * lane), ku = *(const unsigned*)(row + 2048 + hq * 128 + 2 * lane);
            const float vv = bf2f(row[4096 + hv * 128 + j]), gg = g[m * 32 + hv], be = beta[m * 32 + hv];
            const float q0 = bf_lo(qu), q1 = bf_hi(qu), k0 = bf_lo(ku), k1 = bf_hi(ku), eg = __expf(gg);
            s0 *= eg; s1 *= eg;
            float dk = s0 * k0 + s1 * k1, dq = s0 * q0 + s1 * q1, kq = k0 * q0 + k1 * q1;
#pragma unroll
            for (int of = 1; of < 64; of <<= 1) { dk += __shfl_xor(dk, of); dq += __shfl_xor(dq, of); kq += __shfl_xor(kq, of); }
            const float cc = be * (vv - dk);
            s0 += cc * k0; s1 += cc * k1;
            if (lane == 0) o[m * 4096 + hv * 128 + j] = dq + cc * kq; }
    }
}
__device__ __forceinline__ void ph_dn_norm(const Ctx& c, const float* o, const float* norm_w, const bf16* zs, bf16* odn) {
    int lane = c.lane; asm volatile("" : "+v"(lane));
    for (int gw = c.gw; gw < M * 32; gw += c.NW) { const size_t off = (size_t)gw * 128 + 2 * lane;
        const float a0 = o[off], a1 = o[off + 1]; const float r = rsqrtf(wave_sum(a0 * a0 + a1 * a1) * (1.0f / 128.0f) + EPS);
        const unsigned zu = *(const unsigned*)(zs + off);
        *(unsigned*)(odn + off) = pk2(a0 * r * norm_w[2 * lane] * bf_lo(zu), a1 * r * norm_w[2 * lane + 1] * bf_hi(zu)); }
}
__device__ __forceinline__ void ph_fox_naive(const Ctx& c, const bf16* fqkv, const float* fc, bf16* ofox) {
    int lane = c.lane; asm volatile("" : "+v"(lane));
    for (int gw = c.gw; gw < NB * FOXH * T; gw += c.NW) {
        const int h = gw & 15, t = (T - 1) - ((gw >> 4) % T), b = gw / (16 * T);
        const size_t m = (size_t)b * T + t;
        const unsigned qu = *(const unsigned*)(fqkv + m * 6144 + h * 128 + 2 * lane);
        const float q0 = bf_lo(qu) * 0.08838834764831845f, q1 = bf_hi(qu) * 0.08838834764831845f;
        const float* fch = fc + (size_t)(b * FOXH + h) * T; const float ft = fch[t];
        float mx = -1e30f, l = 0.f, o0 = 0.f, o1 = 0.f;
#pragma unroll 4
        for (int s = 0; s <= t; ++s) { const bf16* row = fqkv + ((size_t)b * T + s) * 6144 + h * 128 + 2 * lane;
            const unsigned ku = *(const unsigned*)(row + 2048), vu = *(const unsigned*)(row + 4096);
            float d = q0 * bf_lo(ku) + q1 * bf_hi(ku);
#pragma unroll
            for (int of = 1; of < 64; of <<= 1) d += __shfl_xor(d, of);
            d += ft - fch[s];
            const float mn = fmaxf(mx, d), al = __expf(mx - mn), p = __expf(d - mn);
            l = l * al + p; o0 = o0 * al + p * bf_lo(vu); o1 = o1 * al + p * bf_hi(vu); mx = mn; }
        const float il = 1.0f / l;
        *(unsigned*)(ofox + m * 2048 + h * 128 + 2 * lane) = pk2(o0 * il, o1 * il);
    }
}

constexpr size_t al256(size_t x) { return (x + 255) & ~(size_t)255; }
constexpr size_t WS_CTL = 0, CTL_ZERO_BYTES = 1u << 20;
constexpr int CW_BAR = 4096;
constexpr size_t WS_WIN = CTL_ZERO_BYTES;
constexpr size_t WS_WBRDN = WS_WIN + al256((size_t)DEPTH * NBIG * D * 2);
constexpr size_t WS_WBRFOX = WS_WBRDN + al256((size_t)DEPTH * D * 4096 * 2);
constexpr size_t WS_WOUT = WS_WBRFOX + al256((size_t)DEPTH * D * D * 2);
constexpr size_t WS_WGU = WS_WOUT + al256((size_t)DEPTH * D * D * 2);
constexpr size_t WS_WDOWN = WS_WGU + al256((size_t)DEPTH * 2 * FF * D * 2);
constexpr size_t WS_WSM = WS_WDOWN + al256((size_t)DEPTH * D * FF * 2);
constexpr size_t WS_MOD = WS_WSM + al256((size_t)DEPTH * NSM * D * 4);
constexpr size_t WS_H = WS_MOD + al256((size_t)DEPTH * 2 * 6 * D * 4);
constexpr size_t WS_DNRAW = WS_H + al256((size_t)M * D * 2);
constexpr size_t WS_DNC = WS_DNRAW + al256((size_t)M * 8192 * 2);
constexpr size_t WS_ZS = WS_DNC + al256((size_t)M * 8192 * 2);
constexpr size_t WS_FQKV = WS_ZS + al256((size_t)M * 4096 * 2);
constexpr size_t WS_MG = WS_FQKV + al256((size_t)M * 6144 * 2);
constexpr size_t WS_BAF = WS_MG + al256((size_t)M * 4096 * 2);
constexpr size_t WS_BETA = WS_BAF + al256((size_t)M * NSM * 4);
constexpr size_t WS_GG = WS_BETA + al256((size_t)M * 32 * 4);
constexpr size_t WS_LOGF = WS_GG + al256((size_t)M * 32 * 4);
constexpr size_t WS_FC = WS_LOGF + al256((size_t)M * 16 * 4);
constexpr size_t WS_ODNRAW = WS_FC + al256((size_t)M * 16 * 4);
constexpr size_t WS_ODN = WS_ODNRAW + al256((size_t)M * 4096 * 4);
constexpr size_t WS_OFOX = WS_ODN + al256((size_t)M * 4096 * 2);
constexpr size_t WS_YDN = WS_OFOX + al256((size_t)M * 2048 * 2);
constexpr size_t WS_MM = WS_YDN + al256((size_t)M * D * 4);
constexpr size_t WS_Y = WS_MM + al256((size_t)M * D * 2);
constexpr size_t WS_HID = WS_Y + al256((size_t)M * D * 4);
constexpr size_t WS_END = WS_HID + al256((size_t)M * FF * 2);

constexpr int RING_BYTES = 131072;
constexpr int LDSCTL_OFF = RING_BYTES, MISC_OFF = LDSCTL_OFF + 320;
constexpr int LDS_BYTES = 147456;

struct Params { const float* in[17]; float* out; unsigned char* ws; };

__global__ void __launch_bounds__(512, 2) mega_fwd(Params p) {
    extern __shared__ __attribute__((aligned(16))) unsigned char lds_raw[];
    Ctx c; c.lds = (LAS unsigned char*)lds_raw; c.tid = threadIdx.x; c.lane = c.tid & 63; c.wave = __builtin_amdgcn_readfirstlane(c.tid >> 6);
    c.G = gridDim.x; c.gw = blockIdx.x * 8 + c.wave; c.NW = c.G * 8;
    for (int u = c.tid; u < (LDS_BYTES - LDSCTL_OFF) / 4; u += 512) ((LAS unsigned*)(c.lds + LDSCTL_OFF))[u] = 0u;
    __syncthreads();
    unsigned char* ws = p.ws;
    XcdBarrier bar = xcd_barrier_post((unsigned*)(ws + WS_CTL) + CW_BAR, (volatile LAS unsigned*)(c.lds + MISC_OFF) + 8);
#define GRID_BAR() xcd_barrier(bar)
#define PH_BEGIN unsigned char* wsl = ws; asm volatile("" : "+s"(wsl));
#define WSP(type, off) ((type*)(wsl + (off)))

    for (int l = 0; l < DEPTH; ++l) { PH_BEGIN
        ph_transpose(c, p.in[5] + (size_t)l * D * NIN, D, NIN, NBIG, WSP(bf16, WS_WIN) + (size_t)l * NBIG * D, 1);
        ph_transpose(c, p.in[11] + (size_t)l * 4096 * D, 4096, D, D, WSP(bf16, WS_WBRDN) + (size_t)l * D * 4096, 0);
        ph_transpose(c, p.in[12] + (size_t)l * D * D, D, D, D, WSP(bf16, WS_WBRFOX) + (size_t)l * D * D, 0);
        ph_transpose(c, p.in[13] + (size_t)l * D * D, D, D, D, WSP(bf16, WS_WOUT) + (size_t)l * D * D, 0);
        ph_transpose(c, p.in[14] + (size_t)l * D * FF, D, FF, FF, WSP(bf16, WS_WGU) + (size_t)l * 2 * FF * D, 2);
        ph_transpose(c, p.in[15] + (size_t)l * D * FF, D, FF, FF, WSP(bf16, WS_WGU) + (size_t)l * 2 * FF * D, 3);
        ph_transpose(c, p.in[16] + (size_t)l * FF * D, FF, D, D, WSP(bf16, WS_WDOWN) + (size_t)l * D * FF, 0);
    }
    { PH_BEGIN ph_wsmall(c, p.in[5], WSP(float, WS_WSM)); }
    __syncthreads();
    { PH_BEGIN ph_adaln(c, p.in[1], p.in[2], p.in[3], WSP(float, WS_MOD)); }
    GRID_BAR();
    { PH_BEGIN RowArgs a{}; a.xin = p.in[0]; a.x = p.out; a.gn = p.in[4]; a.scale = WSP(float, WS_MOD) + 1 * D; a.shift = WSP(float, WS_MOD); a.H = WSP(bf16, WS_H); a.wsm = WSP(float, WS_WSM); a.baf = WSP(float, WS_BAF);
      a.has_y = 0; a.has_h = 1; a.has_small = 1; ph_rowpass(c, a); }
    GRID_BAR();

    for (int l = 0; l < DEPTH; ++l) {
        { PH_BEGIN pg8::Gemm g{WSP(bf16, WS_H), WSP(bf16, WS_WIN) + (size_t)l * NBIG * D, M, NBIG, D, 0}; pg8::StaticOrder S; S.init(M, NBIG, c.G, (int)blockIdx.x);
          pg8::EpiInProj E{WSP(bf16, WS_DNRAW), WSP(bf16, WS_ZS), WSP(bf16, WS_FQKV), WSP(bf16, WS_MG)};
          pg8::gemm_phase<pg8::EpiInProj, pg8::StaticOrder, true, true>(c.lds, g, S, E); }
        GRID_BAR();
        { PH_BEGIN ph_conv(c, WSP(bf16, WS_DNRAW), p.in[6] + (size_t)l * 8192 * 4, WSP(bf16, WS_DNC)); }
        { PH_BEGIN ph_gates(c, WSP(float, WS_BAF), p.in[7] + l * 32, p.in[8] + l * 32, p.in[10] + l * 16, WSP(float, WS_BETA), WSP(float, WS_GG), WSP(float, WS_LOGF)); }
        GRID_BAR();
        { PH_BEGIN ph_fcum(c, WSP(float, WS_LOGF), WSP(float, WS_FC)); }
        GRID_BAR();
        { PH_BEGIN ph_dn_naive(c, WSP(bf16, WS_DNC), WSP(float, WS_GG), WSP(float, WS_BETA), WSP(float, WS_ODNRAW)); }
        { PH_BEGIN ph_fox_naive(c, WSP(bf16, WS_FQKV), WSP(float, WS_FC), WSP(bf16, WS_OFOX)); }
        GRID_BAR();
        { PH_BEGIN ph_dn_norm(c, WSP(float, WS_ODNRAW), p.in[9] + l * 128, WSP(bf16, WS_ZS), WSP(bf16, WS_ODN)); }
        GRID_BAR();
        { PH_BEGIN pg8::Gemm g{WSP(bf16, WS_ODN), WSP(bf16, WS_WBRDN) + (size_t)l * D * 4096, M, D, 4096, 0}; pg8::StaticOrder S; S.init(M, D, c.G, (int)blockIdx.x); pg8::EpiF32 E{WSP(float, WS_YDN), D, 0};
          pg8::gemm_phase<pg8::EpiF32, pg8::StaticOrder, true, true>(c.lds, g, S, E); }
        __syncthreads();
        { PH_BEGIN pg8::Gemm g{WSP(bf16, WS_OFOX), WSP(bf16, WS_WBRFOX) + (size_t)l * D * D, M, D, D, 0}; pg8::StaticOrder S; S.init(M, D, c.G, (int)blockIdx.x); pg8::EpiMerge E{WSP(float, WS_YDN), WSP(bf16, WS_MG), WSP(bf16, WS_MM)};
          pg8::gemm_phase<pg8::EpiMerge, pg8::StaticOrder, true, true>(c.lds, g, S, E); }
        GRID_BAR();
        { PH_BEGIN pg8::Gemm g{WSP(bf16, WS_MM), WSP(bf16, WS_WOUT) + (size_t)l * D * D, M, D, D, 0}; pg8::StaticOrder S; S.init(M, D, c.G, (int)blockIdx.x); pg8::EpiF32 E{WSP(float, WS_Y), D, 0};
          pg8::gemm_phase<pg8::EpiF32, pg8::StaticOrder, true, true>(c.lds, g, S, E); }
        GRID_BAR();
        { PH_BEGIN const float* mod = WSP(float, WS_MOD) + (size_t)l * 2 * 6 * D; const float* gl = p.in[4] + (size_t)l * 4 * D;
          RowArgs a{}; a.xin = p.out; a.x = p.out; a.Y = WSP(float, WS_Y); a.gy = gl + 1 * D; a.gate = mod + 2 * D; a.gn = gl + 2 * D; a.scale = mod + 4 * D; a.shift = mod + 3 * D; a.H = WSP(bf16, WS_H); a.has_y = 1; a.has_h = 1; a.has_small = 0;
          ph_rowpass(c, a); }
        GRID_BAR();
        { PH_BEGIN pg8::Gemm g{WSP(bf16, WS_H), WSP(bf16, WS_WGU) + (size_t)l * 2 * FF * D, M, 2 * FF, D, 0}; pg8::StaticOrder S; S.init(M, 2 * FF, c.G, (int)blockIdx.x); pg8::EpiSwiGLU E{WSP(bf16, WS_HID), FF, 0};
          pg8::gemm_phase<pg8::EpiSwiGLU, pg8::StaticOrder, true, true>(c.lds, g, S, E); }
        GRID_BAR();
        { PH_BEGIN pg8::Gemm g{WSP(bf16, WS_HID), WSP(bf16, WS_WDOWN) + (size_t)l * D * FF, M, D, FF, 0}; pg8::StaticOrder S; S.init(M, D, c.G, (int)blockIdx.x); pg8::EpiF32 E{WSP(float, WS_Y), D, 0};
          pg8::gemm_phase<pg8::EpiF32, pg8::StaticOrder, true, true>(c.lds, g, S, E); }
        GRID_BAR();
        { PH_BEGIN const float* mod = WSP(float, WS_MOD) + (size_t)l * 2 * 6 * D; const float* gl = p.in[4] + (size_t)l * 4 * D;
          RowArgs a{}; a.xin = p.out; a.x = p.out; a.Y = WSP(float, WS_Y); a.gy = gl + 3 * D; a.gate = mod + 5 * D; a.has_y = 1;
          if (l + 1 < DEPTH) { const float* mod2 = mod + 2 * 6 * D; const float* gl2 = gl + 4 * D;
              a.gn = gl2; a.scale = mod2 + 1 * D; a.shift = mod2; a.H = WSP(bf16, WS_H); a.wsm = WSP(float, WS_WSM) + (size_t)(l + 1) * NSM * D; a.baf = WSP(float, WS_BAF); a.has_h = 1; a.has_small = 1; }
          ph_rowpass(c, a); }
        if (l + 1 < DEPTH) GRID_BAR();
    }
#undef PH_BEGIN
#undef WSP
#undef GRID_BAR
}

extern "C" void kernel_launch(void* const* d_in, const int* in_sizes, int n_in, void* d_out, int out_size, void* d_ws, size_t ws_size, hipStream_t stream) {
    static int grid = 0;
    if (grid == 0) {
        if (n_in != 17 || out_size != M * D || ws_size < WS_END) { fprintf(stderr, "kernel_launch: bad shapes / workspace (need %zu, have %zu)\n", (size_t)WS_END, ws_size); grid = -1; return; }
        int dev = 0, cus = 0, per_cu = 0;
        if (hipGetDevice(&dev) != hipSuccess || hipDeviceGetAttribute(&cus, hipDeviceAttributeMultiprocessorCount, dev) != hipSuccess) { grid = -1; return; }
        if (hipFuncSetAttribute((const void*)mega_fwd, hipFuncAttributeMaxDynamicSharedMemorySize, LDS_BYTES) != hipSuccess) { fprintf(stderr, "kernel_launch: hipFuncSetAttribute failed\n"); grid = -1; return; }
        if (hipOccupancyMaxActiveBlocksPerMultiprocessor(&per_cu, (const void*)mega_fwd, 512, LDS_BYTES) != hipSuccess || per_cu < 1) { fprintf(stderr, "kernel_launch: occupancy query reports %d workgroups per CU\n", per_cu); }
        (void)hipGetLastError();
        grid = cus;
    }
    if (grid < 0) return;
    if (hipMemsetAsync((char*)d_ws + WS_CTL, 0, CTL_ZERO_BYTES, stream) != hipSuccess) return;
    Params p{};
    for (int i = 0; i < 17; ++i) p.in[i] = (const float*)d_in[i];
    p.out = (float*)d_out; p.ws = (unsigned char*)d_ws;
    hipLaunchKernelGGL(mega_fwd, dim3(grid), dim3(512), LDS_BYTES, stream, p);
}
```

```cpp
#include <hip/hip_runtime.h>
#include <cstdio>
#include <cstdint>

constexpr int D = 2048, NB = 2, T = 4096, M = NB * T, DEPTH = 4;
constexpr int HD = 128, DN_VH = 32, DN_CONV = 8192;
constexpr int FOXH = 16;
constexpr int FF = 5632;
constexpr int NIN = 22608;
constexpr int SRC_B = 12288, SRC_A = 12320, SRC_FQKV = 12352, SRC_F = 18496, SRC_MERGE = 18512;
constexpr int NBIG = 22528;
constexpr int NSM = 80;
constexpr float EPS = 1e-6f;

typedef unsigned short bf16;
typedef float f32x4 __attribute__((ext_vector_type(4)));
typedef unsigned u32x4 __attribute__((ext_vector_type(4)));
typedef unsigned u32x2 __attribute__((ext_vector_type(2)));
#define LAS __attribute__((address_space(3)))

__device__ __forceinline__ float bf_lo(unsigned w) { return __uint_as_float(w << 16); }
__device__ __forceinline__ float bf_hi(unsigned w) { return __uint_as_float(w & 0xffff0000u); }
__device__ __forceinline__ float bf2f(bf16 h) { return __uint_as_float(((unsigned)h) << 16); }
__device__ __forceinline__ unsigned f2bf(float f) { unsigned u = __float_as_uint(f); return (u + 0x7fffu + ((u >> 16) & 1u)) >> 16; }
__device__ __forceinline__ unsigned pk2(float lo, float hi) { return f2bf(lo) | (f2bf(hi) << 16); }
__device__ __forceinline__ float fsigmoid(float x) { return __builtin_amdgcn_rcpf(1.0f + __expf(-x)); }
__device__ __forceinline__ float fsilu(float x) { return x * fsigmoid(x); }
__device__ __forceinline__ float wave_sum(float v) {
#pragma unroll
    for (int o = 1; o < 64; o <<= 1) v += __shfl_xor(v, o);
    return v;
}
namespace pg8 {
#define PG8_LAS __attribute__((address_space(3)))
typedef unsigned short bf16_t;
typedef short bf16x8 __attribute__((ext_vector_type(8)));
typedef float f32x4 __attribute__((ext_vector_type(4)));
typedef unsigned u32x4 __attribute__((ext_vector_type(4)));
constexpr int BM = 256, BK = 64, HALF = 128, HTB = HALF * BK * 2  , STAGE_BYTES = 8 * HTB, NXCD = 8, WGM = 8;

__host__ __device__ __forceinline__ int lds_byte(int r, int c) { const int st = (r >> 4) * 2 + (c >> 5), rr = r & 15, cc = c & 31, ob = rr * 64 + cc * 2; return st * 1024 + (ob ^ (((ob >> 9) & 1) << 5)); }
__host__ __device__ __forceinline__ void stage_rc(int b, int& R, int& C) { const int st = b / 1024, sb = b % 1024, swz = sb ^ (((sb >> 9) & 1) << 5); R = (st >> 1) * 16 + swz / 64; C = (st & 1) * 32 + (swz % 64) / 2; }
__host__ __device__ __forceinline__ int perm32(int rho) { const int n = rho >> 4, i = rho & 15; return 8 * (i >> 2) + 4 * n + (i & 3); }

struct Unit { int pm, pn; };
struct Gemm { const bf16_t* A; const bf16_t* Bt; int M, N, K, pad; };

struct StaticOrder {
    int nM, nN, nwg, G, c;
    __host__ __device__ void init(int M, int N, int G_, int c_) { nM = M / BM; nN = N / BM; nwg = nM * nN; G = G_; c = c_; }
    __host__ __device__ bool next(int i, Unit& u) const {
        const long L = (long)i * G + c; if (L >= nwg) return false;
        int wgid = (int)L; { const int q = nwg / NXCD, r = nwg % NXCD, xcd = wgid % NXCD, off = wgid / NXCD; wgid = (xcd < r ? xcd * (q + 1) : r * (q + 1) + (xcd - r) * q) + off; }
        const int nig = WGM * nN, gid = wgid / nig, fm = gid * WGM, gsz = (nM - fm) < WGM ? (nM - fm) : WGM;
        u.pm = fm + ((wgid % nig) % gsz); u.pn = (wgid % nig) / gsz; return true;
    }
    __device__ __forceinline__ void a_ready(const Unit&) const {}
    __device__ __forceinline__ void done(const Unit&) const {}
};

__device__ __forceinline__ unsigned cvt_pk_bf16(float lo, float hi) { unsigned r; asm volatile("v_cvt_pk_bf16_f32 %0, %1, %2" : "=v"(r) : "v"(lo), "v"(hi)); return r; }
__device__ __forceinline__ float e_sigmoid(float x) { return __builtin_amdgcn_rcpf(1.0f + __expf(-x)); }

struct EpiF32 {
    static constexpr bool PERM = false, AFTER_DRAIN = false;
    float* C; int ldc, pad;
    __device__ __forceinline__ void operator()(const f32x4 (&acc)[2][2][4][2], const Unit& u, int wr, int wc, int fr, int fq) const {
        const int row0 = u.pm * BM + wr * 64 + fr, col0 = u.pn * BM + wc * 32 + 4 * fq;
#pragma unroll
        for (int ai = 0; ai < 2; ++ai)
#pragma unroll
            for (int m = 0; m < 4; ++m) { float* rowp = C + (size_t)(row0 + ai * HALF + m * 16) * ldc + col0;
#pragma unroll
                for (int bj = 0; bj < 2; ++bj)
#pragma unroll
                    for (int n = 0; n < 2; ++n) *(f32x4*)(rowp + bj * HALF + n * 16) = acc[ai][bj][m][n]; }
    }
};
struct EpiInProj {
    static constexpr bool PERM = true, AFTER_DRAIN = false;
    bf16_t *dnraw, *z, *fqkv, *mg;
    __device__ __forceinline__ void operator()(const f32x4 (&acc)[2][2][4][2], const Unit& u, int wr, int wc, int fr, int fq) const {
        const int pn = u.pn; bf16_t* base; int ldc, colt, act;
        if (pn < 32) { base = dnraw; ldc = 8192; colt = pn * BM; act = 0; }
        else if (pn < 48) { base = z; ldc = 4096; colt = (pn - 32) * BM; act = 1; }
        else if (pn < 72) { base = fqkv; ldc = 6144; colt = (pn - 48) * BM; act = 0; }
        else { base = mg; ldc = 4096; colt = (pn - 72) * BM; act = 2; }
        const int row0 = u.pm * BM + wr * 64 + fr, col0 = colt + wc * 32 + 8 * fq;
#pragma unroll
        for (int ai = 0; ai < 2; ++ai)
#pragma unroll
            for (int m = 0; m < 4; ++m) { bf16_t* rowp = base + (size_t)(row0 + ai * HALF + m * 16) * ldc + col0;
#pragma unroll
                for (int bj = 0; bj < 2; ++bj) { f32x4 v0 = acc[ai][bj][m][0], v1 = acc[ai][bj][m][1];
                    if (act == 1) {
#pragma unroll
                        for (int j = 0; j < 4; ++j) { v0[j] = v0[j] * e_sigmoid(v0[j]); v1[j] = v1[j] * e_sigmoid(v1[j]); } }
                    if (act == 2) {
#pragma unroll
                        for (int j = 0; j < 4; ++j) { v0[j] = e_sigmoid(v0[j]); v1[j] = e_sigmoid(v1[j]); } }
                    u32x4 w; w.x = cvt_pk_bf16(v0[0], v0[1]); w.y = cvt_pk_bf16(v0[2], v0[3]); w.z = cvt_pk_bf16(v1[0], v1[1]); w.w = cvt_pk_bf16(v1[2], v1[3]);
                    *(u32x4*)(rowp + bj * HALF) = w; } }
    }
};
struct EpiMerge {
    static constexpr bool PERM = true, AFTER_DRAIN = false;
    const float* ydn; const bf16_t* mg; bf16_t* mm;
    __device__ __forceinline__ void operator()(const f32x4 (&acc)[2][2][4][2], const Unit& u, int wr, int wc, int fr, int fq) const {
        const int row0 = u.pm * BM + wr * 64 + fr, col0 = u.pn * BM + wc * 32 + 8 * fq;
#pragma unroll
        for (int ai = 0; ai < 2; ++ai)
#pragma unroll
            for (int m = 0; m < 4; ++m) { const size_t row = (size_t)(row0 + ai * HALF + m * 16);
#pragma unroll
                for (int bj = 0; bj < 2; ++bj) { const int col = col0 + bj * HALF;
                    const f32x4 y0 = *(const f32x4*)(ydn + row * 2048 + col), y1 = *(const f32x4*)(ydn + row * 2048 + col + 4);
                    const u32x4 gd = *(const u32x4*)(mg + row * 4096 + col), gf = *(const u32x4*)(mg + row * 4096 + 2048 + col);
                    const f32x4 a0 = acc[ai][bj][m][0], a1 = acc[ai][bj][m][1];
                    float o[8];
                    o[0] = __uint_as_float(gd.x << 16) * y0[0] + __uint_as_float(gf.x << 16) * a0[0];
                    o[1] = __uint_as_float(gd.x & 0xffff0000u) * y0[1] + __uint_as_float(gf.x & 0xffff0000u) * a0[1];
                    o[2] = __uint_as_float(gd.y << 16) * y0[2] + __uint_as_float(gf.y << 16) * a0[2];
                    o[3] = __uint_as_float(gd.y & 0xffff0000u) * y0[3] + __uint_as_float(gf.y & 0xffff0000u) * a0[3];
                    o[4] = __uint_as_float(gd.z << 16) * y1[0] + __uint_as_float(gf.z << 16) * a1[0];
                    o[5] = __uint_as_float(gd.z & 0xffff0000u) * y1[1] + __uint_as_float(gf.z & 0xffff0000u) * a1[1];
                    o[6] = __uint_as_float(gd.w << 16) * y1[2] + __uint_as_float(gf.w << 16) * a1[2];
                    o[7] = __uint_as_float(gd.w & 0xffff0000u) * y1[3] + __uint_as_float(gf.w & 0xffff0000u) * a1[3];
                    u32x4 w; w.x = cvt_pk_bf16(o[0], o[1]); w.y = cvt_pk_bf16(o[2], o[3]); w.z = cvt_pk_bf16(o[4], o[5]); w.w = cvt_pk_bf16(o[6], o[7]);
                    *(u32x4*)(mm + row * 2048 + col) = w; } }
    }
};
struct EpiSwiGLU {
    static constexpr bool PERM = true, AFTER_DRAIN = false;
    bf16_t* hid; int ldc, pad;
    __device__ __forceinline__ void operator()(const f32x4 (&acc)[2][2][4][2], const Unit& u, int wr, int wc, int fr, int fq) const {
        const int row0 = u.pm * BM + wr * 64 + fr, col0 = u.pn * HALF + wc * 32 + 8 * fq;
#pragma unroll
        for (int ai = 0; ai < 2; ++ai)
#pragma unroll
            for (int m = 0; m < 4; ++m) { bf16_t* rowp = hid + (size_t)(row0 + ai * HALF + m * 16) * ldc + col0;
                const f32x4 g0 = acc[ai][0][m][0], g1 = acc[ai][0][m][1], u0 = acc[ai][1][m][0], u1 = acc[ai][1][m][1];
                float o[8];
#pragma unroll
                for (int j = 0; j < 4; ++j) { o[j] = g0[j] * e_sigmoid(g0[j]) * u0[j]; o[4 + j] = g1[j] * e_sigmoid(g1[j]) * u1[j]; }
                u32x4 w; w.x = cvt_pk_bf16(o[0], o[1]); w.y = cvt_pk_bf16(o[2], o[3]); w.z = cvt_pk_bf16(o[4], o[5]); w.w = cvt_pk_bf16(o[6], o[7]);
                *(u32x4*)rowp = w; }
    }
};

template <class Epi, class Sched, bool ALIGN_EPI = false, bool SP2 = false>
__device__ __forceinline__ void gemm_phase(PG8_LAS unsigned char* lds, const Gemm g, const Sched& S, const Epi& E) {
    int tid_ = threadIdx.x; asm volatile("" : "+v"(tid_)); const int tid = tid_, wid = __builtin_amdgcn_readfirstlane(tid >> 6), lane = tid & 63, wr = wid >> 2, wc = wid & 3, fr = lane & 15, fq = lane >> 4;
    const int K = g.K, nt = K / BK;
    unsigned voffA[2], voffB[2];
#pragma unroll
    for (int i = 0; i < 2; ++i) { int R, C; stage_rc(tid * 16 + i * 8192, R, C); const int Rb = Epi::PERM ? ((R & ~31) + perm32(R & 31)) : R;
        voffA[i] = (unsigned)(R * K + C) * 2u; voffB[i] = (unsigned)(Rb * K + C) * 2u; }
    const size_t kstep = (size_t)(BK * 2);
    const size_t hstep = (size_t)HALF * K * 2;
    const size_t tstep = 2 * hstep;
    const unsigned ldsw = (unsigned)wid * 1024u;
    const int aoff = lds_byte(wr * 64 + fr, fq * 8), boff = lds_byte(wc * 32 + fr, fq * 8);
#define PG8_SA(b, h) (((b) * 2 + (h)) * HTB)
#define PG8_SB(b, h) ((4 + (b) * 2 + (h)) * HTB)
#define PG8_STAGE(bufoff, gbase, voff) do { _Pragma("unroll") for (int _i = 0; _i < 2; ++_i) \
        __builtin_amdgcn_global_load_lds((const unsigned*)((const char*)(gbase) + (voff)[_i]), (PG8_LAS unsigned*)(lds + (bufoff) + ldsw + _i * 8192), 16, 0, 0); } while (0)
#define PG8_LDA(dst, b, h) do { _Pragma("unroll") for (int m = 0; m < 4; ++m) _Pragma("unroll") for (int k = 0; k < 2; ++k) dst[m][k] = *(const PG8_LAS bf16x8*)(lds + PG8_SA(b, h) + aoff + m * 2048 + k * 1024); } while (0)
#define PG8_LDB(dst, b, h) do { _Pragma("unroll") for (int n = 0; n < 2; ++n) _Pragma("unroll") for (int k = 0; k < 2; ++k) dst[n][k] = *(const PG8_LAS bf16x8*)(lds + PG8_SB(b, h) + boff + n * 2048 + k * 1024); } while (0)
#define PG8_MMA(ai, bj, At, Bt) do { __builtin_amdgcn_s_setprio(1); _Pragma("unroll") for (int m = 0; m < 4; ++m) _Pragma("unroll") for (int n = 0; n < 2; ++n) _Pragma("unroll") for (int k = 0; k < 2; ++k) \
        acc[ai][bj][m][n] = __builtin_amdgcn_mfma_f32_16x16x32_bf16(Bt[n][k], At[m][k], acc[ai][bj][m][n], 0, 0, 0); __builtin_amdgcn_s_setprio(0); } while (0)
#define PG8_WAIT_V(n) asm volatile("s_waitcnt vmcnt(" #n ")" ::: "memory")
#define PG8_WAIT_L(n) asm volatile("s_waitcnt lgkmcnt(" #n ")" ::: "memory")
#define PG8_BAR __builtin_amdgcn_s_barrier()
#define PG8_SCHED __builtin_amdgcn_sched_barrier(0)
    Unit cur, nxt; int ui = 0;
    if (!S.next(0, cur)) return;
    f32x4 acc[2][2][4][2];
#pragma unroll
    for (int a = 0; a < 2; ++a)
#pragma unroll
        for (int b = 0; b < 2; ++b)
#pragma unroll
            for (int m = 0; m < 4; ++m)
#pragma unroll
                for (int n = 0; n < 2; ++n) acc[a][b][m][n] = (f32x4){0.f, 0.f, 0.f, 0.f};
    bf16x8 At[4][2], B0[2][2], B1[2][2];
    const char* cA = (const char*)g.A + (size_t)cur.pm * tstep; const char* cB = (const char*)g.Bt + (size_t)cur.pn * tstep;
    S.a_ready(cur);
    if constexpr (SP2) {
        PG8_STAGE(PG8_SB(0, 0), cB, voffB); PG8_STAGE(PG8_SB(0, 1), cB + hstep, voffB); PG8_STAGE(PG8_SA(0, 0), cA, voffA); PG8_STAGE(PG8_SA(0, 1), cA + hstep, voffA);
        if (wr == 1) PG8_BAR;
        PG8_WAIT_V(2); PG8_BAR;
        PG8_STAGE(PG8_SB(1, 0), cB + kstep, voffB); PG8_STAGE(PG8_SA(1, 0), cA + kstep, voffA); PG8_STAGE(PG8_SB(1, 1), cB + hstep + kstep, voffB);
        PG8_WAIT_V(6); PG8_BAR;
    } else {
        PG8_STAGE(PG8_SB(0, 0), cB, voffB); PG8_STAGE(PG8_SA(0, 0), cA, voffA); PG8_STAGE(PG8_SB(0, 1), cB + hstep, voffB); PG8_STAGE(PG8_SA(0, 1), cA + hstep, voffA);
        if (wr == 1) PG8_BAR;
        PG8_WAIT_V(4); PG8_BAR;
        PG8_STAGE(PG8_SB(1, 0), cB + kstep, voffB); PG8_STAGE(PG8_SA(1, 0), cA + kstep, voffA); PG8_STAGE(PG8_SB(1, 1), cB + hstep + kstep, voffB);
        PG8_WAIT_V(6); PG8_BAR;
    }
    for (;;) {
        const bool has_next = S.next(ui + 1, nxt);
        const char* nA = has_next ? (const char*)g.A + (size_t)nxt.pm * tstep : cA; const char* nB = has_next ? (const char*)g.Bt + (size_t)nxt.pn * tstep : cB;
        for (int t = 0; t < nt; t += 2) {
            const bool last = (t == nt - 2);
            const char* a1 = cA + (size_t)(t + 1) * kstep;
            const char* a2 = last ? nA : cA + (size_t)(t + 2) * kstep; const char* b2 = last ? nB : cB + (size_t)(t + 2) * kstep;
            const char* a3 = a2 + kstep; const char* b3 = b2 + kstep;
            if (last && has_next) S.a_ready(nxt);
            if constexpr (SP2) {
            PG8_LDB(B0, 0, 0); PG8_LDB(B1, 0, 1); PG8_SCHED; PG8_LDA(At, 0, 0); PG8_STAGE(PG8_SA(1, 1), a1 + hstep, voffA);
            PG8_WAIT_V(8); PG8_WAIT_L(0); PG8_BAR; PG8_MMA(0, 0, At, B0); PG8_MMA(0, 1, At, B1); PG8_BAR; PG8_SCHED;
            PG8_LDA(At, 0, 1); PG8_STAGE(PG8_SB(0, 0), b2, voffB); PG8_STAGE(PG8_SB(0, 1), b2 + hstep, voffB); PG8_STAGE(PG8_SA(0, 0), a2, voffA);
            PG8_WAIT_V(8); PG8_WAIT_L(0); PG8_BAR; PG8_MMA(1, 0, At, B0); PG8_MMA(1, 1, At, B1); PG8_BAR; PG8_SCHED;
            PG8_LDB(B0, 1, 0); PG8_LDB(B1, 1, 1); PG8_SCHED; PG8_LDA(At, 1, 0); PG8_STAGE(PG8_SA(0, 1), a2 + hstep, voffA);
            PG8_WAIT_V(8); PG8_WAIT_L(0); PG8_BAR; PG8_MMA(0, 0, At, B0); PG8_MMA(0, 1, At, B1); PG8_BAR; PG8_SCHED;
            PG8_LDA(At, 1, 1); PG8_STAGE(PG8_SB(1, 0), b3, voffB); PG8_STAGE(PG8_SB(1, 1), b3 + hstep, voffB); PG8_STAGE(PG8_SA(1, 0), a3, voffA);
            PG8_WAIT_V(8); PG8_WAIT_L(0); PG8_BAR; PG8_MMA(1, 0, At, B0); PG8_MMA(1, 1, At, B1); PG8_BAR; PG8_SCHED;
            } else {
            PG8_LDB(B0, 0, 0); PG8_SCHED; PG8_LDA(At, 0, 0); PG8_STAGE(PG8_SA(1, 1), a1 + hstep, voffA);
            PG8_WAIT_L(8); PG8_BAR; PG8_WAIT_L(0); PG8_MMA(0, 0, At, B0); PG8_BAR; PG8_SCHED;
            PG8_LDB(B1, 0, 1); PG8_STAGE(PG8_SB(0, 0), b2, voffB);
            PG8_BAR; PG8_WAIT_L(0); PG8_MMA(0, 1, At, B1); PG8_BAR;
            PG8_LDA(At, 0, 1); PG8_STAGE(PG8_SA(0, 0), a2, voffA);
            PG8_BAR; PG8_WAIT_L(0); PG8_MMA(1, 0, At, B0); PG8_BAR; PG8_SCHED;
            PG8_STAGE(PG8_SB(0, 1), b2 + hstep, voffB);
            PG8_WAIT_V(6); PG8_BAR; PG8_MMA(1, 1, At, B1); PG8_BAR;
            PG8_LDB(B0, 1, 0); PG8_SCHED; PG8_LDA(At, 1, 0); PG8_STAGE(PG8_SA(0, 1), a2 + hstep, voffA);
            PG8_WAIT_L(8); PG8_BAR; PG8_WAIT_L(0); PG8_MMA(0, 0, At, B0); PG8_BAR; PG8_SCHED;
            PG8_LDB(B1, 1, 1); PG8_STAGE(PG8_SB(1, 0), b3, voffB);
            PG8_BAR; PG8_WAIT_L(0); PG8_MMA(0, 1, At, B1); PG8_BAR;
            PG8_LDA(At, 1, 1); PG8_STAGE(PG8_SA(1, 0), a3, voffA);
            PG8_BAR; PG8_WAIT_L(0); PG8_MMA(1, 0, At, B0); PG8_BAR; PG8_SCHED;
            PG8_STAGE(PG8_SB(1, 1), b3 + hstep, voffB);
            PG8_WAIT_V(6); PG8_BAR; PG8_MMA(1, 1, At, B1); PG8_BAR;
            }
        }
        if constexpr (ALIGN_EPI) { if (wr == 0) PG8_BAR; }
        if constexpr (!Epi::AFTER_DRAIN) { E(acc, cur, wr, wc, fr, fq); S.done(cur); }
        if (!has_next) break;
#pragma unroll
        for (int a = 0; a < 2; ++a)
#pragma unroll
            for (int b = 0; b < 2; ++b)
#pragma unroll
                for (int m = 0; m < 4; ++m)
#pragma unroll
                    for (int n = 0; n < 2; ++n) acc[a][b][m][n] = (f32x4){0.f, 0.f, 0.f, 0.f};
        cur = nxt; cA = nA; cB = nB; ++ui;
        if constexpr (ALIGN_EPI) { if (wr == 1) PG8_BAR; }
    }
    PG8_WAIT_V(0);
    if constexpr (!ALIGN_EPI) { if (wr == 0) PG8_BAR; }
    PG8_BAR;
    if constexpr (Epi::AFTER_DRAIN) { E.fused(acc, cur, wr, wc, fr, fq, lds, wid, lane); S.done(cur); }
#undef PG8_SA
#undef PG8_SB
#undef PG8_STAGE
#undef PG8_LDA
#undef PG8_LDB
#undef PG8_MMA
#undef PG8_WAIT_V
#undef PG8_WAIT_L
#undef PG8_BAR
#undef PG8_SCHED
}
}
#define XB_TMO      128
#define XB_XCNT(j)  (256  + 64 * (j))
#define XB_XSUB(j)  (1280 + 64 * (j))
#define XB_XGEN(j)  (2304 + 64 * (j))
#define XB_TOP      3328
#define XB_TOPGEN   3392
#define XCD_BAR_WORDS 3456
#define XB_SPIN_CAP (1u << 21)


__device__ __forceinline__ unsigned xb_ld(unsigned* p)              { return __hip_atomic_load(p, __ATOMIC_RELAXED, __HIP_MEMORY_SCOPE_AGENT); }
__device__ __forceinline__ unsigned xb_add(unsigned* p, unsigned v) { return __hip_atomic_fetch_add(p, v, __ATOMIC_RELAXED, __HIP_MEMORY_SCOPE_AGENT); }
__device__ __forceinline__ unsigned xb_xcc_id() { return (unsigned)__builtin_amdgcn_s_getreg((3 << 11) | 20) & 0xFu; }
#define XB_SPIN(cond, bar) do { unsigned _sp = 0; while (cond) { __builtin_amdgcn_s_sleep(1); \
    if ((++_sp & 255u) == 0u) { if (xb_ld(&(bar)[XB_TMO])) break; if (_sp > XB_SPIN_CAP) { atomicAdd(&(bar)[XB_TMO], 1u); break; } } } } while (0)

struct XcdBarrier {
    unsigned* bar; unsigned x;
    volatile LAS unsigned* st;
};

__device__ __forceinline__ XcdBarrier xcd_barrier_post(unsigned* bar, volatile LAS unsigned* st) {
    XcdBarrier b; b.bar = bar; b.x = xb_xcc_id(); b.st = st;
    if (threadIdx.x == 0) (void)xb_add(&bar[XB_XCNT(b.x)], 1u);
    return b;
}
__device__ __forceinline__ void xcd_barrier_complete(unsigned* bar, unsigned x, unsigned& nloc, unsigned& nx) {
    const unsigned G = gridDim.x * gridDim.y * gridDim.z;
    unsigned sum, cnt, mine, sp = 0u;
    for (;;) {
        sum = 0u; cnt = 0u; mine = 0u;
#pragma unroll
        for (unsigned j = 0; j < 16; ++j) { const unsigned c = xb_ld(&bar[XB_XCNT(j)]); sum += c; cnt += (c > 0u) ? 1u : 0u; mine = (j == x) ? c : mine; }
        if (sum == G) break;
        __builtin_amdgcn_s_sleep(1);
        if ((++sp & 255u) == 0u) { if (xb_ld(&bar[XB_TMO])) break; if (sp > XB_SPIN_CAP) { atomicAdd(&bar[XB_TMO], 1u); break; } }
    }
    nloc = mine > 0u ? mine : 1u; nx = cnt > 0u ? cnt : 1u;
}

__device__ __forceinline__ void xcd_barrier(const XcdBarrier& b) {
    asm volatile("s_waitcnt vmcnt(0)" ::: "memory");
    __syncthreads();
    if (threadIdx.x == 0) {
        unsigned* bar = b.bar;
        __builtin_amdgcn_s_waitcnt(0);
        unsigned nloc = b.st[0], nx = b.st[1];
        if (nloc == 0u) { xcd_barrier_complete(bar, b.x, nloc, nx); b.st[0] = nloc; b.st[1] = nx; }
        const unsigned old = xb_add(&bar[XB_XSUB(b.x)], 1u);
        const unsigned gen = old / nloc;
        if (old + 1u == (gen + 1u) * nloc) {
            __builtin_amdgcn_fence(__ATOMIC_RELEASE, "agent");
            asm volatile("s_waitcnt vmcnt(0)" ::: "memory");
            const unsigned og = xb_add(&bar[XB_TOP], 1u);
            const unsigned tg = og / nx;
            if (og + 1u == (tg + 1u) * nx) xb_add(&bar[XB_TOPGEN], 1u);
            else XB_SPIN(xb_ld(&bar[XB_TOPGEN]) == tg, bar);
            __builtin_amdgcn_fence(__ATOMIC_ACQUIRE, "agent");
            xb_add(&bar[XB_XGEN(b.x)], 1u);
            asm volatile("s_waitcnt vmcnt(0)" ::: "memory");
        } else {
            XB_SPIN(xb_ld(&bar[XB_XGEN(b.x)]) == gen, bar);
            __builtin_amdgcn_fence(__ATOMIC_ACQUIRE, "agent");
            asm volatile("s_waitcnt vmcnt(0)" ::: "memory");
        }
    }
    __syncthreads();
}

namespace fox {
constexpr int D = 128, QP = 6144, KVP = 6144, OP = 2048;
constexpr float THR = 8.f;
constexpr bool WSKIP = false;
using bf16 = unsigned short;
constexpr float SCALE = 0.08838834764831845f;
constexpr int NW = 8, QBLK = 32, KVBLK = 64, QB = NW * QBLK;
constexpr int SHM_V = KVBLK * D * 2, SHM_K = KVBLK * D * 2;
constexpr int BIAS_OFF = 2 * SHM_V + 2 * SHM_K + NW * 64 * 4;
constexpr int LDS_BYTES = BIAS_OFF + 4096 * 4;

typedef short bf16x8 __attribute__((ext_vector_type(8)));
typedef short s16x4 __attribute__((ext_vector_type(4)));
typedef float f32x16 __attribute__((ext_vector_type(16)));
typedef float f32x4 __attribute__((ext_vector_type(4)));
typedef unsigned u32x4 __attribute__((ext_vector_type(4)));
template <class A, class Bt> struct same_t { static constexpr bool v = false; };
template <class A> struct same_t<A, A> { static constexpr bool v = true; };

#define KSWZ(row, colB) ((row) * 256 + ((colB) ^ (((row) & 7) << 4)))
#define SBAR() __builtin_amdgcn_sched_barrier(0)
__device__ __forceinline__ int v_st(int k, int c) { const int kk = (k & ~0xC) | ((k & 4) << 1) | ((k & 8) >> 1); return ((kk >> 3) * 4 + (c >> 5)) * 512 + ((kk & 7) * 32 + (c & 31)) * 2; }
__device__ __forceinline__ int v_rd_base(int lane) { return ((lane & 3) << 3) | (((lane >> 2) & 3) << 6) | (((lane >> 4) & 1) << 5) | (((lane >> 5) & 1) << 8); }
constexpr int v_rd_off(int d0, int ks, int half) { return d0 * 512 + ks * 4096 + half * 2048; }
__device__ __forceinline__ int crow(int r, int hi) { return (r & 3) + 8 * (r >> 2) + 4 * hi; }
__device__ __forceinline__ unsigned cvtpk(float lo, float hi) {
    unsigned r; asm volatile("v_cvt_pk_bf16_f32 %0, %1, %2" : "=v"(r) : "v"(lo), "v"(hi)); return r;
}
__device__ __forceinline__ bf16x8 pack8(f32x4 a, f32x4 b) {
    u32x4 w = {cvtpk(a[0], a[1]), cvtpk(a[2], a[3]), cvtpk(b[0], b[1]), cvtpk(b[2], b[3])};
    return *reinterpret_cast<bf16x8*>(&w);
}
template <class T> __device__ __forceinline__ bf16x8 load8(const T* p) {
    if constexpr (same_t<T, float>::v) { return pack8(*(const f32x4*)p, *(const f32x4*)(p + 4)); }
    else { return *reinterpret_cast<const bf16x8*>(p); }
}
__device__ __forceinline__ void mask_tile(f32x16& p0, f32x16& p1, int dq, unsigned W) {
    const float NEG = -__builtin_inff();
#pragma unroll
    for (int r = 0; r < 16; ++r) {
        const int c = (r & 3) + 8 * (r >> 2);
        if ((unsigned)(dq - c) >= W) p0[r] = NEG;
        if ((unsigned)(dq - c - 32) >= W) p1[r] = NEG;
    }
}
__device__ __forceinline__ void partialSM(f32x16& p0, f32x16& p1, float& m_reg, float& mn, float& alpha) {
    float pmax = p0[0]; for (int r = 1; r < 16; ++r) pmax = fmaxf(pmax, p0[r]); for (int r = 0; r < 16; ++r) pmax = fmaxf(pmax, p1[r]);
    { auto rr = __builtin_amdgcn_permlane32_swap(__float_as_uint(pmax), __float_as_uint(pmax), false, false);
      pmax = fmaxf(__uint_as_float(rr[0]), __uint_as_float(rr[1])); }
    constexpr float C2 = 1.4426950408889634f * SCALE;
    if (__builtin_expect(__all((pmax - m_reg) * SCALE <= THR), 1)) { mn = m_reg; alpha = 1.f; }
    else { mn = fmaxf(m_reg, pmax); alpha = __builtin_amdgcn_exp2f((m_reg - mn) * C2); m_reg = mn; }
    const float mnL = -mn * C2;
    for (int r = 0; r < 16; ++r) p0[r] = fmaf(p0[r], C2, mnL); for (int r = 0; r < 16; ++r) p1[r] = fmaf(p1[r], C2, mnL);
    for (int r = 0; r < 16; ++r) p0[r] = __builtin_amdgcn_exp2f(p0[r]);
}
__device__ __forceinline__ void finishSM(f32x16& p0, f32x16& p1, float alpha, float& l_reg, bf16x8& pa0, bf16x8& pa1, bf16x8& pa2, bf16x8& pa3) {
    for (int r = 0; r < 16; ++r) p1[r] = __builtin_amdgcn_exp2f(p1[r]);
    float ps = 0; for (int r = 0; r < 16; ++r) ps += p0[r]; for (int r = 0; r < 16; ++r) ps += p1[r];
    { auto rr = __builtin_amdgcn_permlane32_swap(__float_as_uint(ps), __float_as_uint(ps), false, false);
      ps = __uint_as_float(rr[0]) + __uint_as_float(rr[1]); }
    l_reg = l_reg * alpha + ps;
#define PK4(P, B_, OUT) do { unsigned a0 = cvtpk(P[B_+0], P[B_+1]), a1 = cvtpk(P[B_+2], P[B_+3]);                          \
        unsigned b0 = cvtpk(P[B_+4], P[B_+5]), b1 = cvtpk(P[B_+6], P[B_+7]);                                             \
        auto r0 = __builtin_amdgcn_permlane32_swap(a0, b0, false, false); auto r1 = __builtin_amdgcn_permlane32_swap(a1, b1, false, false); \
        u32x4 w = {r0[0], r1[0], r0[1], r1[1]}; OUT = *reinterpret_cast<bf16x8*>(&w); } while (0)
    PK4(p0, 0, pa0); PK4(p0, 8, pa1); PK4(p1, 0, pa2); PK4(p1, 8, pa3);
#undef PK4
}
template <int KB, bool SK>
__device__ __forceinline__ void qkt(f32x16& p0, f32x16& p1, const char* K_lds, int r32, int hi, const bf16x8* qr, bool act, const float* bl  ) {
    if (SK && !act) { const float NEG = -__builtin_inff();
#pragma unroll
        for (int r = 0; r < 16; ++r) { p0[r] = NEG; p1[r] = NEG; } return; }
    { const f32x4 a0 = *(const f32x4*)(bl), a1 = *(const f32x4*)(bl + 8), a2 = *(const f32x4*)(bl + 16), a3 = *(const f32x4*)(bl + 24);
      const f32x4 c0 = *(const f32x4*)(bl + 32), c1 = *(const f32x4*)(bl + 40), c2 = *(const f32x4*)(bl + 48), c3 = *(const f32x4*)(bl + 56);
      p0 = (f32x16){a0[0], a0[1], a0[2], a0[3], a1[0], a1[1], a1[2], a1[3], a2[0], a2[1], a2[2], a2[3], a3[0], a3[1], a3[2], a3[3]};
      p1 = (f32x16){c0[0], c0[1], c0[2], c0[3], c1[0], c1[1], c1[2], c1[3], c2[0], c2[1], c2[2], c2[3], c3[0], c3[1], c3[2], c3[3]}; }
    const char* kb[4];
#pragma unroll
    for (int dd = 0; dd < 4; ++dd) kb[dd] = K_lds + KB * SHM_K + KSWZ(r32, (dd * 16 + hi * 8) * 2);
#pragma unroll
    for (int d0 = 0; d0 < 8; ++d0) { const char* a = kb[d0 & 3] + (d0 >> 2) * 128;
        bf16x8 b0 = *reinterpret_cast<const bf16x8*>(a);
        bf16x8 b1 = *reinterpret_cast<const bf16x8*>(a + 32 * 256);
        p0 = __builtin_amdgcn_mfma_f32_32x32x16_bf16(b0, qr[d0], p0, 0, 0, 0);
        p1 = __builtin_amdgcn_mfma_f32_32x32x16_bf16(b1, qr[d0], p1, 0, 0, 0); }
}
template <int VB, bool SK>
__device__ __forceinline__ void pv_tile(f32x16* o, int vb0, bf16x8 pa0, bf16x8 pa1, bf16x8 pa2, bf16x8 pa3, bool act) {
    if (SK && !act) return;
#define TRRD(dst, off) asm volatile("ds_read_b64_tr_b16 %0, %1 offset:%2" : "=&v"(dst) : "v"(vb0), "i"(off) : "memory")
#define PV_D0(d0) do { s16x4 l0, l1, l2, l3, h0, h1, h2, h3; constexpr int b_ = VB * SHM_V + v_rd_off(d0, 0, 0);     \
        TRRD(l0, b_); TRRD(h0, b_ + 2048); TRRD(l1, b_ + 4096); TRRD(h1, b_ + 6144); TRRD(l2, b_ + 8192); TRRD(h2, b_ + 10240); TRRD(l3, b_ + 12288); TRRD(h3, b_ + 14336); \
        asm volatile("s_waitcnt lgkmcnt(0)" ::: "memory"); SBAR();                 \
        o[d0] = __builtin_amdgcn_mfma_f32_32x32x16_bf16(pa0, (bf16x8){l0[0], l0[1], l0[2], l0[3], h0[0], h0[1], h0[2], h0[3]}, o[d0], 0, 0, 0);   \
        o[d0] = __builtin_amdgcn_mfma_f32_32x32x16_bf16(pa1, (bf16x8){l1[0], l1[1], l1[2], l1[3], h1[0], h1[1], h1[2], h1[3]}, o[d0], 0, 0, 0);   \
        o[d0] = __builtin_amdgcn_mfma_f32_32x32x16_bf16(pa2, (bf16x8){l2[0], l2[1], l2[2], l2[3], h2[0], h2[1], h2[2], h2[3]}, o[d0], 0, 0, 0);   \
        o[d0] = __builtin_amdgcn_mfma_f32_32x32x16_bf16(pa3, (bf16x8){l3[0], l3[1], l3[2], l3[3], h3[0], h3[1], h3[2], h3[3]}, o[d0], 0, 0, 0); } while (0)
    PV_D0(0); PV_D0(1); PV_D0(2); PV_D0(3);
#undef PV_D0
#undef TRRD
}

template <class TIn, class TOut> struct BlockRef { const TIn* Q; const TIn* K; const TIn* V; TOut* O; int P0; };
template <class TIn> struct Seam {
    bf16x8 qr[8];
    bf16x8 st_k0, st_k1;
};
__device__ __forceinline__ int swa_jlo(int P0, int W) { const int lowk = P0 - W + 1; return lowk > 0 ? lowk / KVBLK : 0; }
#define ROW(p, k0, rr) ((p) + (unsigned)(((k0) + (rr)) * KVP + sc))
#define VMW() asm volatile("s_waitcnt vmcnt(0)" ::: "memory")
#define VMWN(n) asm volatile("s_waitcnt vmcnt(%0)" :: "i"(n) : "memory")
#define SLOAD_F(p, k0) do { S.st_k0 = load8<TIn>(ROW(p, k0, sr)); S.st_k1 = load8<TIn>(ROW(p, k0, 32 + sr)); } while (0)
#define SWRITE_KF(bf) do { *(bf16x8*)(K_lds + (bf) * SHM_K + kws) = S.st_k0; *(bf16x8*)(K_lds + (bf) * SHM_K + kws + 32 * 256) = S.st_k1; } while (0)
#define SWRITE_VF(bf) do { *(bf16x8*)(V_lds + (bf) * SHM_V + vst0) = S.st_k0; *(bf16x8*)(V_lds + (bf) * SHM_V + vst1) = S.st_k1; } while (0)
template <class TIn, class TOut>
__device__ __forceinline__ void causal_swa_prime(const BlockRef<TIn, TOut>& cur, int W, char* lds, Seam<TIn>& S) {
    int tid_ = threadIdx.x; asm volatile("" : "+v"(tid_));
    const int tid = tid_, wid = __builtin_amdgcn_readfirstlane(tid >> 6), lane = tid & 63, r32 = lane & 31, hi = lane >> 5;
    const int sr = tid >> 4, sc = (tid & 15) * 8, kws = KSWZ(sr, sc * 2); char* K_lds = lds + 2 * SHM_V;
    const int kb0 = swa_jlo(cur.P0, W) * KVBLK;
    for (int d0 = 0; d0 < 8; ++d0) S.qr[d0] = load8<TIn>(cur.Q + (unsigned)((wid * QBLK + r32) * QP + hi * 8) + d0 * 16);
    SLOAD_F(cur.K, kb0); VMW(); SWRITE_KF(0); SBAR(); SLOAD_F(cur.V, kb0);
    __syncthreads();
}
template <class TIn, class TOut>
__device__ __forceinline__ void causal_swa_block(const BlockRef<TIn, TOut>& cur, const BlockRef<TIn, TOut>& nxt, int skv, int W, char* lds, Seam<TIn>& S) {
    int tid_ = threadIdx.x; asm volatile("" : "+v"(tid_));
    const int tid = tid_, wid = __builtin_amdgcn_readfirstlane(tid >> 6), lane = tid & 63, r32 = lane & 31, hi = lane >> 5;
    const int j_lo = swa_jlo(cur.P0, W);
    int j_hi = (cur.P0 + QB - 1) / KVBLK + 1; if (j_hi > skv / KVBLK) j_hi = skv / KVBLK;
    const int NT = j_hi - j_lo;
    const int kbn = swa_jlo(nxt.P0, W) * KVBLK;
    const int qlo = cur.P0 + wid * QBLK, qm = qlo + r32 - 4 * hi;
    char* V_lds = lds; char* K_lds = lds + 2 * SHM_V;
    float* ws = (float*)(lds + 2 * SHM_V + 2 * SHM_K) + wid * 64; float* li_l = ws, * al_l = ws + 32;
    float m_reg = -1e30f, l_reg = 0; f32x16 o[4] = {};
    const int sr = tid >> 4, sc = (tid & 15) * 8, vst0 = v_st(sr, sc), vst1 = v_st(32 + sr, sc), kws = KSWZ(sr, sc * 2);
    const int vb0 = (int)(uintptr_t)V_lds + v_rd_base(lane);
    const TIn* Kh = cur.K; const TIn* Vh = cur.V;
    const float* btab = (const float*)(lds + BIAS_OFF) + 4 * hi;
#define RESC(a) do { if (__any((a) < 1.f)) { if (hi == 0) al_l[r32] = (a); asm volatile("s_waitcnt lgkmcnt(0)" ::: "memory");              \
                     for (int d_ = 0; d_ < 4; ++d_) for (int r = 0; r < 16; ++r) o[d_][r] *= al_l[crow(r, hi)]; } } while (0)
#define KBASE(t) ((j_lo + (t)) * KVBLK)
#define ACT(t) (KBASE(t) <= qlo + QBLK - 1 && KBASE(t) + KVBLK - 1 >= qlo - W + 1)
#define MASKT(P0_, P1_, t) do { const int kb_ = KBASE(t); if ((!SK || ACT(t)) && (kb_ + KVBLK - 1 > qlo || kb_ <= qlo + QBLK - 1 - W)) mask_tile(P0_, P1_, qm - kb_, (unsigned)W); } while (0)
    constexpr int NQL = 8;
    constexpr bool SK = WSKIP;
#define SEAM_K0() do { VMWN(NQL); SWRITE_KF(0); SBAR(); SLOAD_F(nxt.V, kbn); SBAR(); } while (0)
    f32x16 pA0, pA1, pB0, pB1; float mnA, mnB, alA, alB; bf16x8 pa0, pa1, pa2, pa3;
    VMW(); SWRITE_VF(0); SBAR();
    if (NT > 1) { SLOAD_F(Kh, KBASE(1)); }
    SBAR(); qkt<0, SK>(pA0, pA1, K_lds, r32, hi, S.qr, ACT(0), btab + KBASE(0));
    if (NT > 1) { VMW(); SWRITE_KF(1); SBAR(); SLOAD_F(Vh, KBASE(1)); }
    MASKT(pA0, pA1, 0); partialSM(pA0, pA1, m_reg, mnA, alA);
    if (NT > 1) { VMW(); SWRITE_VF(1); SBAR(); if (NT > 2) SLOAD_F(Kh, KBASE(2)); }
    __syncthreads();
#define HALF_STEP(PX0, PX1, mnX, alX, PY0, PY1, alY, t, KB, VB, SB) do {                                                      \
        SBAR(); qkt<KB, SK>(PX0, PX1, K_lds, r32, hi, S.qr, ACT(t), btab + KBASE(t));                                             \
        finishSM(PY0, PY1, alY, l_reg, pa0, pa1, pa2, pa3); SBAR();                                                           \
        if ((t) + 1 < NT) { VMW(); SWRITE_KF(SB); SBAR(); SLOAD_F(Vh, KBASE((t) + 1)); SBAR(); }                              \
        pv_tile<VB, SK>(o, vb0, pa0, pa1, pa2, pa3, ACT((t) - 1)); MASKT(PX0, PX1, (t)); partialSM(PX0, PX1, m_reg, mnX, alX);                                        \
        __syncthreads();                                                                                                      \
        if ((t) + 1 < NT) { VMW(); SWRITE_VF(SB); SBAR(); if ((t) + 2 < NT) SLOAD_F(Kh, KBASE((t) + 2)); }                    \
        RESC(alX); __syncthreads(); } while (0)
    for (int t = 1; t + 1 < NT; t += 2) {
        HALF_STEP(pB0, pB1, mnB, alB, pA0, pA1, alA, t, 1, 0, 0);
        HALF_STEP(pA0, pA1, mnA, alA, pB0, pB1, alB, t + 1, 0, 1, 1);
    }
    const bool even = (NT & 1) == 0;
    if (even) { SBAR(); qkt<1, SK>(pB0, pB1, K_lds, r32, hi, S.qr, ACT(NT - 1), btab + KBASE(NT - 1)); SBAR(); }
    SLOAD_F(nxt.K, kbn); SBAR();
#pragma unroll
    for (int d0 = 0; d0 < 8; ++d0) S.qr[d0] = load8<TIn>(nxt.Q + (unsigned)((wid * QBLK + r32) * QP + hi * 8) + d0 * 16);
    SBAR();
    finishSM(pA0, pA1, alA, l_reg, pa0, pa1, pa2, pa3); SBAR();
    pv_tile<0, SK>(o, vb0, pa0, pa1, pa2, pa3, ACT(even ? NT - 2 : NT - 1));
    if (even) { MASKT(pB0, pB1, NT - 1); partialSM(pB0, pB1, m_reg, mnB, alB); __syncthreads(); RESC(alB);
        finishSM(pB0, pB1, alB, l_reg, pa0, pa1, pa2, pa3); SBAR(); pv_tile<1, SK>(o, vb0, pa0, pa1, pa2, pa3, ACT(NT - 1)); }
    SBAR(); SEAM_K0();
    if (hi == 0) li_l[r32] = l_reg; asm volatile("s_waitcnt lgkmcnt(0)" ::: "memory");
    float rli[16];
#pragma unroll
    for (int r = 0; r < 16; ++r) rli[r] = __builtin_amdgcn_rcpf(li_l[crow(r, hi)]);
    TOut* Ow = cur.O + (unsigned)(wid * QBLK * OP);
#pragma unroll
    for (int r = 0; r < 16; ++r) { const int orow = crow(r, hi);
#pragma unroll
        for (int d0 = 0; d0 < 4; ++d0) { const float v = o[d0][r] * rli[r];
            if constexpr (same_t<TOut, float>::v) { Ow[(unsigned)(orow * OP + d0 * 32 + r32)] = v; }
            else { const float vn = __shfl_xor(v, 1);
                   if ((r32 & 1) == 0) *(unsigned*)(Ow + (unsigned)(orow * OP + d0 * 32 + r32)) = cvtpk(v, vn); } } }
    __syncthreads();
#undef RESC
#undef KBASE
#undef ACT
#undef MASKT
#undef SEAM_K0
#undef HALF_STEP
}
#undef ROW
#undef VMW
#undef VMWN
#undef SLOAD_F
#undef SWRITE_KF
#undef SWRITE_VF
__device__ __forceinline__ BlockRef<bf16, bf16> fox_ref(int L, int pass, const bf16* FQKV, bf16* OFOX) {
    const int bh = L >> 3, x = L & 7, qb = pass ? 15 - x : x, b = bh >> 4, h = bh & 15;
    BlockRef<bf16, bf16> r; const size_t row0 = (size_t)b * 4096;
    r.Q = FQKV + (row0 + (size_t)qb * QB) * QP + h * 128; r.K = FQKV + row0 * KVP + 2048 + h * 128; r.V = FQKV + row0 * KVP + 4096 + h * 128;
    r.O = OFOX + (row0 + (size_t)qb * QB) * OP + h * 128; r.P0 = qb * QB; return r;
}
__device__ __forceinline__ void fox_phase(char* lds, int vcu, int G, const bf16* FQKV, bf16* OFOX, const float* FB) {
    constexpr int total = 256, SKV_ = 4096, W = 4096;
    for (int L = vcu; L < total; L += G) {
        __syncthreads();
        { int tid = threadIdx.x; asm volatile("" : "+v"(tid));
          const float* fb = FB + (size_t)(L >> 3) * 4096 + tid * 8; float* tb = (float*)(lds + BIAS_OFF) + tid * 8;
          const f32x4 v0 = *(const f32x4*)fb, v1 = *(const f32x4*)(fb + 4); *(f32x4*)tb = v0; *(f32x4*)(tb + 4) = v1; }
        BlockRef<bf16, bf16> cur = fox_ref(L, 0, FQKV, OFOX); const BlockRef<bf16, bf16> b1 = fox_ref(L, 1, FQKV, OFOX);
        Seam<bf16> S;
        causal_swa_prime<bf16, bf16>(cur, W, lds, S);
        for (int pass = 0; pass < 2; ++pass) {
            causal_swa_block<bf16, bf16>(cur, b1, SKV_, W, lds, S);
            cur = b1; }
    }
}
}

struct Ctx { LAS unsigned char* lds; int wave, gw, NW, G; };

__device__ __forceinline__ void transpose_item(const float* W, int ldw, int k0, int c0, bf16* WT, int K, int r0, LAS float* scr, int lane) {
#pragma unroll 8
    for (int i = 0; i < 32; ++i) { const int kk = 2 * i + (lane >> 5); scr[kk * 33 + (lane & 31)] = W[(size_t)(k0 + kk) * ldw + c0 + (lane & 31)]; }
    asm volatile("s_waitcnt lgkmcnt(0)" ::: "memory");
    const int c = lane & 7;
#pragma unroll
    for (int j = 0; j < 4; ++j) { const int n = (lane >> 3) + 8 * j; const LAS float* s = scr + (8 * c) * 33 + n;
        u32x4 o; o.x = pk2(s[0 * 33], s[1 * 33]); o.y = pk2(s[2 * 33], s[3 * 33]); o.z = pk2(s[4 * 33], s[5 * 33]); o.w = pk2(s[6 * 33], s[7 * 33]);
        *(u32x4*)(WT + (size_t)(r0 + n) * K + k0 + 8 * c) = o; }
    asm volatile("s_waitcnt lgkmcnt(0)" ::: "memory");
}
__device__ __forceinline__ void map_rows(int mode, int nb, int& c0, int& r0) {
    const int n0 = nb * 32;
    if (mode == 0) { c0 = n0; r0 = n0; }
    else if (mode == 1) { r0 = n0; c0 = n0 < 12288 ? n0 : (n0 < 18432 ? SRC_FQKV + (n0 - 12288) : SRC_MERGE + (n0 - 18432)); }
    else { c0 = n0; r0 = (n0 >> 7) * 256 + (n0 & 127) + (mode == 3 ? 128 : 0); }
}
__device__ __forceinline__ void ph_transpose(const Ctx& c, const float* W, int K, int ldw, int ncols, bf16* WT, int mode) {
    LAS float* scr = (LAS float*)(c.lds + c.wave * 16384); int lane = threadIdx.x & 63; asm volatile("" : "+v"(lane));
    const int nblk = ncols / 32, nitems = (K / 64) * nblk;
    for (int it = c.gw; it < nitems; it += c.NW) { const int kb = it / nblk, nb = it % nblk; int c0, r0; map_rows(mode, nb, c0, r0);
        transpose_item(W, ldw, kb * 64, c0, WT, K, r0, scr, lane); }
}
__device__ __forceinline__ void ph_wsmall(const Ctx& c, const float* w_in, float* wsm) {
    int lane = threadIdx.x & 63; asm volatile("" : "+v"(lane));
    for (int idx = c.gw * 64 + lane; idx < DEPTH * D * NSM; idx += c.NW * 64) {
        const int j = idx % NSM, k = (idx / NSM) % D, l = idx / (NSM * D);
        const int sc = j < 32 ? SRC_B + j : (j < 64 ? SRC_A + (j - 32) : SRC_F + (j - 64));
        wsm[((size_t)l * NSM + j) * D + k] = w_in[((size_t)l * D + k) * NIN + sc]; }
}
__device__ __forceinline__ void ph_adaln(const Ctx& c, const float* cin, const float* w_ada, const float* b_ada, float* mod) {
    LAS float* cond = (LAS float*)c.lds;
    LAS float* red = (LAS float*)(c.lds + 16384);
    int tid = threadIdx.x; asm volatile("" : "+v"(tid)); const int lane = tid & 63;
    for (int i = tid; i < 2 * D; i += 512) cond[i] = fsilu(cin[i]);
    __syncthreads();
    const int ntask = DEPTH * (6 * D / 64);
    for (int task = blockIdx.x; task < ntask; task += c.G) {
        const int l = task / (6 * D / 64), n = (task % (6 * D / 64)) * 64 + lane;
        const float* w = w_ada + (size_t)l * D * (6 * D) + n; float a0 = 0.f, a1 = 0.f;
#pragma unroll 8
        for (int k = c.wave * 256; k < c.wave * 256 + 256; ++k) { const float wv = w[(size_t)k * (6 * D)]; a0 += cond[k] * wv; a1 += cond[D + k] * wv; }
        red[(c.wave * 2 + 0) * 64 + lane] = a0; red[(c.wave * 2 + 1) * 64 + lane] = a1;
        __syncthreads();
        if (tid < 128) { const int b = tid >> 6; float s = b_ada[(size_t)l * 6 * D + n];
#pragma unroll
            for (int w8 = 0; w8 < 8; ++w8) s += red[(w8 * 2 + b) * 64 + lane];
            mod[((size_t)l * 2 + b) * (6 * D) + n] = s; }
        __syncthreads();
    }
}

struct RowArgs { const float* xin; float* x; const float* Y; const float* gy; const float* gate; const float* gn; const float* scale; const float* shift; bf16* H; const float* wsm; float* baf; int has_y, has_h, has_small; };
__device__ __forceinline__ void ph_rowpass(const Ctx& c, const RowArgs& a) {
    int lane = threadIdx.x & 63; asm volatile("" : "+v"(lane));
    for (int m = c.gw; m < M; m += c.NW) {
        const int b = m / T; const size_t ro = (size_t)m * D; const int mo = b * 6 * D;
        f32x4 v[8];
#pragma unroll
        for (int i = 0; i < 8; ++i) v[i] = *(const f32x4*)(a.xin + ro + 4 * lane + 256 * i);
        if (a.has_y) {
            f32x4 y[8]; float ss = 0.f;
#pragma unroll
            for (int i = 0; i < 8; ++i) { y[i] = *(const f32x4*)(a.Y + ro + 4 * lane + 256 * i); ss += (y[i][0] * y[i][0] + y[i][1] * y[i][1]) + (y[i][2] * y[i][2] + y[i][3] * y[i][3]); }
            const float r = rsqrtf(wave_sum(ss) * (1.0f / D) + EPS);
#pragma unroll
            for (int i = 0; i < 8; ++i) { const int cc = 4 * lane + 256 * i; const f32x4 g = *(const f32x4*)(a.gy + cc), gt = *(const f32x4*)(a.gate + mo + cc);
                v[i] = v[i] + gt * (y[i] * r * g); }
        }
#pragma unroll
        for (int i = 0; i < 8; ++i) *(f32x4*)(a.x + ro + 4 * lane + 256 * i) = v[i];
        if (!a.has_h) continue;
        float ss = 0.f;
#pragma unroll
        for (int i = 0; i < 8; ++i) ss += (v[i][0] * v[i][0] + v[i][1] * v[i][1]) + (v[i][2] * v[i][2] + v[i][3] * v[i][3]);
        const float r = rsqrtf(wave_sum(ss) * (1.0f / D) + EPS);
#pragma unroll
        for (int i = 0; i < 8; ++i) { const int cc = 4 * lane + 256 * i; const f32x4 g = *(const f32x4*)(a.gn + cc), sc = *(const f32x4*)(a.scale + mo + cc), sh = *(const f32x4*)(a.shift + mo + cc);
            v[i] = v[i] * r * g * (sc + 1.0f) + sh;
            u32x2 w; w.x = pk2(v[i][0], v[i][1]); w.y = pk2(v[i][2], v[i][3]); *(u32x2*)(a.H + ro + cc) = w; }
        if (!a.has_small) continue;
        float keep0 = 0.f, keep1 = 0.f;
        for (int j = 0; j < NSM; ++j) { const float* wr = a.wsm + (size_t)j * D; float p = 0.f;
#pragma unroll
            for (int i = 0; i < 8; ++i) { const f32x4 w = *(const f32x4*)(wr + 4 * lane + 256 * i); p += (v[i][0] * w[0] + v[i][1] * w[1]) + (v[i][2] * w[2] + v[i][3] * w[3]); }
            p = wave_sum(p);
            if (j < 64) { if (lane == j) keep0 = p; } else { if (lane == j - 64) keep1 = p; } }
        a.baf[(size_t)m * NSM + lane] = keep0;
        if (lane < 16) a.baf[(size_t)m * NSM + 64 + lane] = keep1;
    }
}

__device__ __forceinline__ void ph_conv(const Ctx& c, const bf16* raw, const float* convw  , bf16* dnc) {
    int lane = threadIdx.x & 63; asm volatile("" : "+v"(lane));
    for (int gw = c.gw; gw < M * 64; gw += c.NW) {
        const int hv = gw & 63, m = gw >> 6, t = m % T, ch = hv * 128 + 2 * lane;
        const f32x4 w0 = *(const f32x4*)(convw + (size_t)ch * 4), w1 = *(const f32x4*)(convw + (size_t)ch * 4 + 4);
        float a0 = 0.f, a1 = 0.f;
#pragma unroll
        for (int j = 0; j < 4; ++j) { const int tt = t - 3 + j; if (tt >= 0) { const unsigned u = *(const unsigned*)(raw + (size_t)(m - 3 + j) * DN_CONV + ch); a0 += w0[j] * bf_lo(u); a1 += w1[j] * bf_hi(u); } }
        a0 = fsilu(a0); a1 = fsilu(a1);
        if (hv < 32) { const float ss = wave_sum(a0 * a0 + a1 * a1); float r = rsqrtf(ss + EPS); if (hv < 16) r *= 0.08838834764831845f; a0 *= r; a1 *= r; }
        *(unsigned*)(dnc + (size_t)m * DN_CONV + ch) = pk2(a0, a1);
    }
}
__device__ __forceinline__ float softplus_f(float x) { return fmaxf(x, 0.f) + log1pf(__expf(-fabsf(x))); }
__device__ __forceinline__ void ph_gates(const Ctx& c, const float* baf, const float* a_log, const float* dt_bias, const float* f_bias, float* beta, float* g, float* logf) {
    int lane = threadIdx.x & 63; asm volatile("" : "+v"(lane));
    for (int idx = c.gw * 64 + lane; idx < M * NSM; idx += c.NW * 64) {
        const int m = idx / NSM, j = idx % NSM; const float v = baf[idx];
        if (j < 32) beta[(size_t)m * 32 + j] = 1.0f / (1.0f + expf(-v));
        else if (j < 64) { const int h = j - 32; g[(size_t)m * 32 + h] = -expf(a_log[h]) * softplus_f(v + dt_bias[h]); }
        else { const int h = j - 64; logf[(size_t)m * 16 + h] = -softplus_f(-(v + f_bias[h])); } }
}
__device__ __forceinline__ void ph_fcum(const Ctx& c, const float* logf, float* fc) {
    int lane = threadIdx.x & 63; asm volatile("" : "+v"(lane));
    for (int bh = c.gw; bh < NB * FOXH; bh += c.NW) { const int b = bh / FOXH, h = bh % FOXH; float carry = 0.f;
        for (int t0 = 0; t0 < T; t0 += 64) { float v = logf[(size_t)(b * T + t0 + lane) * 16 + h];
#pragma unroll
            for (int o = 1; o < 64; o <<= 1) { const float u = __shfl_up(v, o); if (lane >= o) v += u; }
            v += carry; fc[(size_t)bh * T + t0 + lane] = v * (-11.313708498984761f); carry = __shfl(v, 63); } }
}
__device__ __forceinline__ void ph_dn_naive(const Ctx& c, const bf16* dnc, const float* g, const float* beta, float* o) {
    int lane = threadIdx.x & 63; asm volatile("" : "+v"(lane));
    for (int gw = c.gw; gw < NB * 32 * 128; gw += c.NW) {
        const int j = gw & 127, hv = (gw >> 7) & 31, b = gw >> 12, hq = hv >> 1;
        float s0 = 0.f, s1 = 0.f;
#pragma unroll 4
        for (int t = 0; t < T; ++t) { const size_t m = (size_t)b * T + t; const bf16* row = dnc + m * DN_CONV;
            const unsigned qu = *(const unsigned*)(row + hq * 128 + 2 * lane), ku = *(const unsigned*)(row + 2048 + hq * 128 + 2 * lane);
            const float vv = bf2f(row[4096 + hv * 128 + j]), gg = g[m * 32 + hv], be = beta[m * 32 + hv];
            const float q0 = bf_lo(qu), q1 = bf_hi(qu), k0 = bf_lo(ku), k1 = bf_hi(ku), eg = __expf(gg);
            s0 *= eg; s1 *= eg;
            float dk = s0 * k0 + s1 * k1, dq = s0 * q0 + s1 * q1, kq = k0 * q0 + k1 * q1;
#pragma unroll
            for (int of = 1; of < 64; of <<= 1) { dk += __shfl_xor(dk, of); dq += __shfl_xor(dq, of); kq += __shfl_xor(kq, of); }
            const float cc = be * (vv - dk);
            s0 += cc * k0; s1 += cc * k1;
            if (lane == 0) o[m * 4096 + hv * 128 + j] = dq + cc * kq; }
    }
}
__device__ __forceinline__ void ph_dn_norm(const Ctx& c, const float* o, const float* norm_w, const bf16* zs, bf16* odn) {
    int lane = threadIdx.x & 63; asm volatile("" : "+v"(lane));
    for (int gw = c.gw; gw < M * 32; gw += c.NW) { const size_t off = (size_t)gw * 128 + 2 * lane;
        const float a0 = o[off], a1 = o[off + 1]; const float r = rsqrtf(wave_sum(a0 * a0 + a1 * a1) * (1.0f / 128.0f) + EPS);
        const unsigned zu = *(const unsigned*)(zs + off);
        *(unsigned*)(odn + off) = pk2(a0 * r * norm_w[2 * lane] * bf_lo(zu), a1 * r * norm_w[2 * lane + 1] * bf_hi(zu)); }
}

constexpr size_t al256(size_t x) { return (x + 255) & ~(size_t)255; }
constexpr size_t WS_CTL = 0, CTL_ZERO_BYTES = 1u << 20;
constexpr int CW_BAR = 4096;
constexpr size_t WS_WIN = CTL_ZERO_BYTES;
constexpr size_t WS_WBRDN = WS_WIN + al256((size_t)DEPTH * NBIG * D * 2);
constexpr size_t WS_WBRFOX = WS_WBRDN + al256((size_t)DEPTH * D * 4096 * 2);
constexpr size_t WS_WOUT = WS_WBRFOX + al256((size_t)DEPTH * D * D * 2);
constexpr size_t WS_WGU = WS_WOUT + al256((size_t)DEPTH * D * D * 2);
constexpr size_t WS_WDOWN = WS_WGU + al256((size_t)DEPTH * 2 * FF * D * 2);
constexpr size_t WS_WSM = WS_WDOWN + al256((size_t)DEPTH * D * FF * 2);
constexpr size_t WS_MOD = WS_WSM + al256((size_t)DEPTH * NSM * D * 4);
constexpr size_t WS_H = WS_MOD + al256((size_t)DEPTH * 2 * 6 * D * 4);
constexpr size_t WS_DNRAW = WS_H + al256((size_t)M * D * 2);
constexpr size_t WS_DNC = WS_DNRAW + al256((size_t)M * 8192 * 2);
constexpr size_t WS_ZS = WS_DNC + al256((size_t)M * 8192 * 2);
constexpr size_t WS_FQKV = WS_ZS + al256((size_t)M * 4096 * 2);
constexpr size_t WS_MG = WS_FQKV + al256((size_t)M * 6144 * 2);
constexpr size_t WS_BAF = WS_MG + al256((size_t)M * 4096 * 2);
constexpr size_t WS_BETA = WS_BAF + al256((size_t)M * NSM * 4);
constexpr size_t WS_GG = WS_BETA + al256((size_t)M * 32 * 4);
constexpr size_t WS_LOGF = WS_GG + al256((size_t)M * 32 * 4);
constexpr size_t WS_FC = WS_LOGF + al256((size_t)M * 16 * 4);
constexpr size_t WS_ODNRAW = WS_FC + al256((size_t)M * 16 * 4);
constexpr size_t WS_ODN = WS_ODNRAW + al256((size_t)M * 4096 * 4);
constexpr size_t WS_OFOX = WS_ODN + al256((size_t)M * 4096 * 2);
constexpr size_t WS_YDN = WS_OFOX + al256((size_t)M * 2048 * 2);
constexpr size_t WS_MM = WS_YDN + al256((size_t)M * D * 4);
constexpr size_t WS_Y = WS_MM + al256((size_t)M * D * 2);
constexpr size_t WS_HID = WS_Y + al256((size_t)M * D * 4);
constexpr size_t WS_END = WS_HID + al256((size_t)M * FF * 2);

constexpr int RING_BYTES = 131072;
constexpr int LDSCTL_OFF = RING_BYTES, MISC_OFF = LDSCTL_OFF + 320;
constexpr int LDS_BYTES = 147456;

struct Params { const float* in[17]; float* out; unsigned char* ws; };

__global__ void __launch_bounds__(512, 2) mega_fwd(Params p) {
    extern __shared__ __attribute__((aligned(16))) unsigned char lds_raw[];
    Ctx c; c.lds = (LAS unsigned char*)lds_raw; c.wave = __builtin_amdgcn_readfirstlane((int)threadIdx.x >> 6);
    c.G = gridDim.x; c.gw = blockIdx.x * 8 + c.wave; c.NW = c.G * 8;
    for (int u = threadIdx.x; u < (LDS_BYTES - LDSCTL_OFF) / 4; u += 512) ((LAS unsigned*)(c.lds + LDSCTL_OFF))[u] = 0u;
    __syncthreads();
    typedef __attribute__((address_space(4))) const Params* KParams;
    const KParams kp0 = (KParams)__builtin_amdgcn_kernarg_segment_ptr();
    unsigned char* ws = p.ws;
    XcdBarrier bar = xcd_barrier_post((unsigned*)(ws + WS_CTL) + CW_BAR, (volatile LAS unsigned*)(c.lds + MISC_OFF) + 8);
#define GRID_BAR() xcd_barrier(bar)
#define PH_BEGIN KParams kp = kp0; asm volatile("" : "+s"(kp)); unsigned char* wsl = kp->ws;
#define WSP(type, off) ((type*)(wsl + (off)))

    for (int l = 0; l < DEPTH; ++l) { PH_BEGIN
        ph_transpose(c, kp->in[5] + (size_t)l * D * NIN, D, NIN, NBIG, WSP(bf16, WS_WIN) + (size_t)l * NBIG * D, 1);
        ph_transpose(c, kp->in[11] + (size_t)l * 4096 * D, 4096, D, D, WSP(bf16, WS_WBRDN) + (size_t)l * D * 4096, 0);
        ph_transpose(c, kp->in[12] + (size_t)l * D * D, D, D, D, WSP(bf16, WS_WBRFOX) + (size_t)l * D * D, 0);
        ph_transpose(c, kp->in[13] + (size_t)l * D * D, D, D, D, WSP(bf16, WS_WOUT) + (size_t)l * D * D, 0);
        ph_transpose(c, kp->in[14] + (size_t)l * D * FF, D, FF, FF, WSP(bf16, WS_WGU) + (size_t)l * 2 * FF * D, 2);
        ph_transpose(c, kp->in[15] + (size_t)l * D * FF, D, FF, FF, WSP(bf16, WS_WGU) + (size_t)l * 2 * FF * D, 3);
        ph_transpose(c, kp->in[16] + (size_t)l * FF * D, FF, D, D, WSP(bf16, WS_WDOWN) + (size_t)l * D * FF, 0);
    }
    { PH_BEGIN ph_wsmall(c, kp->in[5], WSP(float, WS_WSM)); }
    __syncthreads();
    { PH_BEGIN ph_adaln(c, kp->in[1], kp->in[2], kp->in[3], WSP(float, WS_MOD)); }
    GRID_BAR();
    { PH_BEGIN RowArgs a{}; a.xin = kp->in[0]; a.x = kp->out; a.gn = kp->in[4]; a.scale = WSP(float, WS_MOD) + 1 * D; a.shift = WSP(float, WS_MOD); a.H = WSP(bf16, WS_H); a.wsm = WSP(float, WS_WSM); a.baf = WSP(float, WS_BAF);
      a.has_y = 0; a.has_h = 1; a.has_small = 1; ph_rowpass(c, a); }
    GRID_BAR();

    for (int l = 0; l < DEPTH; ++l) {
        { PH_BEGIN pg8::Gemm g{WSP(bf16, WS_H), WSP(bf16, WS_WIN) + (size_t)l * NBIG * D, M, NBIG, D, 0}; pg8::StaticOrder S; S.init(M, NBIG, c.G, (int)blockIdx.x);
          pg8::EpiInProj E{WSP(bf16, WS_DNRAW), WSP(bf16, WS_ZS), WSP(bf16, WS_FQKV), WSP(bf16, WS_MG)};
          pg8::gemm_phase<pg8::EpiInProj, pg8::StaticOrder, true, true>(c.lds, g, S, E); }
        GRID_BAR();
        { PH_BEGIN ph_conv(c, WSP(bf16, WS_DNRAW), kp->in[6] + (size_t)l * 8192 * 4, WSP(bf16, WS_DNC)); }
        { PH_BEGIN ph_gates(c, WSP(float, WS_BAF), kp->in[7] + l * 32, kp->in[8] + l * 32, kp->in[10] + l * 16, WSP(float, WS_BETA), WSP(float, WS_GG), WSP(float, WS_LOGF)); }
        GRID_BAR();
        { PH_BEGIN ph_fcum(c, WSP(float, WS_LOGF), WSP(float, WS_FC)); }
        GRID_BAR();
        { PH_BEGIN ph_dn_naive(c, WSP(bf16, WS_DNC), WSP(float, WS_GG), WSP(float, WS_BETA), WSP(float, WS_ODNRAW)); }
        { PH_BEGIN const int bx = blockIdx.x, vcu = (c.G % 8 == 0) ? (bx % 8) * (c.G / 8) + bx / 8 : bx;
          fox::fox_phase((char*)lds_raw, vcu, c.G, WSP(bf16, WS_FQKV), WSP(bf16, WS_OFOX), WSP(float, WS_FC)); }
        GRID_BAR();
        { PH_BEGIN ph_dn_norm(c, WSP(float, WS_ODNRAW), kp->in[9] + l * 128, WSP(bf16, WS_ZS), WSP(bf16, WS_ODN)); }
        GRID_BAR();
        { PH_BEGIN pg8::Gemm g{WSP(bf16, WS_ODN), WSP(bf16, WS_WBRDN) + (size_t)l * D * 4096, M, D, 4096, 0}; pg8::StaticOrder S; S.init(M, D, c.G, (int)blockIdx.x); pg8::EpiF32 E{WSP(float, WS_YDN), D, 0};
          pg8::gemm_phase<pg8::EpiF32, pg8::StaticOrder, true, true>(c.lds, g, S, E); }
        __syncthreads();
        { PH_BEGIN pg8::Gemm g{WSP(bf16, WS_OFOX), WSP(bf16, WS_WBRFOX) + (size_t)l * D * D, M, D, D, 0}; pg8::StaticOrder S; S.init(M, D, c.G, (int)blockIdx.x); pg8::EpiMerge E{WSP(float, WS_YDN), WSP(bf16, WS_MG), WSP(bf16, WS_MM)};
          pg8::gemm_phase<pg8::EpiMerge, pg8::StaticOrder, true, true>(c.lds, g, S, E); }
        GRID_BAR();
        { PH_BEGIN pg8::Gemm g{WSP(bf16, WS_MM), WSP(bf16, WS_WOUT) + (size_t)l * D * D, M, D, D, 0}; pg8::StaticOrder S; S.init(M, D, c.G, (int)blockIdx.x); pg8::EpiF32 E{WSP(float, WS_Y), D, 0};
          pg8::gemm_phase<pg8::EpiF32, pg8::StaticOrder, true, true>(c.lds, g, S, E); }
        GRID_BAR();
        { PH_BEGIN const float* mod = WSP(float, WS_MOD) + (size_t)l * 2 * 6 * D; const float* gl = kp->in[4] + (size_t)l * 4 * D;
          RowArgs a{}; a.xin = kp->out; a.x = kp->out; a.Y = WSP(float, WS_Y); a.gy = gl + 1 * D; a.gate = mod + 2 * D; a.gn = gl + 2 * D; a.scale = mod + 4 * D; a.shift = mod + 3 * D; a.H = WSP(bf16, WS_H); a.has_y = 1; a.has_h = 1; a.has_small = 0;
          ph_rowpass(c, a); }
        GRID_BAR();
        { PH_BEGIN pg8::Gemm g{WSP(bf16, WS_H), WSP(bf16, WS_WGU) + (size_t)l * 2 * FF * D, M, 2 * FF, D, 0}; pg8::StaticOrder S; S.init(M, 2 * FF, c.G, (int)blockIdx.x); pg8::EpiSwiGLU E{WSP(bf16, WS_HID), FF, 0};
          pg8::gemm_phase<pg8::EpiSwiGLU, pg8::StaticOrder, true, true>(c.lds, g, S, E); }
        GRID_BAR();
        { PH_BEGIN pg8::Gemm g{WSP(bf16, WS_HID), WSP(bf16, WS_WDOWN) + (size_t)l * D * FF, M, D, FF, 0}; pg8::StaticOrder S; S.init(M, D, c.G, (int)blockIdx.x); pg8::EpiF32 E{WSP(float, WS_Y), D, 0};
          pg8::gemm_phase<pg8::EpiF32, pg8::StaticOrder, true, true>(c.lds, g, S, E); }
        GRID_BAR();
        { PH_BEGIN const float* mod = WSP(float, WS_MOD) + (size_t)l * 2 * 6 * D; const float* gl = kp->in[4] + (size_t)l * 4 * D;
          RowArgs a{}; a.xin = kp->out; a.x = kp->out; a.Y = WSP(float, WS_Y); a.gy = gl + 3 * D; a.gate = mod + 5 * D; a.has_y = 1;
          if (l + 1 < DEPTH) { const float* mod2 = mod + 2 * 6 * D; const float* gl2 = gl + 4 * D;
              a.gn = gl2; a.scale = mod2 + 1 * D; a.shift = mod2; a.H = WSP(bf16, WS_H); a.wsm = WSP(float, WS_WSM) + (size_t)(l + 1) * NSM * D; a.baf = WSP(float, WS_BAF); a.has_h = 1; a.has_small = 1; }
          ph_rowpass(c, a); }
        if (l + 1 < DEPTH) GRID_BAR();
    }
#undef PH_BEGIN
#undef WSP
#undef GRID_BAR
}

extern "C" void kernel_launch(void* const* d_in, const int* in_sizes, int n_in, void* d_out, int out_size, void* d_ws, size_t ws_size, hipStream_t stream) {
    static int grid = 0;
    if (grid == 0) {
        if (n_in != 17 || out_size != M * D || ws_size < WS_END) { fprintf(stderr, "kernel_launch: bad shapes / workspace (need %zu, have %zu)\n", (size_t)WS_END, ws_size); grid = -1; return; }
        int dev = 0, cus = 0, per_cu = 0;
        if (hipGetDevice(&dev) != hipSuccess || hipDeviceGetAttribute(&cus, hipDeviceAttributeMultiprocessorCount, dev) != hipSuccess) { grid = -1; return; }
        if (hipFuncSetAttribute((const void*)mega_fwd, hipFuncAttributeMaxDynamicSharedMemorySize, LDS_BYTES) != hipSuccess) { fprintf(stderr, "kernel_launch: hipFuncSetAttribute failed\n"); grid = -1; return; }
        if (hipOccupancyMaxActiveBlocksPerMultiprocessor(&per_cu, (const void*)mega_fwd, 512, LDS_BYTES) != hipSuccess || per_cu < 1) { fprintf(stderr, "kernel_launch: occupancy query reports %d workgroups per CU\n", per_cu); }
        (void)hipGetLastError();
        grid = cus;
    }
    if (grid < 0) return;
    if (hipMemsetAsync((char*)d_ws + WS_CTL, 0, CTL_ZERO_BYTES, stream) != hipSuccess) return;
    Params p{};
    for (int i = 0; i < 17; ++i) p.in[i] = (const float*)d_in[i];
    p.out = (float*)d_out; p.ws = (unsigned char*)d_ws;
    hipLaunchKernelGGL(mega_fwd, dim3(grid), dim3(512), LDS_BYTES, stream, p);
}
```

```cpp
#include <hip/hip_runtime.h>
#include <cstdio>
#include <cstdint>

constexpr int D = 2048, NB = 2, T = 4096, M = NB * T, DEPTH = 4;
constexpr int HD = 128, DN_VH = 32, DN_CONV = 8192;
constexpr int FOXH = 16;
constexpr int FF = 5632;
constexpr int NIN = 22608;
constexpr int SRC_B = 12288, SRC_A = 12320, SRC_FQKV = 12352, SRC_F = 18496, SRC_MERGE = 18512;
constexpr int NBIG = 22528;
constexpr int NSM = 80;
constexpr float EPS = 1e-6f;

typedef unsigned short bf16;
typedef float f32x4 __attribute__((ext_vector_type(4)));
typedef unsigned u32x4 __attribute__((ext_vector_type(4)));
typedef unsigned u32x2 __attribute__((ext_vector_type(2)));
#define LAS __attribute__((address_space(3)))

__device__ __forceinline__ float bf_lo(unsigned w) { return __uint_as_float(w << 16); }
__device__ __forceinline__ float bf_hi(unsigned w) { return __uint_as_float(w & 0xffff0000u); }
__device__ __forceinline__ float bf2f(bf16 h) { return __uint_as_float(((unsigned)h) << 16); }
__device__ __forceinline__ unsigned f2bf(float f) { unsigned u = __float_as_uint(f); return (u + 0x7fffu + ((u >> 16) & 1u)) >> 16; }
__device__ __forceinline__ unsigned pk2(float lo, float hi) { return f2bf(lo) | (f2bf(hi) << 16); }
__device__ __forceinline__ float fsigmoid(float x) { return __builtin_amdgcn_rcpf(1.0f + __expf(-x)); }
__device__ __forceinline__ float fsilu(float x) { return x * fsigmoid(x); }
__device__ __forceinline__ float wave_sum(float v) {
#pragma unroll
    for (int o = 1; o < 64; o <<= 1) v += __shfl_xor(v, o);
    return v;
}
namespace pg8 {
#define PG8_LAS __attribute__((address_space(3)))
typedef unsigned short bf16_t;
typedef short bf16x8 __attribute__((ext_vector_type(8)));
typedef float f32x4 __attribute__((ext_vector_type(4)));
typedef unsigned u32x4 __attribute__((ext_vector_type(4)));
constexpr int BM = 256, BK = 64, HALF = 128, HTB = HALF * BK * 2  , STAGE_BYTES = 8 * HTB, NXCD = 8, WGM = 8;

__host__ __device__ __forceinline__ int lds_byte(int r, int c) { const int st = (r >> 4) * 2 + (c >> 5), rr = r & 15, cc = c & 31, ob = rr * 64 + cc * 2; return st * 1024 + (ob ^ (((ob >> 9) & 1) << 5)); }
__host__ __device__ __forceinline__ void stage_rc(int b, int& R, int& C) { const int st = b / 1024, sb = b % 1024, swz = sb ^ (((sb >> 9) & 1) << 5); R = (st >> 1) * 16 + swz / 64; C = (st & 1) * 32 + (swz % 64) / 2; }
__host__ __device__ __forceinline__ int perm32(int rho) { const int n = rho >> 4, i = rho & 15; return 8 * (i >> 2) + 4 * n + (i & 3); }

struct Unit { int pm, pn; };
struct Gemm { const bf16_t* A; const bf16_t* Bt; int M, N, K, pad; };

struct StaticOrder {
    int nM, nN, nwg, G, c;
    __host__ __device__ void init(int M, int N, int G_, int c_) { nM = M / BM; nN = N / BM; nwg = nM * nN; G = G_; c = c_; }
    __host__ __device__ bool next(int i, Unit& u) const {
        const long L = (long)i * G + c; if (L >= nwg) return false;
        int wgid = (int)L; { const int q = nwg / NXCD, r = nwg % NXCD, xcd = wgid % NXCD, off = wgid / NXCD; wgid = (xcd < r ? xcd * (q + 1) : r * (q + 1) + (xcd - r) * q) + off; }
        const int nig = WGM * nN, gid = wgid / nig, fm = gid * WGM, gsz = (nM - fm) < WGM ? (nM - fm) : WGM;
        u.pm = fm + ((wgid % nig) % gsz); u.pn = (wgid % nig) / gsz; return true;
    }
    __device__ __forceinline__ void a_ready(const Unit&) const {}
    __device__ __forceinline__ void done(const Unit&) const {}
};

__device__ __forceinline__ unsigned cvt_pk_bf16(float lo, float hi) { unsigned r; asm volatile("v_cvt_pk_bf16_f32 %0, %1, %2" : "=v"(r) : "v"(lo), "v"(hi)); return r; }
__device__ __forceinline__ float e_sigmoid(float x) { return __builtin_amdgcn_rcpf(1.0f + __expf(-x)); }

struct EpiF32 {
    static constexpr bool PERM = false, AFTER_DRAIN = false;
    float* C; int ldc, pad;
    __device__ __forceinline__ void operator()(const f32x4 (&acc)[2][2][4][2], const Unit& u, int wr, int wc, int fr, int fq) const {
        const int row0 = u.pm * BM + wr * 64 + fr, col0 = u.pn * BM + wc * 32 + 4 * fq;
#pragma unroll
        for (int ai = 0; ai < 2; ++ai)
#pragma unroll
            for (int m = 0; m < 4; ++m) { float* rowp = C + (size_t)(row0 + ai * HALF + m * 16) * ldc + col0;
#pragma unroll
                for (int bj = 0; bj < 2; ++bj)
#pragma unroll
                    for (int n = 0; n < 2; ++n) *(f32x4*)(rowp + bj * HALF + n * 16) = acc[ai][bj][m][n]; }
    }
};
struct EpiInProj {
    static constexpr bool PERM = true, AFTER_DRAIN = false;
    bf16_t *dnraw, *z, *fqkv, *mg;
    __device__ __forceinline__ void operator()(const f32x4 (&acc)[2][2][4][2], const Unit& u, int wr, int wc, int fr, int fq) const {
        const int pn = u.pn; bf16_t* base; int ldc, colt, act;
        if (pn < 32) { base = dnraw; ldc = 8192; colt = pn * BM; act = 0; }
        else if (pn < 48) { base = z; ldc = 4096; colt = (pn - 32) * BM; act = 1; }
        else if (pn < 72) { base = fqkv; ldc = 6144; colt = (pn - 48) * BM; act = 0; }
        else { base = mg; ldc = 4096; colt = (pn - 72) * BM; act = 2; }
        const int row0 = u.pm * BM + wr * 64 + fr, col0 = colt + wc * 32 + 8 * fq;
#pragma unroll
        for (int ai = 0; ai < 2; ++ai)
#pragma unroll
            for (int m = 0; m < 4; ++m) { bf16_t* rowp = base + (size_t)(row0 + ai * HALF + m * 16) * ldc + col0;
#pragma unroll
                for (int bj = 0; bj < 2; ++bj) { f32x4 v0 = acc[ai][bj][m][0], v1 = acc[ai][bj][m][1];
                    if (act == 1) {
#pragma unroll
                        for (int j = 0; j < 4; ++j) { v0[j] = v0[j] * e_sigmoid(v0[j]); v1[j] = v1[j] * e_sigmoid(v1[j]); } }
                    if (act == 2) {
#pragma unroll
                        for (int j = 0; j < 4; ++j) { v0[j] = e_sigmoid(v0[j]); v1[j] = e_sigmoid(v1[j]); } }
                    u32x4 w; w.x = cvt_pk_bf16(v0[0], v0[1]); w.y = cvt_pk_bf16(v0[2], v0[3]); w.z = cvt_pk_bf16(v1[0], v1[1]); w.w = cvt_pk_bf16(v1[2], v1[3]);
                    *(u32x4*)(rowp + bj * HALF) = w; } }
    }
};
struct EpiMerge {
    static constexpr bool PERM = true, AFTER_DRAIN = false;
    const float* ydn; const bf16_t* mg; bf16_t* mm;
    __device__ __forceinline__ void operator()(const f32x4 (&acc)[2][2][4][2], const Unit& u, int wr, int wc, int fr, int fq) const {
        const int row0 = u.pm * BM + wr * 64 + fr, col0 = u.pn * BM + wc * 32 + 8 * fq;
#pragma unroll
        for (int ai = 0; ai < 2; ++ai)
#pragma unroll
            for (int m = 0; m < 4; ++m) { const size_t row = (size_t)(row0 + ai * HALF + m * 16);
#pragma unroll
                for (int bj = 0; bj < 2; ++bj) { const int col = col0 + bj * HALF;
                    const f32x4 y0 = *(const f32x4*)(ydn + row * 2048 + col), y1 = *(const f32x4*)(ydn + row * 2048 + col + 4);
                    const u32x4 gd = *(const u32x4*)(mg + row * 4096 + col), gf = *(const u32x4*)(mg + row * 4096 + 2048 + col);
                    const f32x4 a0 = acc[ai][bj][m][0], a1 = acc[ai][bj][m][1];
                    float o[8];
                    o[0] = __uint_as_float(gd.x << 16) * y0[0] + __uint_as_float(gf.x << 16) * a0[0];
                    o[1] = __uint_as_float(gd.x & 0xffff0000u) * y0[1] + __uint_as_float(gf.x & 0xffff0000u) * a0[1];
                    o[2] = __uint_as_float(gd.y << 16) * y0[2] + __uint_as_float(gf.y << 16) * a0[2];
                    o[3] = __uint_as_float(gd.y & 0xffff0000u) * y0[3] + __uint_as_float(gf.y & 0xffff0000u) * a0[3];
                    o[4] = __uint_as_float(gd.z << 16) * y1[0] + __uint_as_float(gf.z << 16) * a1[0];
                    o[5] = __uint_as_float(gd.z & 0xffff0000u) * y1[1] + __uint_as_float(gf.z & 0xffff0000u) * a1[1];
                    o[6] = __uint_as_float(gd.w << 16) * y1[2] + __uint_as_float(gf.w << 16) * a1[2];
                    o[7] = __uint_as_float(gd.w & 0xffff0000u) * y1[3] + __uint_as_float(gf.w & 0xffff0000u) * a1[3];
                    u32x4 w; w.x = cvt_pk_bf16(o[0], o[1]); w.y = cvt_pk_bf16(o[2], o[3]); w.z = cvt_pk_bf16(o[4], o[5]); w.w = cvt_pk_bf16(o[6], o[7]);
                    *(u32x4*)(mm + row * 2048 + col) = w; } }
    }
};
struct EpiSwiGLU {
    static constexpr bool PERM = true, AFTER_DRAIN = false;
    bf16_t* hid; int ldc, pad;
    __device__ __forceinline__ void operator()(const f32x4 (&acc)[2][2][4][2], const Unit& u, int wr, int wc, int fr, int fq) const {
        const int row0 = u.pm * BM + wr * 64 + fr, col0 = u.pn * HALF + wc * 32 + 8 * fq;
#pragma unroll
        for (int ai = 0; ai < 2; ++ai)
#pragma unroll
            for (int m = 0; m < 4; ++m) { bf16_t* rowp = hid + (size_t)(row0 + ai * HALF + m * 16) * ldc + col0;
                const f32x4 g0 = acc[ai][0][m][0], g1 = acc[ai][0][m][1], u0 = acc[ai][1][m][0], u1 = acc[ai][1][m][1];
                float o[8];
#pragma unroll
                for (int j = 0; j < 4; ++j) { o[j] = g0[j] * e_sigmoid(g0[j]) * u0[j]; o[4 + j] = g1[j] * e_sigmoid(g1[j]) * u1[j]; }
                u32x4 w; w.x = cvt_pk_bf16(o[0], o[1]); w.y = cvt_pk_bf16(o[2], o[3]); w.z = cvt_pk_bf16(o[4], o[5]); w.w = cvt_pk_bf16(o[6], o[7]);
                *(u32x4*)rowp = w; }
    }
};

template <class Epi, class Sched, bool ALIGN_EPI = false, bool SP2 = false>
__device__ __forceinline__ void gemm_phase(PG8_LAS unsigned char* lds, const Gemm g, const Sched& S, const Epi& E) {
    int tid_ = threadIdx.x; asm volatile("" : "+v"(tid_)); const int tid = tid_, wid = __builtin_amdgcn_readfirstlane(tid >> 6), lane = tid & 63, wr = wid >> 2, wc = wid & 3, fr = lane & 15, fq = lane >> 4;
    const int K = g.K, nt = K / BK;
    unsigned voffA[2], voffB[2];
#pragma unroll
    for (int i = 0; i < 2; ++i) { int R, C; stage_rc(tid * 16 + i * 8192, R, C); const int Rb = Epi::PERM ? ((R & ~31) + perm32(R & 31)) : R;
        voffA[i] = (unsigned)(R * K + C) * 2u; voffB[i] = (unsigned)(Rb * K + C) * 2u; }
    const size_t kstep = (size_t)(BK * 2);
    const size_t hstep = (size_t)HALF * K * 2;
    const size_t tstep = 2 * hstep;
    const unsigned ldsw = (unsigned)wid * 1024u;
    const int aoff = lds_byte(wr * 64 + fr, fq * 8), boff = lds_byte(wc * 32 + fr, fq * 8);
#define PG8_SA(b, h) (((b) * 2 + (h)) * HTB)
#define PG8_SB(b, h) ((4 + (b) * 2 + (h)) * HTB)
#define PG8_STAGE(bufoff, gbase, voff) do { _Pragma("unroll") for (int _i = 0; _i < 2; ++_i) \
        __builtin_amdgcn_global_load_lds((const unsigned*)((const char*)(gbase) + (voff)[_i]), (PG8_LAS unsigned*)(lds + (bufoff) + ldsw + _i * 8192), 16, 0, 0); } while (0)
#define PG8_LDA(dst, b, h) do { _Pragma("unroll") for (int m = 0; m < 4; ++m) _Pragma("unroll") for (int k = 0; k < 2; ++k) dst[m][k] = *(const PG8_LAS bf16x8*)(lds + PG8_SA(b, h) + aoff + m * 2048 + k * 1024); } while (0)
#define PG8_LDB(dst, b, h) do { _Pragma("unroll") for (int n = 0; n < 2; ++n) _Pragma("unroll") for (int k = 0; k < 2; ++k) dst[n][k] = *(const PG8_LAS bf16x8*)(lds + PG8_SB(b, h) + boff + n * 2048 + k * 1024); } while (0)
#define PG8_MMA(ai, bj, At, Bt) do { __builtin_amdgcn_s_setprio(1); _Pragma("unroll") for (int m = 0; m < 4; ++m) _Pragma("unroll") for (int n = 0; n < 2; ++n) _Pragma("unroll") for (int k = 0; k < 2; ++k) \
        acc[ai][bj][m][n] = __builtin_amdgcn_mfma_f32_16x16x32_bf16(Bt[n][k], At[m][k], acc[ai][bj][m][n], 0, 0, 0); __builtin_amdgcn_s_setprio(0); } while (0)
#define PG8_WAIT_V(n) asm volatile("s_waitcnt vmcnt(" #n ")" ::: "memory")
#define PG8_WAIT_L(n) asm volatile("s_waitcnt lgkmcnt(" #n ")" ::: "memory")
#define PG8_BAR __builtin_amdgcn_s_barrier()
#define PG8_SCHED __builtin_amdgcn_sched_barrier(0)
    Unit cur, nxt; int ui = 0;
    if (!S.next(0, cur)) return;
    f32x4 acc[2][2][4][2];
#pragma unroll
    for (int a = 0; a < 2; ++a)
#pragma unroll
        for (int b = 0; b < 2; ++b)
#pragma unroll
            for (int m = 0; m < 4; ++m)
#pragma unroll
                for (int n = 0; n < 2; ++n) acc[a][b][m][n] = (f32x4){0.f, 0.f, 0.f, 0.f};
    bf16x8 At[4][2], B0[2][2], B1[2][2];
    const char* cA = (const char*)g.A + (size_t)cur.pm * tstep; const char* cB = (const char*)g.Bt + (size_t)cur.pn * tstep;
    S.a_ready(cur);
    if constexpr (SP2) {
        PG8_STAGE(PG8_SB(0, 0), cB, voffB); PG8_STAGE(PG8_SB(0, 1), cB + hstep, voffB); PG8_STAGE(PG8_SA(0, 0), cA, voffA); PG8_STAGE(PG8_SA(0, 1), cA + hstep, voffA);
        if (wr == 1) PG8_BAR;
        PG8_WAIT_V(2); PG8_BAR;
        PG8_STAGE(PG8_SB(1, 0), cB + kstep, voffB); PG8_STAGE(PG8_SA(1, 0), cA + kstep, voffA); PG8_STAGE(PG8_SB(1, 1), cB + hstep + kstep, voffB);
        PG8_WAIT_V(6); PG8_BAR;
    } else {
        PG8_STAGE(PG8_SB(0, 0), cB, voffB); PG8_STAGE(PG8_SA(0, 0), cA, voffA); PG8_STAGE(PG8_SB(0, 1), cB + hstep, voffB); PG8_STAGE(PG8_SA(0, 1), cA + hstep, voffA);
        if (wr == 1) PG8_BAR;
        PG8_WAIT_V(4); PG8_BAR;
        PG8_STAGE(PG8_SB(1, 0), cB + kstep, voffB); PG8_STAGE(PG8_SA(1, 0), cA + kstep, voffA); PG8_STAGE(PG8_SB(1, 1), cB + hstep + kstep, voffB);
        PG8_WAIT_V(6); PG8_BAR;
    }
    for (;;) {
        const bool has_next = S.next(ui + 1, nxt);
        const char* nA = has_next ? (const char*)g.A + (size_t)nxt.pm * tstep : cA; const char* nB = has_next ? (const char*)g.Bt + (size_t)nxt.pn * tstep : cB;
        for (int t = 0; t < nt; t += 2) {
            const bool last = (t == nt - 2);
            const char* a1 = cA + (size_t)(t + 1) * kstep;
            const char* a2 = last ? nA : cA + (size_t)(t + 2) * kstep; const char* b2 = last ? nB : cB + (size_t)(t + 2) * kstep;
            const char* a3 = a2 + kstep; const char* b3 = b2 + kstep;
            if (last && has_next) S.a_ready(nxt);
            if constexpr (SP2) {
            PG8_LDB(B0, 0, 0); PG8_LDB(B1, 0, 1); PG8_SCHED; PG8_LDA(At, 0, 0); PG8_STAGE(PG8_SA(1, 1), a1 + hstep, voffA);
            PG8_WAIT_V(8); PG8_WAIT_L(0); PG8_BAR; PG8_MMA(0, 0, At, B0); PG8_MMA(0, 1, At, B1); PG8_BAR; PG8_SCHED;
            PG8_LDA(At, 0, 1); PG8_STAGE(PG8_SB(0, 0), b2, voffB); PG8_STAGE(PG8_SB(0, 1), b2 + hstep, voffB); PG8_STAGE(PG8_SA(0, 0), a2, voffA);
            PG8_WAIT_V(8); PG8_WAIT_L(0); PG8_BAR; PG8_MMA(1, 0, At, B0); PG8_MMA(1, 1, At, B1); PG8_BAR; PG8_SCHED;
            PG8_LDB(B0, 1, 0); PG8_LDB(B1, 1, 1); PG8_SCHED; PG8_LDA(At, 1, 0); PG8_STAGE(PG8_SA(0, 1), a2 + hstep, voffA);
            PG8_WAIT_V(8); PG8_WAIT_L(0); PG8_BAR; PG8_MMA(0, 0, At, B0); PG8_MMA(0, 1, At, B1); PG8_BAR; PG8_SCHED;
            PG8_LDA(At, 1, 1); PG8_STAGE(PG8_SB(1, 0), b3, voffB); PG8_STAGE(PG8_SB(1, 1), b3 + hstep, voffB); PG8_STAGE(PG8_SA(1, 0), a3, voffA);
            PG8_WAIT_V(8); PG8_WAIT_L(0); PG8_BAR; PG8_MMA(1, 0, At, B0); PG8_MMA(1, 1, At, B1); PG8_BAR; PG8_SCHED;
            } else {
            PG8_LDB(B0, 0, 0); PG8_SCHED; PG8_LDA(At, 0, 0); PG8_STAGE(PG8_SA(1, 1), a1 + hstep, voffA);
            PG8_WAIT_L(8); PG8_BAR; PG8_WAIT_L(0); PG8_MMA(0, 0, At, B0); PG8_BAR; PG8_SCHED;
            PG8_LDB(B1, 0, 1); PG8_STAGE(PG8_SB(0, 0), b2, voffB);
            PG8_BAR; PG8_WAIT_L(0); PG8_MMA(0, 1, At, B1); PG8_BAR;
            PG8_LDA(At, 0, 1); PG8_STAGE(PG8_SA(0, 0), a2, voffA);
            PG8_BAR; PG8_WAIT_L(0); PG8_MMA(1, 0, At, B0); PG8_BAR; PG8_SCHED;
            PG8_STAGE(PG8_SB(0, 1), b2 + hstep, voffB);
            PG8_WAIT_V(6); PG8_BAR; PG8_MMA(1, 1, At, B1); PG8_BAR;
            PG8_LDB(B0, 1, 0); PG8_SCHED; PG8_LDA(At, 1, 0); PG8_STAGE(PG8_SA(0, 1), a2 + hstep, voffA);
            PG8_WAIT_L(8); PG8_BAR; PG8_WAIT_L(0); PG8_MMA(0, 0, At, B0); PG8_BAR; PG8_SCHED;
            PG8_LDB(B1, 1, 1); PG8_STAGE(PG8_SB(1, 0), b3, voffB);
            PG8_BAR; PG8_WAIT_L(0); PG8_MMA(0, 1, At, B1); PG8_BAR;
            PG8_LDA(At, 1, 1); PG8_STAGE(PG8_SA(1, 0), a3, voffA);
            PG8_BAR; PG8_WAIT_L(0); PG8_MMA(1, 0, At, B0); PG8_BAR; PG8_SCHED;
            PG8_STAGE(PG8_SB(1, 1), b3 + hstep, voffB);
            PG8_WAIT_V(6); PG8_BAR; PG8_MMA(1, 1, At, B1); PG8_BAR;
            }
        }
        if constexpr (ALIGN_EPI) { if (wr == 0) PG8_BAR; }
        if constexpr (!Epi::AFTER_DRAIN) { E(acc, cur, wr, wc, fr, fq); S.done(cur); }
        if (!has_next) break;
#pragma unroll
        for (int a = 0; a < 2; ++a)
#pragma unroll
            for (int b = 0; b < 2; ++b)
#pragma unroll
                for (int m = 0; m < 4; ++m)
#pragma unroll
                    for (int n = 0; n < 2; ++n) acc[a][b][m][n] = (f32x4){0.f, 0.f, 0.f, 0.f};
        cur = nxt; cA = nA; cB = nB; ++ui;
        if constexpr (ALIGN_EPI) { if (wr == 1) PG8_BAR; }
    }
    PG8_WAIT_V(0);
    if constexpr (!ALIGN_EPI) { if (wr == 0) PG8_BAR; }
    PG8_BAR;
    if constexpr (Epi::AFTER_DRAIN) { E.fused(acc, cur, wr, wc, fr, fq, lds, wid, lane); S.done(cur); }
#undef PG8_SA
#undef PG8_SB
#undef PG8_STAGE
#undef PG8_LDA
#undef PG8_LDB
#undef PG8_MMA
#undef PG8_WAIT_V
#undef PG8_WAIT_L
#undef PG8_BAR
#undef PG8_SCHED
}
}
#define XB_TMO      128
#define XB_XCNT(j)  (256  + 64 * (j))
#define XB_XSUB(j)  (1280 + 64 * (j))
#define XB_XGEN(j)  (2304 + 64 * (j))
#define XB_TOP      3328
#define XB_TOPGEN   3392
#define XCD_BAR_WORDS 3456
#define XB_SPIN_CAP (1u << 21)


__device__ __forceinline__ unsigned xb_ld(unsigned* p)              { return __hip_atomic_load(p, __ATOMIC_RELAXED, __HIP_MEMORY_SCOPE_AGENT); }
__device__ __forceinline__ unsigned xb_add(unsigned* p, unsigned v) { return __hip_atomic_fetch_add(p, v, __ATOMIC_RELAXED, __HIP_MEMORY_SCOPE_AGENT); }
__device__ __forceinline__ unsigned xb_xcc_id() { return (unsigned)__builtin_amdgcn_s_getreg((3 << 11) | 20) & 0xFu; }
#define XB_SPIN(cond, bar) do { unsigned _sp = 0; while (cond) { __builtin_amdgcn_s_sleep(1); \
    if ((++_sp & 255u) == 0u) { if (xb_ld(&(bar)[XB_TMO])) break; if (_sp > XB_SPIN_CAP) { atomicAdd(&(bar)[XB_TMO], 1u); break; } } } } while (0)

struct XcdBarrier {
    unsigned* bar; unsigned x;
    volatile LAS unsigned* st;
};

__device__ __forceinline__ XcdBarrier xcd_barrier_post(unsigned* bar, volatile LAS unsigned* st) {
    XcdBarrier b; b.bar = bar; b.x = xb_xcc_id(); b.st = st;
    if (threadIdx.x == 0) (void)xb_add(&bar[XB_XCNT(b.x)], 1u);
    return b;
}
__device__ __forceinline__ void xcd_barrier_complete(unsigned* bar, unsigned x, unsigned& nloc, unsigned& nx) {
    const unsigned G = gridDim.x * gridDim.y * gridDim.z;
    unsigned sum, cnt, mine, sp = 0u;
    for (;;) {
        sum = 0u; cnt = 0u; mine = 0u;
#pragma unroll
        for (unsigned j = 0; j < 16; ++j) { const unsigned c = xb_ld(&bar[XB_XCNT(j)]); sum += c; cnt += (c > 0u) ? 1u : 0u; mine = (j == x) ? c : mine; }
        if (sum == G) break;
        __builtin_amdgcn_s_sleep(1);
        if ((++sp & 255u) == 0u) { if (xb_ld(&bar[XB_TMO])) break; if (sp > XB_SPIN_CAP) { atomicAdd(&bar[XB_TMO], 1u); break; } }
    }
    nloc = mine > 0u ? mine : 1u; nx = cnt > 0u ? cnt : 1u;
}

__device__ __forceinline__ void xcd_barrier(const XcdBarrier& b) {
    asm volatile("s_waitcnt vmcnt(0)" ::: "memory");
    __syncthreads();
    if (threadIdx.x == 0) {
        unsigned* bar = b.bar;
        __builtin_amdgcn_s_waitcnt(0);
        unsigned nloc = b.st[0], nx = b.st[1];
        if (nloc == 0u) { xcd_barrier_complete(bar, b.x, nloc, nx); b.st[0] = nloc; b.st[1] = nx; }
        const unsigned old = xb_add(&bar[XB_XSUB(b.x)], 1u);
        const unsigned gen = old / nloc;
        if (old + 1u == (gen + 1u) * nloc) {
            __builtin_amdgcn_fence(__ATOMIC_RELEASE, "agent");
            asm volatile("s_waitcnt vmcnt(0)" ::: "memory");
            const unsigned og = xb_add(&bar[XB_TOP], 1u);
            const unsigned tg = og / nx;
            if (og + 1u == (tg + 1u) * nx) xb_add(&bar[XB_TOPGEN], 1u);
            else XB_SPIN(xb_ld(&bar[XB_TOPGEN]) == tg, bar);
            __builtin_amdgcn_fence(__ATOMIC_ACQUIRE, "agent");
            xb_add(&bar[XB_XGEN(b.x)], 1u);
            asm volatile("s_waitcnt vmcnt(0)" ::: "memory");
        } else {
            XB_SPIN(xb_ld(&bar[XB_XGEN(b.x)]) == gen, bar);
            __builtin_amdgcn_fence(__ATOMIC_ACQUIRE, "agent");
            asm volatile("s_waitcnt vmcnt(0)" ::: "memory");
        }
    }
    __syncthreads();
}

namespace fox {
constexpr int D = 128, QP = 6144, KVP = 6144, OP = 2048;
constexpr float THR = 8.f;
constexpr bool WSKIP = false;
using bf16 = unsigned short;
constexpr float SCALE = 0.08838834764831845f;
constexpr int NW = 8, QBLK = 32, KVBLK = 64, QB = NW * QBLK;
constexpr int SHM_V = KVBLK * D * 2, SHM_K = KVBLK * D * 2;
constexpr int BIAS_OFF = 2 * SHM_V + 2 * SHM_K + NW * 64 * 4;
constexpr int LDS_BYTES = BIAS_OFF + 4096 * 4;

typedef short bf16x8 __attribute__((ext_vector_type(8)));
typedef short s16x4 __attribute__((ext_vector_type(4)));
typedef float f32x16 __attribute__((ext_vector_type(16)));
typedef float f32x4 __attribute__((ext_vector_type(4)));
typedef unsigned u32x4 __attribute__((ext_vector_type(4)));
template <class A, class Bt> struct same_t { static constexpr bool v = false; };
template <class A> struct same_t<A, A> { static constexpr bool v = true; };

#define KSWZ(row, colB) ((row) * 256 + ((colB) ^ (((row) & 7) << 4)))
#define SBAR() __builtin_amdgcn_sched_barrier(0)
__device__ __forceinline__ int v_st(int k, int c) { const int kk = (k & ~0xC) | ((k & 4) << 1) | ((k & 8) >> 1); return ((kk >> 3) * 4 + (c >> 5)) * 512 + ((kk & 7) * 32 + (c & 31)) * 2; }
__device__ __forceinline__ int v_rd_base(int lane) { return ((lane & 3) << 3) | (((lane >> 2) & 3) << 6) | (((lane >> 4) & 1) << 5) | (((lane >> 5) & 1) << 8); }
constexpr int v_rd_off(int d0, int ks, int half) { return d0 * 512 + ks * 4096 + half * 2048; }
__device__ __forceinline__ int crow(int r, int hi) { return (r & 3) + 8 * (r >> 2) + 4 * hi; }
__device__ __forceinline__ unsigned cvtpk(float lo, float hi) {
    unsigned r; asm volatile("v_cvt_pk_bf16_f32 %0, %1, %2" : "=v"(r) : "v"(lo), "v"(hi)); return r;
}
__device__ __forceinline__ bf16x8 pack8(f32x4 a, f32x4 b) {
    u32x4 w = {cvtpk(a[0], a[1]), cvtpk(a[2], a[3]), cvtpk(b[0], b[1]), cvtpk(b[2], b[3])};
    return *reinterpret_cast<bf16x8*>(&w);
}
template <class T> __device__ __forceinline__ bf16x8 load8(const T* p) {
    if constexpr (same_t<T, float>::v) { return pack8(*(const f32x4*)p, *(const f32x4*)(p + 4)); }
    else { return *reinterpret_cast<const bf16x8*>(p); }
}
__device__ __forceinline__ void mask_tile(f32x16& p0, f32x16& p1, int dq, unsigned W) {
    const float NEG = -__builtin_inff();
#pragma unroll
    for (int r = 0; r < 16; ++r) {
        const int c = (r & 3) + 8 * (r >> 2);
        if ((unsigned)(dq - c) >= W) p0[r] = NEG;
        if ((unsigned)(dq - c - 32) >= W) p1[r] = NEG;
    }
}
__device__ __forceinline__ void partialSM(f32x16& p0, f32x16& p1, float& m_reg, float& mn, float& alpha) {
    float pmax = p0[0]; for (int r = 1; r < 16; ++r) pmax = fmaxf(pmax, p0[r]); for (int r = 0; r < 16; ++r) pmax = fmaxf(pmax, p1[r]);
    { auto rr = __builtin_amdgcn_permlane32_swap(__float_as_uint(pmax), __float_as_uint(pmax), false, false);
      pmax = fmaxf(__uint_as_float(rr[0]), __uint_as_float(rr[1])); }
    constexpr float C2 = 1.4426950408889634f * SCALE;
    if (__builtin_expect(__all((pmax - m_reg) * SCALE <= THR), 1)) { mn = m_reg; alpha = 1.f; }
    else { mn = fmaxf(m_reg, pmax); alpha = __builtin_amdgcn_exp2f((m_reg - mn) * C2); m_reg = mn; }
    const float mnL = -mn * C2;
    for (int r = 0; r < 16; ++r) p0[r] = fmaf(p0[r], C2, mnL); for (int r = 0; r < 16; ++r) p1[r] = fmaf(p1[r], C2, mnL);
    for (int r = 0; r < 16; ++r) p0[r] = __builtin_amdgcn_exp2f(p0[r]);
}
__device__ __forceinline__ void finishSM(f32x16& p0, f32x16& p1, float alpha, float& l_reg, bf16x8& pa0, bf16x8& pa1, bf16x8& pa2, bf16x8& pa3) {
    for (int r = 0; r < 16; ++r) p1[r] = __builtin_amdgcn_exp2f(p1[r]);
    float ps = 0; for (int r = 0; r < 16; ++r) ps += p0[r]; for (int r = 0; r < 16; ++r) ps += p1[r];
    { auto rr = __builtin_amdgcn_permlane32_swap(__float_as_uint(ps), __float_as_uint(ps), false, false);
      ps = __uint_as_float(rr[0]) + __uint_as_float(rr[1]); }
    l_reg = l_reg * alpha + ps;
#define PK4(P, B_, OUT) do { unsigned a0 = cvtpk(P[B_+0], P[B_+1]), a1 = cvtpk(P[B_+2], P[B_+3]);                          \
        unsigned b0 = cvtpk(P[B_+4], P[B_+5]), b1 = cvtpk(P[B_+6], P[B_+7]);                                             \
        auto r0 = __builtin_amdgcn_permlane32_swap(a0, b0, false, false); auto r1 = __builtin_amdgcn_permlane32_swap(a1, b1, false, false); \
        u32x4 w = {r0[0], r1[0], r0[1], r1[1]}; OUT = *reinterpret_cast<bf16x8*>(&w); } while (0)
    PK4(p0, 0, pa0); PK4(p0, 8, pa1); PK4(p1, 0, pa2); PK4(p1, 8, pa3);
#undef PK4
}
template <int KB, bool SK>
__device__ __forceinline__ void qkt(f32x16& p0, f32x16& p1, const char* K_lds, int r32, int hi, const bf16x8* qr, bool act, const float* bl  ) {
    if (SK && !act) { const float NEG = -__builtin_inff();
#pragma unroll
        for (int r = 0; r < 16; ++r) { p0[r] = NEG; p1[r] = NEG; } return; }
    { const f32x4 a0 = *(const f32x4*)(bl), a1 = *(const f32x4*)(bl + 8), a2 = *(const f32x4*)(bl + 16), a3 = *(const f32x4*)(bl + 24);
      const f32x4 c0 = *(const f32x4*)(bl + 32), c1 = *(const f32x4*)(bl + 40), c2 = *(const f32x4*)(bl + 48), c3 = *(const f32x4*)(bl + 56);
      p0 = (f32x16){a0[0], a0[1], a0[2], a0[3], a1[0], a1[1], a1[2], a1[3], a2[0], a2[1], a2[2], a2[3], a3[0], a3[1], a3[2], a3[3]};
      p1 = (f32x16){c0[0], c0[1], c0[2], c0[3], c1[0], c1[1], c1[2], c1[3], c2[0], c2[1], c2[2], c2[3], c3[0], c3[1], c3[2], c3[3]}; }
    const char* kb[4];
#pragma unroll
    for (int dd = 0; dd < 4; ++dd) kb[dd] = K_lds + KB * SHM_K + KSWZ(r32, (dd * 16 + hi * 8) * 2);
#pragma unroll
    for (int d0 = 0; d0 < 8; ++d0) { const char* a = kb[d0 & 3] + (d0 >> 2) * 128;
        bf16x8 b0 = *reinterpret_cast<const bf16x8*>(a);
        bf16x8 b1 = *reinterpret_cast<const bf16x8*>(a + 32 * 256);
        p0 = __builtin_amdgcn_mfma_f32_32x32x16_bf16(b0, qr[d0], p0, 0, 0, 0);
        p1 = __builtin_amdgcn_mfma_f32_32x32x16_bf16(b1, qr[d0], p1, 0, 0, 0); }
}
template <int VB, bool SK>
__device__ __forceinline__ void pv_tile(f32x16* o, int vb0, bf16x8 pa0, bf16x8 pa1, bf16x8 pa2, bf16x8 pa3, bool act) {
    if (SK && !act) return;
#define TRRD(dst, off) asm volatile("ds_read_b64_tr_b16 %0, %1 offset:%2" : "=&v"(dst) : "v"(vb0), "i"(off) : "memory")
#define PV_D0(d0) do { s16x4 l0, l1, l2, l3, h0, h1, h2, h3; constexpr int b_ = VB * SHM_V + v_rd_off(d0, 0, 0);     \
        TRRD(l0, b_); TRRD(h0, b_ + 2048); TRRD(l1, b_ + 4096); TRRD(h1, b_ + 6144); TRRD(l2, b_ + 8192); TRRD(h2, b_ + 10240); TRRD(l3, b_ + 12288); TRRD(h3, b_ + 14336); \
        asm volatile("s_waitcnt lgkmcnt(0)" ::: "memory"); SBAR();                 \
        o[d0] = __builtin_amdgcn_mfma_f32_32x32x16_bf16(pa0, (bf16x8){l0[0], l0[1], l0[2], l0[3], h0[0], h0[1], h0[2], h0[3]}, o[d0], 0, 0, 0);   \
        o[d0] = __builtin_amdgcn_mfma_f32_32x32x16_bf16(pa1, (bf16x8){l1[0], l1[1], l1[2], l1[3], h1[0], h1[1], h1[2], h1[3]}, o[d0], 0, 0, 0);   \
        o[d0] = __builtin_amdgcn_mfma_f32_32x32x16_bf16(pa2, (bf16x8){l2[0], l2[1], l2[2], l2[3], h2[0], h2[1], h2[2], h2[3]}, o[d0], 0, 0, 0);   \
        o[d0] = __builtin_amdgcn_mfma_f32_32x32x16_bf16(pa3, (bf16x8){l3[0], l3[1], l3[2], l3[3], h3[0], h3[1], h3[2], h3[3]}, o[d0], 0, 0, 0); } while (0)
    PV_D0(0); PV_D0(1); PV_D0(2); PV_D0(3);
#undef PV_D0
#undef TRRD
}

template <class TIn, class TOut> struct BlockRef { const TIn* Q; const TIn* K; const TIn* V; TOut* O; int P0; };
template <class TIn> struct Seam {
    bf16x8 qr[8];
    bf16x8 st_k0, st_k1;
};
__device__ __forceinline__ int swa_jlo(int P0, int W) { const int lowk = P0 - W + 1; return lowk > 0 ? lowk / KVBLK : 0; }
#define ROW(p, k0, rr) ((p) + (unsigned)(((k0) + (rr)) * KVP + sc))
#define VMW() asm volatile("s_waitcnt vmcnt(0)" ::: "memory")
#define VMWN(n) asm volatile("s_waitcnt vmcnt(%0)" :: "i"(n) : "memory")
#define SLOAD_F(p, k0) do { S.st_k0 = load8<TIn>(ROW(p, k0, sr)); S.st_k1 = load8<TIn>(ROW(p, k0, 32 + sr)); } while (0)
#define SWRITE_KF(bf) do { *(bf16x8*)(K_lds + (bf) * SHM_K + kws) = S.st_k0; *(bf16x8*)(K_lds + (bf) * SHM_K + kws + 32 * 256) = S.st_k1; } while (0)
#define SWRITE_VF(bf) do { *(bf16x8*)(V_lds + (bf) * SHM_V + vst0) = S.st_k0; *(bf16x8*)(V_lds + (bf) * SHM_V + vst1) = S.st_k1; } while (0)
template <class TIn, class TOut>
__device__ __forceinline__ void causal_swa_prime(const BlockRef<TIn, TOut>& cur, int W, char* lds, Seam<TIn>& S) {
    int tid_ = threadIdx.x; asm volatile("" : "+v"(tid_));
    const int tid = tid_, wid = __builtin_amdgcn_readfirstlane(tid >> 6), lane = tid & 63, r32 = lane & 31, hi = lane >> 5;
    const int sr = tid >> 4, sc = (tid & 15) * 8, kws = KSWZ(sr, sc * 2); char* K_lds = lds + 2 * SHM_V;
    const int kb0 = swa_jlo(cur.P0, W) * KVBLK;
    for (int d0 = 0; d0 < 8; ++d0) S.qr[d0] = load8<TIn>(cur.Q + (unsigned)((wid * QBLK + r32) * QP + hi * 8) + d0 * 16);
    SLOAD_F(cur.K, kb0); VMW(); SWRITE_KF(0); SBAR(); SLOAD_F(cur.V, kb0);
    __syncthreads();
}
template <class TIn, class TOut>
__device__ __forceinline__ void causal_swa_block(const BlockRef<TIn, TOut>& cur, const BlockRef<TIn, TOut>& nxt, int skv, int W, char* lds, Seam<TIn>& S) {
    int tid_ = threadIdx.x; asm volatile("" : "+v"(tid_));
    const int tid = tid_, wid = __builtin_amdgcn_readfirstlane(tid >> 6), lane = tid & 63, r32 = lane & 31, hi = lane >> 5;
    const int j_lo = swa_jlo(cur.P0, W);
    int j_hi = (cur.P0 + QB - 1) / KVBLK + 1; if (j_hi > skv / KVBLK) j_hi = skv / KVBLK;
    const int NT = j_hi - j_lo;
    const int kbn = swa_jlo(nxt.P0, W) * KVBLK;
    const int qlo = cur.P0 + wid * QBLK, qm = qlo + r32 - 4 * hi;
    char* V_lds = lds; char* K_lds = lds + 2 * SHM_V;
    float* ws = (float*)(lds + 2 * SHM_V + 2 * SHM_K) + wid * 64; float* li_l = ws, * al_l = ws + 32;
    float m_reg = -1e30f, l_reg = 0; f32x16 o[4] = {};
    const int sr = tid >> 4, sc = (tid & 15) * 8, vst0 = v_st(sr, sc), vst1 = v_st(32 + sr, sc), kws = KSWZ(sr, sc * 2);
    const int vb0 = (int)(uintptr_t)V_lds + v_rd_base(lane);
    const TIn* Kh = cur.K; const TIn* Vh = cur.V;
    const float* btab = (const float*)(lds + BIAS_OFF) + 4 * hi;
#define RESC(a) do { if (__any((a) < 1.f)) { if (hi == 0) al_l[r32] = (a); asm volatile("s_waitcnt lgkmcnt(0)" ::: "memory");              \
                     for (int d_ = 0; d_ < 4; ++d_) for (int r = 0; r < 16; ++r) o[d_][r] *= al_l[crow(r, hi)]; } } while (0)
#define KBASE(t) ((j_lo + (t)) * KVBLK)
#define ACT(t) (KBASE(t) <= qlo + QBLK - 1 && KBASE(t) + KVBLK - 1 >= qlo - W + 1)
#define MASKT(P0_, P1_, t) do { const int kb_ = KBASE(t); if ((!SK || ACT(t)) && (kb_ + KVBLK - 1 > qlo || kb_ <= qlo + QBLK - 1 - W)) mask_tile(P0_, P1_, qm - kb_, (unsigned)W); } while (0)
    constexpr int NQL = 8;
    constexpr bool SK = WSKIP;
#define SEAM_K0() do { VMWN(NQL); SWRITE_KF(0); SBAR(); SLOAD_F(nxt.V, kbn); SBAR(); } while (0)
    f32x16 pA0, pA1, pB0, pB1; float mnA, mnB, alA, alB; bf16x8 pa0, pa1, pa2, pa3;
    VMW(); SWRITE_VF(0); SBAR();
    if (NT > 1) { SLOAD_F(Kh, KBASE(1)); }
    SBAR(); qkt<0, SK>(pA0, pA1, K_lds, r32, hi, S.qr, ACT(0), btab + KBASE(0));
    if (NT > 1) { VMW(); SWRITE_KF(1); SBAR(); SLOAD_F(Vh, KBASE(1)); }
    MASKT(pA0, pA1, 0); partialSM(pA0, pA1, m_reg, mnA, alA);
    if (NT > 1) { VMW(); SWRITE_VF(1); SBAR(); if (NT > 2) SLOAD_F(Kh, KBASE(2)); }
    __syncthreads();
#define HALF_STEP(PX0, PX1, mnX, alX, PY0, PY1, alY, t, KB, VB, SB) do {                                                      \
        SBAR(); qkt<KB, SK>(PX0, PX1, K_lds, r32, hi, S.qr, ACT(t), btab + KBASE(t));                                             \
        finishSM(PY0, PY1, alY, l_reg, pa0, pa1, pa2, pa3); SBAR();                                                           \
        if ((t) + 1 < NT) { VMW(); SWRITE_KF(SB); SBAR(); SLOAD_F(Vh, KBASE((t) + 1)); SBAR(); }                              \
        pv_tile<VB, SK>(o, vb0, pa0, pa1, pa2, pa3, ACT((t) - 1)); MASKT(PX0, PX1, (t)); partialSM(PX0, PX1, m_reg, mnX, alX);                                        \
        __syncthreads();                                                                                                      \
        if ((t) + 1 < NT) { VMW(); SWRITE_VF(SB); SBAR(); if ((t) + 2 < NT) SLOAD_F(Kh, KBASE((t) + 2)); }                    \
        RESC(alX); __syncthreads(); } while (0)
    for (int t = 1; t + 1 < NT; t += 2) {
        HALF_STEP(pB0, pB1, mnB, alB, pA0, pA1, alA, t, 1, 0, 0);
        HALF_STEP(pA0, pA1, mnA, alA, pB0, pB1, alB, t + 1, 0, 1, 1);
    }
    const bool even = (NT & 1) == 0;
    if (even) { SBAR(); qkt<1, SK>(pB0, pB1, K_lds, r32, hi, S.qr, ACT(NT - 1), btab + KBASE(NT - 1)); SBAR(); }
    SLOAD_F(nxt.K, kbn); SBAR();
#pragma unroll
    for (int d0 = 0; d0 < 8; ++d0) S.qr[d0] = load8<TIn>(nxt.Q + (unsigned)((wid * QBLK + r32) * QP + hi * 8) + d0 * 16);
    SBAR();
    finishSM(pA0, pA1, alA, l_reg, pa0, pa1, pa2, pa3); SBAR();
    pv_tile<0, SK>(o, vb0, pa0, pa1, pa2, pa3, ACT(even ? NT - 2 : NT - 1));
    if (even) { MASKT(pB0, pB1, NT - 1); partialSM(pB0, pB1, m_reg, mnB, alB); __syncthreads(); RESC(alB);
        finishSM(pB0, pB1, alB, l_reg, pa0, pa1, pa2, pa3); SBAR(); pv_tile<1, SK>(o, vb0, pa0, pa1, pa2, pa3, ACT(NT - 1)); }
    SBAR(); SEAM_K0();
    if (hi == 0) li_l[r32] = l_reg; asm volatile("s_waitcnt lgkmcnt(0)" ::: "memory");
    float rli[16];
#pragma unroll
    for (int r = 0; r < 16; ++r) rli[r] = __builtin_amdgcn_rcpf(li_l[crow(r, hi)]);
    TOut* Ow = cur.O + (unsigned)(wid * QBLK * OP);
#pragma unroll
    for (int r = 0; r < 16; ++r) { const int orow = crow(r, hi);
#pragma unroll
        for (int d0 = 0; d0 < 4; ++d0) { const float v = o[d0][r] * rli[r];
            if constexpr (same_t<TOut, float>::v) { Ow[(unsigned)(orow * OP + d0 * 32 + r32)] = v; }
            else { const float vn = __shfl_xor(v, 1);
                   if ((r32 & 1) == 0) *(unsigned*)(Ow + (unsigned)(orow * OP + d0 * 32 + r32)) = cvtpk(v, vn); } } }
    __syncthreads();
#undef RESC
#undef KBASE
#undef ACT
#undef MASKT
#undef SEAM_K0
#undef HALF_STEP
}
#undef ROW
#undef VMW
#undef VMWN
#undef SLOAD_F
#undef SWRITE_KF
#undef SWRITE_VF
__device__ __forceinline__ BlockRef<bf16, bf16> fox_ref(int L, int pass, const bf16* FQKV, bf16* OFOX) {
    const int bh = L >> 3, x = L & 7, qb = pass ? 15 - x : x, b = bh >> 4, h = bh & 15;
    BlockRef<bf16, bf16> r; const size_t row0 = (size_t)b * 4096;
    r.Q = FQKV + (row0 + (size_t)qb * QB) * QP + h * 128; r.K = FQKV + row0 * KVP + 2048 + h * 128; r.V = FQKV + row0 * KVP + 4096 + h * 128;
    r.O = OFOX + (row0 + (size_t)qb * QB) * OP + h * 128; r.P0 = qb * QB; return r;
}
__device__ __forceinline__ void fox_phase(char* lds, int vcu, int G, const bf16* FQKV, bf16* OFOX, const float* FB) {
    constexpr int total = 256, SKV_ = 4096, W = 4096;
    for (int L = vcu; L < total; L += G) {
        __syncthreads();
        { int tid = threadIdx.x; asm volatile("" : "+v"(tid));
          const float* fb = FB + (size_t)(L >> 3) * 4096 + tid * 8; float* tb = (float*)(lds + BIAS_OFF) + tid * 8;
          const f32x4 v0 = *(const f32x4*)fb, v1 = *(const f32x4*)(fb + 4); *(f32x4*)tb = v0; *(f32x4*)(tb + 4) = v1; }
        BlockRef<bf16, bf16> cur = fox_ref(L, 0, FQKV, OFOX); const BlockRef<bf16, bf16> b1 = fox_ref(L, 1, FQKV, OFOX);
        Seam<bf16> S;
        causal_swa_prime<bf16, bf16>(cur, W, lds, S);
        for (int pass = 0; pass < 2; ++pass) {
            causal_swa_block<bf16, bf16>(cur, b1, SKV_, W, lds, S);
            cur = b1; }
    }
}
}

struct Ctx { LAS unsigned char* lds; int wave, gw, NW, G; };

__device__ __forceinline__ void transpose_item(const float* W, int ldw, int k0, int c0, bf16* WT, int K, int r0, LAS float* scr, int lane) {
#pragma unroll 8
    for (int i = 0; i < 32; ++i) { const int kk = 2 * i + (lane >> 5); scr[kk * 33 + (lane & 31)] = W[(size_t)(k0 + kk) * ldw + c0 + (lane & 31)]; }
    asm volatile("s_waitcnt lgkmcnt(0)" ::: "memory");
    const int c = lane & 7;
#pragma unroll
    for (int j = 0; j < 4; ++j) { const int n = (lane >> 3) + 8 * j; const LAS float* s = scr + (8 * c) * 33 + n;
        u32x4 o; o.x = pk2(s[0 * 33], s[1 * 33]); o.y = pk2(s[2 * 33], s[3 * 33]); o.z = pk2(s[4 * 33], s[5 * 33]); o.w = pk2(s[6 * 33], s[7 * 33]);
        *(u32x4*)(WT + (size_t)(r0 + n) * K + k0 + 8 * c) = o; }
    asm volatile("s_waitcnt lgkmcnt(0)" ::: "memory");
}
__device__ __forceinline__ void map_rows(int mode, int nb, int& c0, int& r0) {
    const int n0 = nb * 32;
    if (mode == 0) { c0 = n0; r0 = n0; }
    else if (mode == 1) { r0 = n0; c0 = n0 < 12288 ? n0 : (n0 < 18432 ? SRC_FQKV + (n0 - 12288) : SRC_MERGE + (n0 - 18432)); }
    else { c0 = n0; r0 = (n0 >> 7) * 256 + (n0 & 127) + (mode == 3 ? 128 : 0); }
}
__device__ __forceinline__ void ph_transpose(const Ctx& c, const float* W, int K, int ldw, int ncols, bf16* WT, int mode) {
    LAS float* scr = (LAS float*)(c.lds + c.wave * 16384); int lane = threadIdx.x & 63; asm volatile("" : "+v"(lane));
    const int nblk = ncols / 32, nitems = (K / 64) * nblk;
    for (int it = c.gw; it < nitems; it += c.NW) { const int kb = it / nblk, nb = it % nblk; int c0, r0; map_rows(mode, nb, c0, r0);
        transpose_item(W, ldw, kb * 64, c0, WT, K, r0, scr, lane); }
}
__device__ __forceinline__ void ph_wsmall(const Ctx& c, const float* w_in, float* wsm) {
    int lane = threadIdx.x & 63; asm volatile("" : "+v"(lane));
    for (int idx = c.gw * 64 + lane; idx < DEPTH * D * NSM; idx += c.NW * 64) {
        const int j = idx % NSM, k = (idx / NSM) % D, l = idx / (NSM * D);
        const int sc = j < 32 ? SRC_B + j : (j < 64 ? SRC_A + (j - 32) : SRC_F + (j - 64));
        wsm[((size_t)l * NSM + j) * D + k] = w_in[((size_t)l * D + k) * NIN + sc]; }
}
__device__ __forceinline__ void ph_adaln(const Ctx& c, const float* cin, const float* w_ada, const float* b_ada, float* mod) {
    LAS float* cond = (LAS float*)c.lds;
    LAS float* red = (LAS float*)(c.lds + 16384);
    int tid = threadIdx.x; asm volatile("" : "+v"(tid)); const int lane = tid & 63;
    for (int i = tid; i < 2 * D; i += 512) cond[i] = fsilu(cin[i]);
    __syncthreads();
    const int ntask = DEPTH * (6 * D / 64);
    for (int task = blockIdx.x; task < ntask; task += c.G) {
        const int l = task / (6 * D / 64), n = (task % (6 * D / 64)) * 64 + lane;
        const float* w = w_ada + (size_t)l * D * (6 * D) + n; float a0 = 0.f, a1 = 0.f;
#pragma unroll 8
        for (int k = c.wave * 256; k < c.wave * 256 + 256; ++k) { const float wv = w[(size_t)k * (6 * D)]; a0 += cond[k] * wv; a1 += cond[D + k] * wv; }
        red[(c.wave * 2 + 0) * 64 + lane] = a0; red[(c.wave * 2 + 1) * 64 + lane] = a1;
        __syncthreads();
        if (tid < 128) { const int b = tid >> 6; float s = b_ada[(size_t)l * 6 * D + n];
#pragma unroll
            for (int w8 = 0; w8 < 8; ++w8) s += red[(w8 * 2 + b) * 64 + lane];
            mod[((size_t)l * 2 + b) * (6 * D) + n] = s; }
        __syncthreads();
    }
}

struct RowArgs { const float* xin; float* x; const float* Y; const float* gy; const float* gate; const float* gn; const float* scale; const float* shift; bf16* H; const float* wsm; float* baf; int has_y, has_h, has_small; };
__device__ __forceinline__ void ph_rowpass(const Ctx& c, const RowArgs& a) {
    int lane = threadIdx.x & 63; asm volatile("" : "+v"(lane));
    for (int m = c.gw; m < M; m += c.NW) {
        const int b = m / T; const size_t ro = (size_t)m * D; const int mo = b * 6 * D;
        f32x4 v[8];
#pragma unroll
        for (int i = 0; i < 8; ++i) v[i] = *(const f32x4*)(a.xin + ro + 4 * lane + 256 * i);
        if (a.has_y) {
            f32x4 y[8]; float ss = 0.f;
#pragma unroll
            for (int i = 0; i < 8; ++i) { y[i] = *(const f32x4*)(a.Y + ro + 4 * lane + 256 * i); ss += (y[i][0] * y[i][0] + y[i][1] * y[i][1]) + (y[i][2] * y[i][2] + y[i][3] * y[i][3]); }
            const float r = rsqrtf(wave_sum(ss) * (1.0f / D) + EPS);
#pragma unroll
            for (int i = 0; i < 8; ++i) { const int cc = 4 * lane + 256 * i; const f32x4 g = *(const f32x4*)(a.gy + cc), gt = *(const f32x4*)(a.gate + mo + cc);
                v[i] = v[i] + gt * (y[i] * r * g); }
        }
#pragma unroll
        for (int i = 0; i < 8; ++i) *(f32x4*)(a.x + ro + 4 * lane + 256 * i) = v[i];
        if (!a.has_h) continue;
        float ss = 0.f;
#pragma unroll
        for (int i = 0; i < 8; ++i) ss += (v[i][0] * v[i][0] + v[i][1] * v[i][1]) + (v[i][2] * v[i][2] + v[i][3] * v[i][3]);
        const float r = rsqrtf(wave_sum(ss) * (1.0f / D) + EPS);
#pragma unroll
        for (int i = 0; i < 8; ++i) { const int cc = 4 * lane + 256 * i; const f32x4 g = *(const f32x4*)(a.gn + cc), sc = *(const f32x4*)(a.scale + mo + cc), sh = *(const f32x4*)(a.shift + mo + cc);
            v[i] = v[i] * r * g * (sc + 1.0f) + sh;
            u32x2 w; w.x = pk2(v[i][0], v[i][1]); w.y = pk2(v[i][2], v[i][3]); *(u32x2*)(a.H + ro + cc) = w; }
        if (!a.has_small) continue;
        float keep0 = 0.f, keep1 = 0.f;
        for (int j = 0; j < NSM; ++j) { const float* wr = a.wsm + (size_t)j * D; float p = 0.f;
#pragma unroll
            for (int i = 0; i < 8; ++i) { const f32x4 w = *(const f32x4*)(wr + 4 * lane + 256 * i); p += (v[i][0] * w[0] + v[i][1] * w[1]) + (v[i][2] * w[2] + v[i][3] * w[3]); }
            p = wave_sum(p);
            if (j < 64) { if (lane == j) keep0 = p; } else { if (lane == j - 64) keep1 = p; } }
        a.baf[(size_t)m * NSM + lane] = keep0;
        if (lane < 16) a.baf[(size_t)m * NSM + 64 + lane] = keep1;
    }
}

__device__ __forceinline__ void ph_conv(const Ctx& c, const bf16* raw, const float* convw  , bf16* dnc) {
    int lane = threadIdx.x & 63; asm volatile("" : "+v"(lane));
    for (int gw = c.gw; gw < M * 64; gw += c.NW) {
        const int hv = gw & 63, m = gw >> 6, t = m % T, ch = hv * 128 + 2 * lane;
        const f32x4 w0 = *(const f32x4*)(convw + (size_t)ch * 4), w1 = *(const f32x4*)(convw + (size_t)ch * 4 + 4);
        float a0 = 0.f, a1 = 0.f;
#pragma unroll
        for (int j = 0; j < 4; ++j) { const int tt = t - 3 + j; if (tt >= 0) { const unsigned u = *(const unsigned*)(raw + (size_t)(m - 3 + j) * DN_CONV + ch); a0 += w0[j] * bf_lo(u); a1 += w1[j] * bf_hi(u); } }
        a0 = fsilu(a0); a1 = fsilu(a1);
        if (hv < 32) { const float ss = wave_sum(a0 * a0 + a1 * a1); float r = rsqrtf(ss + EPS); if (hv < 16) r *= 0.08838834764831845f; a0 *= r; a1 *= r; }
        *(unsigned*)(dnc + (size_t)m * DN_CONV + ch) = pk2(a0, a1);
    }
}
__device__ __forceinline__ float softplus_f(float x) { return fmaxf(x, 0.f) + log1pf(__expf(-fabsf(x))); }
__device__ __forceinline__ void ph_gates(const Ctx& c, const float* baf, const float* a_log, const float* dt_bias, const float* f_bias, float* beta, float* g, float* logf) {
    int lane = threadIdx.x & 63; asm volatile("" : "+v"(lane));
    for (int idx = c.gw * 64 + lane; idx < M * NSM; idx += c.NW * 64) {
        const int m = idx / NSM, j = idx % NSM; const float v = baf[idx];
        if (j < 32) beta[(size_t)m * 32 + j] = 1.0f / (1.0f + expf(-v));
        else if (j < 64) { const int h = j - 32; g[(size_t)m * 32 + h] = -expf(a_log[h]) * softplus_f(v + dt_bias[h]); }
        else { const int h = j - 64; logf[(size_t)m * 16 + h] = -softplus_f(-(v + f_bias[h])); } }
}
__device__ __forceinline__ void ph_fcum(const Ctx& c, const float* logf, float* fc) {
    int lane = threadIdx.x & 63; asm volatile("" : "+v"(lane));
    for (int bh = c.gw; bh < NB * FOXH; bh += c.NW) { const int b = bh / FOXH, h = bh % FOXH; float carry = 0.f;
        for (int t0 = 0; t0 < T; t0 += 64) { float v = logf[(size_t)(b * T + t0 + lane) * 16 + h];
#pragma unroll
            for (int o = 1; o < 64; o <<= 1) { const float u = __shfl_up(v, o); if (lane >= o) v += u; }
            v += carry; fc[(size_t)bh * T + t0 + lane] = v * (-11.313708498984761f); carry = __shfl(v, 63); } }
}
__device__ __forceinline__ void ph_dn_naive(const Ctx& c, const bf16* dnc, const float* g, const float* beta, float* o) {
    int lane = threadIdx.x & 63; asm volatile("" : "+v"(lane));
    constexpr int TB = 16;
    for (int gw = c.gw; gw < NB * 32 * 128; gw += c.NW) {
        const int j = gw & 127, hv = (gw >> 7) & 31, b = gw >> 12, hq = hv >> 1;
        const bf16* rowq = dnc + (size_t)b * T * DN_CONV + hq * 128 + 2 * lane; const bf16* rowv = dnc + (size_t)b * T * DN_CONV + 4096 + hv * 128 + j;
        const float* gp = g + (size_t)b * T * 32 + hv; const float* bp = beta + (size_t)b * T * 32 + hv;
        unsigned qa[TB], ka[TB]; float va[TB], ga[TB], ba[TB];
#pragma unroll
        for (int i = 0; i < TB; ++i) { qa[i] = *(const unsigned*)(rowq + (size_t)i * DN_CONV); ka[i] = *(const unsigned*)(rowq + (size_t)i * DN_CONV + 2048); va[i] = bf2f(rowv[(size_t)i * DN_CONV]); ga[i] = gp[i * 32]; ba[i] = bp[i * 32]; }
        float s0 = 0.f, s1 = 0.f;
        for (int t0 = 0; t0 < T; t0 += TB) {
            unsigned qn[TB], kn[TB]; float vn[TB], gn[TB], bn[TB];
            const int tn = (t0 + TB < T) ? t0 + TB : t0;
#pragma unroll
            for (int i = 0; i < TB; ++i) { const size_t tt = (size_t)(tn + i); qn[i] = *(const unsigned*)(rowq + tt * DN_CONV); kn[i] = *(const unsigned*)(rowq + tt * DN_CONV + 2048); vn[i] = bf2f(rowv[tt * DN_CONV]); gn[i] = gp[tt * 32]; bn[i] = bp[tt * 32]; }
#pragma unroll
            for (int i = 0; i < TB; ++i) {
                const float q0 = bf_lo(qa[i]), q1 = bf_hi(qa[i]), k0 = bf_lo(ka[i]), k1 = bf_hi(ka[i]), eg = __expf(ga[i]);
                s0 *= eg; s1 *= eg;
                float dk = s0 * k0 + s1 * k1, dq = s0 * q0 + s1 * q1, kq = k0 * q0 + k1 * q1;
#pragma unroll
                for (int of = 1; of < 64; of <<= 1) { dk += __shfl_xor(dk, of); dq += __shfl_xor(dq, of); kq += __shfl_xor(kq, of); }
                const float cc = ba[i] * (va[i] - dk);
                s0 += cc * k0; s1 += cc * k1;
                if (lane == 0) o[((size_t)b * T + t0 + i) * 4096 + hv * 128 + j] = dq + cc * kq; }
#pragma unroll
            for (int i = 0; i < TB; ++i) { qa[i] = qn[i]; ka[i] = kn[i]; va[i] = vn[i]; ga[i] = gn[i]; ba[i] = bn[i]; }
        }
    }
}
__device__ __forceinline__ void ph_dn_norm(const Ctx& c, const float* o, const float* norm_w, const bf16* zs, bf16* odn) {
    int lane = threadIdx.x & 63; asm volatile("" : "+v"(lane));
    for (int gw = c.gw; gw < M * 32; gw += c.NW) { const size_t off = (size_t)gw * 128 + 2 * lane;
        const float a0 = o[off], a1 = o[off + 1]; const float r = rsqrtf(wave_sum(a0 * a0 + a1 * a1) * (1.0f / 128.0f) + EPS);
        const unsigned zu = *(const unsigned*)(zs + off);
        *(unsigned*)(odn + off) = pk2(a0 * r * norm_w[2 * lane] * bf_lo(zu), a1 * r * norm_w[2 * lane + 1] * bf_hi(zu)); }
}
constexpr int RING_BYTES = 131072;
constexpr int LDSCTL_OFF = RING_BYTES, MISC_OFF = LDSCTL_OFF + 320;
constexpr int LDS_BYTES = 147456;


namespace dn {
typedef short bf16x8 __attribute__((ext_vector_type(8)));
typedef short s16x4 __attribute__((ext_vector_type(4)));
typedef float f32x16 __attribute__((ext_vector_type(16)));
typedef float f32x8 __attribute__((ext_vector_type(8)));
typedef __bf16 bf16x8_t __attribute__((ext_vector_type(8)));
#define DN_MFMA(a, b, c) __builtin_amdgcn_mfma_f32_32x32x16_bf16((a), (b), (c), 0, 0, 0)
constexpr int UNIT_FRAGS = 54;
constexpr int F_NW = 0, F_QG = 16, F_KGT = 32, F_AT = 48;
constexpr int UNIT_BYTES = UNIT_FRAGS * 1024;
constexpr int DU_UNIT = 4 * 2 * 64 * 16;

template <int S> __device__ __forceinline__ bf16x8 pack_step(const f32x16& x) {
    const f32x8 v = {x[8 * S + 0], x[8 * S + 1], x[8 * S + 2], x[8 * S + 3], x[8 * S + 4], x[8 * S + 5], x[8 * S + 6], x[8 * S + 7]};
    return __builtin_bit_cast(bf16x8, __builtin_convertvector(v, bf16x8_t));
}
__device__ __forceinline__ bf16x8 pack8(const f32x8& v) { return __builtin_bit_cast(bf16x8, __builtin_convertvector(v, bf16x8_t)); }
__device__ __forceinline__ f32x8 unpack8(const bf16x8& b) { f32x8 v;
#pragma unroll
    for (int j = 0; j < 8; ++j) v[j] = __uint_as_float(((unsigned)(unsigned short)b[j]) << 16);
    return v; }
__device__ __forceinline__ bf16x8 tr_frag(LAS unsigned char* a0  , int col0, int kb, int st) {
    LAS s16x4* p = (LAS s16x4*)(a0 + (32 * kb + 16 * st) * 256 + col0 * 2);
    const s16x4 lo = __builtin_amdgcn_ds_read_tr16_b64_v4i16(p), hi = __builtin_amdgcn_ds_read_tr16_b64_v4i16(p + 256);
    return __builtin_shufflevector(lo, hi, 0, 1, 2, 3, 4, 5, 6, 7);
}
__device__ __forceinline__ LAS unsigned char* tr_base(LAS unsigned char* img, int lane) {
    const int i16 = lane & 15, q = i16 >> 2, p = i16 & 3, cblk = (lane >> 4) & 1, h = lane >> 5;
    return img + (4 * h + q) * 256 + cblk * 32 + 8 * p;
}

__device__ __forceinline__ f32x16 mm2(const bf16x8& a0, const bf16x8& a1, const bf16x8& b0, const bf16x8& b1, f32x16 c) { c = DN_MFMA(a0, b0, c); c = DN_MFMA(a1, b1, c); return c; }
__device__ __forceinline__ void inv_diag(const f32x16& Y, const f32x16& Yt, int r, int h, f32x16& R, f32x16& Rt) {
    f32x16 Yd = Y, Ysub = {}, Ytd = Yt, Ytsub = {};
#pragma unroll
    for (int rr = 8; rr < 16; ++rr) { if (r < 16) { Ysub[rr] = Yd[rr]; Yd[rr] = 0.f; } }
#pragma unroll
    for (int rr = 0; rr < 8; ++rr) { if (r >= 16) { Ytsub[rr] = Ytd[rr]; Ytd[rr] = 0.f; } }
    f32x16 D = Yd, Dt = Ytd;
#pragma unroll
    for (int rr = 0; rr < 16; ++rr) { const float e = ((rr & 3) + 8 * (rr >> 2) + 4 * h == r) ? 1.f : 0.f; D[rr] += e; Dt[rr] += e; }
    bf16x8 Zp0 = pack_step<0>(Yd), Zp1 = pack_step<1>(Yd), Ztp0 = pack_step<0>(Ytd), Ztp1 = pack_step<1>(Ytd);
#pragma unroll 1
    for (int it = 0; it < 3; ++it) {
        const f32x16 zn = mm2(Ztp0, Ztp1, Zp0, Zp1, (f32x16){}), ztn = mm2(Zp0, Zp1, Ztp0, Ztp1, (f32x16){});
        Zp0 = pack_step<0>(zn); Zp1 = pack_step<1>(zn); Ztp0 = pack_step<0>(ztn); Ztp1 = pack_step<1>(ztn);
        const bf16x8 dp0 = pack_step<0>(D), dp1 = pack_step<1>(D), dtp0 = pack_step<0>(Dt), dtp1 = pack_step<1>(Dt);
        Dt = mm2(Zp0, Zp1, dtp0, dtp1, Dt); D = mm2(Ztp0, Ztp1, dp0, dp1, D);
        __builtin_amdgcn_sched_barrier(0);
    }
    const bf16x8 dp0 = pack_step<0>(D), dp1 = pack_step<1>(D), dtp0 = pack_step<0>(Dt), dtp1 = pack_step<1>(Dt);
    const f32x16 M1 = mm2(pack_step<0>(Ytsub), pack_step<1>(Ytsub), dp0, dp1, (f32x16){});
    const f32x16 M1t = mm2(pack_step<0>(Ysub), pack_step<1>(Ysub), dtp0, dtp1, (f32x16){});
    R = mm2(dtp0, dtp1, pack_step<0>(M1), pack_step<1>(M1), D);
    Rt = mm2(dp0, dp1, pack_step<0>(M1t), pack_step<1>(M1t), Dt);
}

__device__ __forceinline__ void prep_unit(int u, const bf16* DNC, const float* GG, const float* BETA, unsigned char* DNP, float* DU, float* EGL,
                                          LAS unsigned char* img, LAS float* tbl, int lane) {
    const int b = u >> 11, hv = (u >> 6) & 31, n = u & 63, hq = hv >> 1, m0 = b * T + n * 64, r = lane & 31, h = lane >> 5;
    const bf16* qbase = DNC + (size_t)m0 * DN_CONV + hq * 128; const bf16* kbase = qbase + 2048; const bf16* vbase = DNC + (size_t)m0 * DN_CONV + 4096 + hv * 128;
    unsigned char* outp = DNP + (size_t)u * UNIT_BYTES + lane * 16;
    float gc = GG[(size_t)(m0 + lane) * 32 + hv]; const float be = BETA[(size_t)(m0 + lane) * 32 + hv];
#pragma unroll
    for (int o = 1; o < 64; o <<= 1) { const float t = __shfl_up(gc, o); if (lane >= o) gc += t; }
    const float glast = __shfl(gc, 63);
    tbl[lane] = gc; tbl[64 + lane] = be;
    if (lane == 0) EGL[u] = __expf(glast);
    asm volatile("s_waitcnt lgkmcnt(0)" ::: "memory");
    const float gcol[2] = {tbl[r], tbl[32 + r]}, bcol[2] = {tbl[64 + r], tbl[96 + r]};
    bf16x8 kf[2][8];
#pragma unroll
    for (int i = 0; i < 2; ++i)
#pragma unroll
        for (int s = 0; s < 8; ++s) kf[i][s] = *(const bf16x8*)(kbase + (unsigned)((32 * i + r) * DN_CONV + 16 * s + 8 * h));
    {
        bf16x8 qf[2][8];
#pragma unroll
        for (int i = 0; i < 2; ++i)
#pragma unroll
            for (int s = 0; s < 8; ++s) qf[i][s] = *(const bf16x8*)(qbase + (unsigned)((32 * i + r) * DN_CONV + 16 * s + 8 * h));
#pragma unroll
        for (int t = 0; t < 3; ++t) { const int I = (t == 2) ? 1 : 0, J = (t == 0) ? 0 : 1;
            f32x16 acc = {};
#pragma unroll
            for (int s = 0; s < 8; ++s) acc = DN_MFMA(kf[I][s], qf[J][s], acc);
#pragma unroll
            for (int g4 = 0; g4 < 4; ++g4) { const f32x4 gs = *(const LAS f32x4*)(tbl + 32 * I + 8 * g4 + 4 * h);
#pragma unroll
                for (int j = 0; j < 4; ++j) { const int rr = 4 * g4 + j; const bool ok = (I != J) || (8 * g4 + 4 * h + j <= r);
                    acc[rr] = ok ? acc[rr] * __expf(gcol[J] - gs[j]) : 0.f; } }
            *(bf16x8*)(outp + (F_AT + t * 2 + 0) * 1024) = pack_step<0>(acc); *(bf16x8*)(outp + (F_AT + t * 2 + 1) * 1024) = pack_step<1>(acc); }
    }
    __builtin_amdgcn_sched_barrier(0);
    f32x16 Z[3], Zt[3], Rt[3];
    {
        f32x16 KK[2][2];
#pragma unroll
        for (int I = 0; I < 2; ++I)
#pragma unroll
            for (int J = 0; J < 2; ++J) { f32x16 acc = {};
#pragma unroll
                for (int s = 0; s < 8; ++s) acc = DN_MFMA(kf[I][s], kf[J][s], acc);
                KK[I][J] = acc; }
#pragma unroll
        for (int t = 0; t < 3; ++t) { const int I = (t == 2) ? 1 : 0, J = (t == 0) ? 0 : 1; f32x16 x;
#pragma unroll
            for (int g4 = 0; g4 < 4; ++g4) { const f32x4 gs = *(const LAS f32x4*)(tbl + 32 * I + 8 * g4 + 4 * h);
#pragma unroll
                for (int j = 0; j < 4; ++j) { const int rr = 4 * g4 + j; const bool ok = (I != J) || (8 * g4 + 4 * h + j < r);
                    x[rr] = ok ? -bcol[J] * KK[I][J][rr] * __expf(gcol[J] - gs[j]) : 0.f; } }
            Zt[t] = x; }
#pragma unroll
        for (int t = 0; t < 3; ++t) { const int I = (t == 0) ? 0 : 1, J = (t == 2) ? 1 : 0; f32x16 x;
#pragma unroll
            for (int g4 = 0; g4 < 4; ++g4) { const f32x4 gcr = *(const LAS f32x4*)(tbl + 32 * I + 8 * g4 + 4 * h), ber = *(const LAS f32x4*)(tbl + 64 + 32 * I + 8 * g4 + 4 * h);
#pragma unroll
                for (int j = 0; j < 4; ++j) { const int rr = 4 * g4 + j; const bool ok = (I != J) || (r < 8 * g4 + 4 * h + j);
                    x[rr] = ok ? -ber[j] * KK[I][J][rr] * __expf(gcr[j] - gcol[J]) : 0.f; } }
            Z[t] = x; }
    }
    __builtin_amdgcn_sched_barrier(0);
    {
        f32x16 R0, Rt0, R1, Rt1;
        inv_diag(Z[0], Zt[0], r, h, R0, Rt0);
        __builtin_amdgcn_sched_barrier(0);
        inv_diag(Z[2], Zt[2], r, h, R1, Rt1);
        __builtin_amdgcn_sched_barrier(0);
        const f32x16 Pm = mm2(pack_step<0>(Z[1]), pack_step<1>(Z[1]), pack_step<0>(Rt1), pack_step<1>(Rt1), (f32x16){});
        Rt[1] = mm2(pack_step<0>(R0), pack_step<1>(R0), pack_step<0>(Pm), pack_step<1>(Pm), (f32x16){});
        Rt[0] = Rt0; Rt[2] = Rt1;
    }
    __builtin_amdgcn_sched_barrier(0);
    bf16x8 Rp[3][2];
#pragma unroll
    for (int t = 0; t < 3; ++t) { Rp[t][0] = pack_step<0>(Rt[t]); Rp[t][1] = pack_step<1>(Rt[t]); }
    LAS unsigned char* a0 = tr_base(img, lane);
    __builtin_amdgcn_sched_barrier(0);
#pragma unroll
    for (int itr = 0; itr < 16; ++itr) { const int ci = itr * 64 + lane, row = ci >> 4, cch = ci & 15;
        const f32x8 v = unpack8(*(const bf16x8*)(kbase + (unsigned)(row * DN_CONV + cch * 8))) * (tbl[64 + row] * __expf(tbl[row]));
        *(LAS bf16x8*)(img + row * 256 + cch * 16) = pack8(v); }
    asm volatile("s_waitcnt lgkmcnt(0)" ::: "memory");
#pragma unroll
    for (int kb = 0; kb < 4; ++kb)
#pragma unroll
        for (int cb = 0; cb < 2; ++cb) { f32x16 acc = {};
            if (cb == 0) { acc = DN_MFMA(tr_frag(a0, 32 * kb, 0, 0), Rp[0][0], acc); acc = DN_MFMA(tr_frag(a0, 32 * kb, 0, 1), Rp[0][1], acc); }
            else { acc = DN_MFMA(tr_frag(a0, 32 * kb, 0, 0), Rp[1][0], acc); acc = DN_MFMA(tr_frag(a0, 32 * kb, 0, 1), Rp[1][1], acc);
                   acc = DN_MFMA(tr_frag(a0, 32 * kb, 1, 0), Rp[2][0], acc); acc = DN_MFMA(tr_frag(a0, 32 * kb, 1, 1), Rp[2][1], acc); }
            acc = -acc;
            *(bf16x8*)(outp + (F_NW + (cb * 4 + kb) * 2 + 0) * 1024) = pack_step<0>(acc); *(bf16x8*)(outp + (F_NW + (cb * 4 + kb) * 2 + 1) * 1024) = pack_step<1>(acc); }
    asm volatile("s_waitcnt lgkmcnt(0)" ::: "memory");
    __builtin_amdgcn_sched_barrier(0);
#pragma unroll
    for (int itr = 0; itr < 16; ++itr) { const int ci = itr * 64 + lane, row = ci >> 4, cch = ci & 15;
        const f32x8 v = unpack8(*(const bf16x8*)(kbase + (unsigned)(row * DN_CONV + cch * 8))) * __expf(glast - tbl[row]);
        *(LAS bf16x8*)(img + row * 256 + cch * 16) = pack8(v); }
    asm volatile("s_waitcnt lgkmcnt(0)" ::: "memory");
#pragma unroll
    for (int kb = 0; kb < 4; ++kb)
#pragma unroll
        for (int cb = 0; cb < 2; ++cb)
#pragma unroll
            for (int st = 0; st < 2; ++st) *(bf16x8*)(outp + (F_KGT + (kb * 2 + cb) * 2 + st) * 1024) = tr_frag(a0, 32 * kb, cb, st);
    asm volatile("s_waitcnt lgkmcnt(0)" ::: "memory");
    __builtin_amdgcn_sched_barrier(0);
#pragma unroll
    for (int itr = 0; itr < 16; ++itr) { const int ci = itr * 64 + lane, row = ci >> 4, cch = ci & 15;
        const f32x8 v = unpack8(*(const bf16x8*)(vbase + (unsigned)(row * DN_CONV + cch * 8))) * tbl[64 + row];
        *(LAS bf16x8*)(img + row * 256 + cch * 16) = pack8(v); }
    asm volatile("s_waitcnt lgkmcnt(0)" ::: "memory");
    float* dup = DU + (size_t)u * DU_UNIT + lane * 16;
#pragma unroll
    for (int dvb = 0; dvb < 4; ++dvb)
#pragma unroll
        for (int cb = 0; cb < 2; ++cb) { f32x16 acc = {};
            if (cb == 0) { acc = DN_MFMA(Rp[0][0], tr_frag(a0, 32 * dvb, 0, 0), acc); acc = DN_MFMA(Rp[0][1], tr_frag(a0, 32 * dvb, 0, 1), acc); }
            else { acc = DN_MFMA(Rp[1][0], tr_frag(a0, 32 * dvb, 0, 0), acc); acc = DN_MFMA(Rp[1][1], tr_frag(a0, 32 * dvb, 0, 1), acc);
                   acc = DN_MFMA(Rp[2][0], tr_frag(a0, 32 * dvb, 1, 0), acc); acc = DN_MFMA(Rp[2][1], tr_frag(a0, 32 * dvb, 1, 1), acc); }
            float* d = dup + (dvb * 2 + cb) * 1024;
#pragma unroll
            for (int g4 = 0; g4 < 4; ++g4) *(f32x4*)(d + 4 * g4) = (f32x4){acc[4 * g4], acc[4 * g4 + 1], acc[4 * g4 + 2], acc[4 * g4 + 3]}; }
    __builtin_amdgcn_sched_barrier(0);
#pragma unroll
    for (int cb = 0; cb < 2; ++cb) { const float eg = __expf(gcol[cb]); const bf16* qrow = qbase + (unsigned)((32 * cb + r) * DN_CONV + 4 * h);
#pragma unroll
        for (int kb = 0; kb < 4; ++kb)
#pragma unroll
            for (int st = 0; st < 2; ++st) { const u32x2 lo = *(const u32x2*)(qrow + 32 * kb + 16 * st), hi = *(const u32x2*)(qrow + 32 * kb + 16 * st + 8);
                const f32x8 v = {bf_lo(lo.x) * eg, bf_hi(lo.x) * eg, bf_lo(lo.y) * eg, bf_hi(lo.y) * eg, bf_lo(hi.x) * eg, bf_hi(hi.x) * eg, bf_lo(hi.y) * eg, bf_hi(hi.y) * eg};
                *(bf16x8*)(outp + (F_QG + (cb * 4 + kb) * 2 + st) * 1024) = pack8(v); } }
    asm volatile("s_waitcnt lgkmcnt(0)" ::: "memory");
}
__device__ __forceinline__ void prep_phase(const Ctx& c, const bf16* DNC, const float* GG, const float* BETA, unsigned char* DNP, float* DU, float* EGL) {
    int lane = threadIdx.x & 63; asm volatile("" : "+v"(lane));
    LAS unsigned char* img = c.lds + c.wave * 16384; LAS float* tbl = (LAS float*)(c.lds + LDSCTL_OFF + 1024 + c.wave * 1024);
    for (int u = c.gw; u < NB * DN_VH * 64; u += c.NW) { int l2 = lane; asm volatile("" : "+v"(l2));
        prep_unit(u, DNC, GG, BETA, DNP, DU, EGL, img, tbl, l2); }
}

#define DN_BAR() do { asm volatile("s_waitcnt vmcnt(0) lgkmcnt(0)" ::: "memory"); __builtin_amdgcn_s_barrier(); asm volatile("" ::: "memory"); } while (0)
#define DN_BAR_L() do { asm volatile("s_waitcnt lgkmcnt(0)" ::: "memory"); __builtin_amdgcn_s_barrier(); asm volatile("" ::: "memory"); } while (0)
__device__ __forceinline__ void scan_head(int bh, LAS unsigned char* lds, const unsigned char* DNP, const float* DU, const float* EGL, const float* norm_w, const bf16* ZS, bf16* ODN) {
    int tid = threadIdx.x; asm volatile("" : "+v"(tid));
    const int lane = tid & 63, wave = __builtin_amdgcn_readfirstlane(tid >> 6), r = lane & 31, h = lane >> 5;
    LAS float* red = (LAS float*)(lds + 2 * UNIT_BYTES);
    LAS float* nwl = red + 512;
    const int b = bh >> 5, hv = bh & 31;
    const unsigned char* src = DNP + (size_t)bh * 64 * UNIT_BYTES;
    if (tid < 128) nwl[tid] = norm_w[tid];
    if (wave >= 4) {
        const int lw = wave - 4;
        for (int n = -1; n < 63; ++n) {
            const unsigned char* s = src + (size_t)(n + 1) * UNIT_BYTES + lane * 16; LAS unsigned char* d = lds + ((n + 1) & 1) * UNIT_BYTES;
#pragma unroll
            for (int f = 0; f < 14; ++f) { const int fr = lw + 4 * f; if (fr < UNIT_FRAGS) __builtin_amdgcn_global_load_lds((const unsigned*)(s + fr * 1024), (LAS unsigned*)(d + fr * 1024), 16, 0, 0); }
            DN_BAR();
        }
        DN_BAR();
    } else {
        const int dvb = wave;
        f32x16 S[4] = {}, OT[2] = {}, UN[2];
        u32x2 zq[2][4] = {};
        const float* dup = DU + (size_t)bh * 64 * DU_UNIT + dvb * 2048 + lane * 16;
        const float eglv = EGL[bh * 64 + lane];
        const size_t orow0 = (size_t)b * T * 4096 + hv * 128 + 32 * dvb + 4 * h;
#pragma unroll
        for (int cb = 0; cb < 2; ++cb)
#pragma unroll
            for (int g4 = 0; g4 < 4; ++g4) { const f32x4 v = *(const f32x4*)(dup + cb * 1024 + 4 * g4); UN[cb][4 * g4] = v[0]; UN[cb][4 * g4 + 1] = v[1]; UN[cb][4 * g4 + 2] = v[2]; UN[cb][4 * g4 + 3] = v[3]; }
        for (int n = 0; n < 64; ++n) {
            DN_BAR_L();
            if (n > 0) {
                const LAS float* rp = red + ((n - 1) & 1) * 256;
#pragma unroll
                for (int cb = 0; cb < 2; ++cb) { const int cc = 32 * cb + r; const float ss = rp[cc] + rp[64 + cc] + rp[128 + cc] + rp[192 + cc];
                    const float rs = rsqrtf(ss * (1.0f / 128.0f) + EPS); bf16* op = ODN + orow0 + (size_t)((n - 1) * 64 + cc) * 4096;
#pragma unroll
                    for (int g4 = 0; g4 < 4; ++g4) { const u32x2 z = zq[cb][g4]; const f32x4 nw = *(const LAS f32x4*)(nwl + 32 * dvb + 8 * g4 + 4 * h);
                        u32x2 w; w.x = pk2(OT[cb][4 * g4] * rs * nw[0] * bf_lo(z.x), OT[cb][4 * g4 + 1] * rs * nw[1] * bf_hi(z.x));
                        w.y = pk2(OT[cb][4 * g4 + 2] * rs * nw[2] * bf_lo(z.y), OT[cb][4 * g4 + 3] * rs * nw[3] * bf_hi(z.y));
                        *(u32x2*)(op + 8 * g4) = w; } } }
            const float egl = __shfl(eglv, n);
            const LAS unsigned char* fb = lds + (n & 1) * UNIT_BYTES + lane * 16;
#define DN_F(idx) (*(const LAS bf16x8*)(fb + (idx) * 1024))
            bf16x8 Sp[4][2];
#pragma unroll
            for (int kb = 0; kb < 4; ++kb) { Sp[kb][0] = pack_step<0>(S[kb]); Sp[kb][1] = pack_step<1>(S[kb]); }
            f32x16 VN[2] = {UN[0], UN[1]};
#pragma unroll
            for (int cb = 0; cb < 2; ++cb)
#pragma unroll
                for (int kb = 0; kb < 4; ++kb) { VN[cb] = DN_MFMA(DN_F(F_NW + (cb * 4 + kb) * 2 + 0), Sp[kb][0], VN[cb]); VN[cb] = DN_MFMA(DN_F(F_NW + (cb * 4 + kb) * 2 + 1), Sp[kb][1], VN[cb]); }
            __builtin_amdgcn_sched_barrier(0);
            bf16x8 VNp[2][2];
#pragma unroll
            for (int cb = 0; cb < 2; ++cb) { VNp[cb][0] = pack_step<0>(VN[cb]); VNp[cb][1] = pack_step<1>(VN[cb]); }
            { const float* d = dup + (size_t)(n < 63 ? n + 1 : n) * DU_UNIT;
#pragma unroll
              for (int cb = 0; cb < 2; ++cb)
#pragma unroll
                for (int g4 = 0; g4 < 4; ++g4) { const f32x4 v = *(const f32x4*)(d + cb * 1024 + 4 * g4); UN[cb][4 * g4] = v[0]; UN[cb][4 * g4 + 1] = v[1]; UN[cb][4 * g4 + 2] = v[2]; UN[cb][4 * g4 + 3] = v[3]; } }
            __builtin_amdgcn_sched_barrier(0);
#pragma unroll
            for (int cb = 0; cb < 2; ++cb) { f32x16 acc = {};
#pragma unroll
                for (int kb = 0; kb < 4; ++kb) { acc = DN_MFMA(Sp[kb][0], DN_F(F_QG + (cb * 4 + kb) * 2 + 0), acc); acc = DN_MFMA(Sp[kb][1], DN_F(F_QG + (cb * 4 + kb) * 2 + 1), acc); }
                if (cb == 0) { acc = DN_MFMA(VNp[0][0], DN_F(F_AT + 0), acc); acc = DN_MFMA(VNp[0][1], DN_F(F_AT + 1), acc); }
                else { acc = DN_MFMA(VNp[0][0], DN_F(F_AT + 2), acc); acc = DN_MFMA(VNp[0][1], DN_F(F_AT + 3), acc); acc = DN_MFMA(VNp[1][0], DN_F(F_AT + 4), acc); acc = DN_MFMA(VNp[1][1], DN_F(F_AT + 5), acc); }
                OT[cb] = acc; }
            __builtin_amdgcn_sched_barrier(0);
#pragma unroll
            for (int cb = 0; cb < 2; ++cb)
#pragma unroll
                for (int g4 = 0; g4 < 4; ++g4) zq[cb][g4] = *(const u32x2*)(ZS + orow0 + (size_t)(n * 64 + 32 * cb + r) * 4096 + 8 * g4);
#pragma unroll
            for (int kb = 0; kb < 4; ++kb) { f32x16 acc = S[kb] * egl;
#pragma unroll
                for (int cb = 0; cb < 2; ++cb) { acc = DN_MFMA(DN_F(F_KGT + (kb * 2 + cb) * 2 + 0), VNp[cb][0], acc); acc = DN_MFMA(DN_F(F_KGT + (kb * 2 + cb) * 2 + 1), VNp[cb][1], acc); }
                S[kb] = acc; }
#undef DN_F
            __builtin_amdgcn_sched_barrier(0);
            LAS float* wp = red + (n & 1) * 256 + dvb * 64;
#pragma unroll
            for (int cb = 0; cb < 2; ++cb) { float ss = 0.f;
#pragma unroll
                for (int rr = 0; rr < 16; ++rr) ss += OT[cb][rr] * OT[cb][rr];
                ss += __shfl_xor(ss, 32);
                if (h == 0) wp[32 * cb + r] = ss; }
        }
        DN_BAR_L();
        {   const LAS float* rp = red + 256;
#pragma unroll
            for (int cb = 0; cb < 2; ++cb) { const int cc = 32 * cb + r; const float ss = rp[cc] + rp[64 + cc] + rp[128 + cc] + rp[192 + cc];
                const float rs = rsqrtf(ss * (1.0f / 128.0f) + EPS); bf16* op = ODN + orow0 + (size_t)(63 * 64 + cc) * 4096;
#pragma unroll
                for (int g4 = 0; g4 < 4; ++g4) { const u32x2 z = zq[cb][g4]; const f32x4 nw = *(const LAS f32x4*)(nwl + 32 * dvb + 8 * g4 + 4 * h);
                    u32x2 w; w.x = pk2(OT[cb][4 * g4] * rs * nw[0] * bf_lo(z.x), OT[cb][4 * g4 + 1] * rs * nw[1] * bf_hi(z.x));
                    w.y = pk2(OT[cb][4 * g4 + 2] * rs * nw[2] * bf_lo(z.y), OT[cb][4 * g4 + 3] * rs * nw[3] * bf_hi(z.y));
                    *(u32x2*)(op + 8 * g4) = w; } } }
    }
}
#undef DN_BAR
#undef DN_BAR_L
}

constexpr size_t al256(size_t x) { return (x + 255) & ~(size_t)255; }
constexpr size_t WS_CTL = 0, CTL_ZERO_BYTES = 1u << 20;
constexpr int CW_BAR = 4096;
constexpr size_t WS_WIN = CTL_ZERO_BYTES;
constexpr size_t WS_WBRDN = WS_WIN + al256((size_t)DEPTH * NBIG * D * 2);
constexpr size_t WS_WBRFOX = WS_WBRDN + al256((size_t)DEPTH * D * 4096 * 2);
constexpr size_t WS_WOUT = WS_WBRFOX + al256((size_t)DEPTH * D * D * 2);
constexpr size_t WS_WGU = WS_WOUT + al256((size_t)DEPTH * D * D * 2);
constexpr size_t WS_WDOWN = WS_WGU + al256((size_t)DEPTH * 2 * FF * D * 2);
constexpr size_t WS_WSM = WS_WDOWN + al256((size_t)DEPTH * D * FF * 2);
constexpr size_t WS_MOD = WS_WSM + al256((size_t)DEPTH * NSM * D * 4);
constexpr size_t WS_H = WS_MOD + al256((size_t)DEPTH * 2 * 6 * D * 4);
constexpr size_t WS_DNRAW = WS_H + al256((size_t)M * D * 2);
constexpr size_t WS_DNC = WS_DNRAW + al256((size_t)M * 8192 * 2);
constexpr size_t WS_ZS = WS_DNC + al256((size_t)M * 8192 * 2);
constexpr size_t WS_FQKV = WS_ZS + al256((size_t)M * 4096 * 2);
constexpr size_t WS_MG = WS_FQKV + al256((size_t)M * 6144 * 2);
constexpr size_t WS_BAF = WS_MG + al256((size_t)M * 4096 * 2);
constexpr size_t WS_BETA = WS_BAF + al256((size_t)M * NSM * 4);
constexpr size_t WS_GG = WS_BETA + al256((size_t)M * 32 * 4);
constexpr size_t WS_LOGF = WS_GG + al256((size_t)M * 32 * 4);
constexpr size_t WS_FC = WS_LOGF + al256((size_t)M * 16 * 4);
constexpr size_t WS_ODNRAW = WS_FC + al256((size_t)M * 16 * 4);
constexpr size_t WS_ODN = WS_ODNRAW + al256((size_t)M * 4096 * 4);
constexpr size_t WS_OFOX = WS_ODN + al256((size_t)M * 4096 * 2);
constexpr size_t WS_YDN = WS_OFOX + al256((size_t)M * 2048 * 2);
constexpr size_t WS_MM = WS_YDN + al256((size_t)M * D * 4);
constexpr size_t WS_Y = WS_MM + al256((size_t)M * D * 2);
constexpr size_t WS_HID = WS_Y + al256((size_t)M * D * 4);
constexpr size_t WS_DNP = WS_HID + al256((size_t)M * FF * 2);
constexpr size_t WS_EGL = WS_DNP + al256((size_t)NB * DN_VH * 64 * dn::UNIT_BYTES);
constexpr size_t WS_END = WS_EGL + al256((size_t)NB * DN_VH * 64 * 4);
constexpr size_t WS_DU = WS_ODNRAW;

struct Params { const float* in[17]; float* out; unsigned char* ws; };

__global__ void __launch_bounds__(512, 2) mega_fwd(Params p) {
    extern __shared__ __attribute__((aligned(16))) unsigned char lds_raw[];
    Ctx c; c.lds = (LAS unsigned char*)lds_raw; c.wave = __builtin_amdgcn_readfirstlane((int)threadIdx.x >> 6);
    c.G = gridDim.x; c.gw = blockIdx.x * 8 + c.wave; c.NW = c.G * 8;
    for (int u = threadIdx.x; u < (LDS_BYTES - LDSCTL_OFF) / 4; u += 512) ((LAS unsigned*)(c.lds + LDSCTL_OFF))[u] = 0u;
    __syncthreads();
    typedef __attribute__((address_space(4))) const Params* KParams;
    const KParams kp0 = (KParams)__builtin_amdgcn_kernarg_segment_ptr();
    unsigned char* ws = p.ws;
    XcdBarrier bar = xcd_barrier_post((unsigned*)(ws + WS_CTL) + CW_BAR, (volatile LAS unsigned*)(c.lds + MISC_OFF) + 8);
#define GRID_BAR() do { XcdBarrier b2_ = bar; asm volatile("" : "+s"(b2_.x), "+s"(b2_.bar)); xcd_barrier(b2_); } while (0)
#define PH_BEGIN KParams kp = kp0; asm volatile("" : "+s"(kp)); unsigned char* wsl = kp->ws;
#define WSP(type, off) ((type*)(wsl + (off)))

    for (int l = 0; l < DEPTH; ++l) { PH_BEGIN
        ph_transpose(c, kp->in[5] + (size_t)l * D * NIN, D, NIN, NBIG, WSP(bf16, WS_WIN) + (size_t)l * NBIG * D, 1);
        ph_transpose(c, kp->in[11] + (size_t)l * 4096 * D, 4096, D, D, WSP(bf16, WS_WBRDN) + (size_t)l * D * 4096, 0);
        ph_transpose(c, kp->in[12] + (size_t)l * D * D, D, D, D, WSP(bf16, WS_WBRFOX) + (size_t)l * D * D, 0);
        ph_transpose(c, kp->in[13] + (size_t)l * D * D, D, D, D, WSP(bf16, WS_WOUT) + (size_t)l * D * D, 0);
        ph_transpose(c, kp->in[14] + (size_t)l * D * FF, D, FF, FF, WSP(bf16, WS_WGU) + (size_t)l * 2 * FF * D, 2);
        ph_transpose(c, kp->in[15] + (size_t)l * D * FF, D, FF, FF, WSP(bf16, WS_WGU) + (size_t)l * 2 * FF * D, 3);
        ph_transpose(c, kp->in[16] + (size_t)l * FF * D, FF, D, D, WSP(bf16, WS_WDOWN) + (size_t)l * D * FF, 0);
    }
    { PH_BEGIN ph_wsmall(c, kp->in[5], WSP(float, WS_WSM)); }
    __syncthreads();
    { PH_BEGIN ph_adaln(c, kp->in[1], kp->in[2], kp->in[3], WSP(float, WS_MOD)); }
    GRID_BAR();
    { PH_BEGIN RowArgs a{}; a.xin = kp->in[0]; a.x = kp->out; a.gn = kp->in[4]; a.scale = WSP(float, WS_MOD) + 1 * D; a.shift = WSP(float, WS_MOD); a.H = WSP(bf16, WS_H); a.wsm = WSP(float, WS_WSM); a.baf = WSP(float, WS_BAF);
      a.has_y = 0; a.has_h = 1; a.has_small = 1; ph_rowpass(c, a); }
    GRID_BAR();

    for (int l = 0; l < DEPTH; ++l) {
        { PH_BEGIN pg8::Gemm g{WSP(bf16, WS_H), WSP(bf16, WS_WIN) + (size_t)l * NBIG * D, M, NBIG, D, 0}; pg8::StaticOrder S; S.init(M, NBIG, c.G, (int)blockIdx.x);
          pg8::EpiInProj E{WSP(bf16, WS_DNRAW), WSP(bf16, WS_ZS), WSP(bf16, WS_FQKV), WSP(bf16, WS_MG)};
          pg8::gemm_phase<pg8::EpiInProj, pg8::StaticOrder, true, true>(c.lds, g, S, E); }
        GRID_BAR();
        { PH_BEGIN ph_conv(c, WSP(bf16, WS_DNRAW), kp->in[6] + (size_t)l * 8192 * 4, WSP(bf16, WS_DNC)); }
        { PH_BEGIN ph_gates(c, WSP(float, WS_BAF), kp->in[7] + l * 32, kp->in[8] + l * 32, kp->in[10] + l * 16, WSP(float, WS_BETA), WSP(float, WS_GG), WSP(float, WS_LOGF)); }
        GRID_BAR();
        { PH_BEGIN ph_fcum(c, WSP(float, WS_LOGF), WSP(float, WS_FC)); }
        { PH_BEGIN dn::prep_phase(c, WSP(bf16, WS_DNC), WSP(float, WS_GG), WSP(float, WS_BETA), WSP(unsigned char, WS_DNP), WSP(float, WS_DU), WSP(float, WS_EGL)); }
        GRID_BAR();
        { PH_BEGIN for (int bh = blockIdx.x; bh < NB * DN_VH; bh += c.G) { __syncthreads();
            dn::scan_head(bh, c.lds, WSP(unsigned char, WS_DNP), WSP(float, WS_DU), WSP(float, WS_EGL), kp->in[9] + l * 128, WSP(bf16, WS_ZS), WSP(bf16, WS_ODN)); } }
        { PH_BEGIN const int bx = blockIdx.x, vcu = (c.G % 8 == 0) ? (bx % 8) * (c.G / 8) + bx / 8 : bx;
          fox::fox_phase((char*)lds_raw, vcu, c.G, WSP(bf16, WS_FQKV), WSP(bf16, WS_OFOX), WSP(float, WS_FC)); }
        GRID_BAR();
        { PH_BEGIN pg8::Gemm g{WSP(bf16, WS_ODN), WSP(bf16, WS_WBRDN) + (size_t)l * D * 4096, M, D, 4096, 0}; pg8::StaticOrder S; S.init(M, D, c.G, (int)blockIdx.x); pg8::EpiF32 E{WSP(float, WS_YDN), D, 0};
          pg8::gemm_phase<pg8::EpiF32, pg8::StaticOrder, true, true>(c.lds, g, S, E); }
        __syncthreads();
        { PH_BEGIN pg8::Gemm g{WSP(bf16, WS_OFOX), WSP(bf16, WS_WBRFOX) + (size_t)l * D * D, M, D, D, 0}; pg8::StaticOrder S; S.init(M, D, c.G, (int)blockIdx.x); pg8::EpiMerge E{WSP(float, WS_YDN), WSP(bf16, WS_MG), WSP(bf16, WS_MM)};
          pg8::gemm_phase<pg8::EpiMerge, pg8::StaticOrder, true, true>(c.lds, g, S, E); }
        GRID_BAR();
        { PH_BEGIN pg8::Gemm g{WSP(bf16, WS_MM), WSP(bf16, WS_WOUT) + (size_t)l * D * D, M, D, D, 0}; pg8::StaticOrder S; S.init(M, D, c.G, (int)blockIdx.x); pg8::EpiF32 E{WSP(float, WS_Y), D, 0};
          pg8::gemm_phase<pg8::EpiF32, pg8::StaticOrder, true, true>(c.lds, g, S, E); }
        GRID_BAR();
        { PH_BEGIN const float* mod = WSP(float, WS_MOD) + (size_t)l * 2 * 6 * D; const float* gl = kp->in[4] + (size_t)l * 4 * D;
          RowArgs a{}; a.xin = kp->out; a.x = kp->out; a.Y = WSP(float, WS_Y); a.gy = gl + 1 * D; a.gate = mod + 2 * D; a.gn = gl + 2 * D; a.scale = mod + 4 * D; a.shift = mod + 3 * D; a.H = WSP(bf16, WS_H); a.has_y = 1; a.has_h = 1; a.has_small = 0;
          ph_rowpass(c, a); }
        GRID_BAR();
        { PH_BEGIN pg8::Gemm g{WSP(bf16, WS_H), WSP(bf16, WS_WGU) + (size_t)l * 2 * FF * D, M, 2 * FF, D, 0}; pg8::StaticOrder S; S.init(M, 2 * FF, c.G, (int)blockIdx.x); pg8::EpiSwiGLU E{WSP(bf16, WS_HID), FF, 0};
          pg8::gemm_phase<pg8::EpiSwiGLU, pg8::StaticOrder, true, true>(c.lds, g, S, E); }
        GRID_BAR();
        { PH_BEGIN pg8::Gemm g{WSP(bf16, WS_HID), WSP(bf16, WS_WDOWN) + (size_t)l * D * FF, M, D, FF, 0}; pg8::StaticOrder S; S.init(M, D, c.G, (int)blockIdx.x); pg8::EpiF32 E{WSP(float, WS_Y), D, 0};
          pg8::gemm_phase<pg8::EpiF32, pg8::StaticOrder, true, true>(c.lds, g, S, E); }
        GRID_BAR();
        { PH_BEGIN const float* mod = WSP(float, WS_MOD) + (size_t)l * 2 * 6 * D; const float* gl = kp->in[4] + (size_t)l * 4 * D;
          RowArgs a{}; a.xin = kp->out; a.x = kp->out; a.Y = WSP(float, WS_Y); a.gy = gl + 3 * D; a.gate = mod + 5 * D; a.has_y = 1;
          if (l + 1 < DEPTH) { const float* mod2 = mod + 2 * 6 * D; const float* gl2 = gl + 4 * D;
              a.gn = gl2; a.scale = mod2 + 1 * D; a.shift = mod2; a.H = WSP(bf16, WS_H); a.wsm = WSP(float, WS_WSM) + (size_t)(l + 1) * NSM * D; a.baf = WSP(float, WS_BAF); a.has_h = 1; a.has_small = 1; }
          ph_rowpass(c, a); }
        if (l + 1 < DEPTH) GRID_BAR();
    }
#undef PH_BEGIN
#undef WSP
#undef GRID_BAR
}

extern "C" void kernel_launch(void* const* d_in, const int* in_sizes, int n_in, void* d_out, int out_size, void* d_ws, size_t ws_size, hipStream_t stream) {
    static int grid = 0;
    if (grid == 0) {
        if (n_in != 17 || out_size != M * D || ws_size < WS_END) { fprintf(stderr, "kernel_launch: bad shapes / workspace (need %zu, have %zu)\n", (size_t)WS_END, ws_size); grid = -1; return; }
        int dev = 0, cus = 0, per_cu = 0;
        if (hipGetDevice(&dev) != hipSuccess || hipDeviceGetAttribute(&cus, hipDeviceAttributeMultiprocessorCount, dev) != hipSuccess) { grid = -1; return; }
        if (hipFuncSetAttribute((const void*)mega_fwd, hipFuncAttributeMaxDynamicSharedMemorySize, LDS_BYTES) != hipSuccess) { fprintf(stderr, "kernel_launch: hipFuncSetAttribute failed\n"); grid = -1; return; }
        if (hipOccupancyMaxActiveBlocksPerMultiprocessor(&per_cu, (const void*)mega_fwd, 512, LDS_BYTES) != hipSuccess || per_cu < 1) { fprintf(stderr, "kernel_launch: occupancy query reports %d workgroups per CU\n", per_cu); }
        (void)hipGetLastError();
        grid = cus;
    }
    if (grid < 0) return;
    if (hipMemsetAsync((char*)d_ws + WS_CTL, 0, CTL_ZERO_BYTES, stream) != hipSuccess) return;
    Params p{};
    for (int i = 0; i < 17; ++i) p.in[i] = (const float*)d_in[i];
    p.out = (float*)d_out; p.ws = (unsigned char*)d_ws;
    hipLaunchKernelGGL(mega_fwd, dim3(grid), dim3(512), LDS_BYTES, stream, p);
}
```

```cpp
#include <hip/hip_runtime.h>
#include <cstdio>
#include <cstdint>

constexpr int D = 2048, NB = 2, T = 4096, M = NB * T, DEPTH = 4;
constexpr int HD = 128, DN_VH = 32, DN_CONV = 8192;
constexpr int FOXH = 16;
constexpr int FF = 5632;
constexpr int NIN = 22608;
constexpr int SRC_B = 12288, SRC_A = 12320, SRC_FQKV = 12352, SRC_F = 18496, SRC_MERGE = 18512;
constexpr int NBIG = 22528;
constexpr int NSM = 80;
constexpr float EPS = 1e-6f;

typedef unsigned short bf16;
typedef float f32x4 __attribute__((ext_vector_type(4)));
typedef unsigned u32x4 __attribute__((ext_vector_type(4)));
typedef unsigned u32x2 __attribute__((ext_vector_type(2)));
#define LAS __attribute__((address_space(3)))

__device__ __forceinline__ float bf_lo(unsigned w) { return __uint_as_float(w << 16); }
__device__ __forceinline__ float bf_hi(unsigned w) { return __uint_as_float(w & 0xffff0000u); }
__device__ __forceinline__ float bf2f(bf16 h) { return __uint_as_float(((unsigned)h) << 16); }
__device__ __forceinline__ unsigned f2bf(float f) { unsigned u = __float_as_uint(f); return (u + 0x7fffu + ((u >> 16) & 1u)) >> 16; }
__device__ __forceinline__ unsigned pk2(float lo, float hi) { return f2bf(lo) | (f2bf(hi) << 16); }
__device__ __forceinline__ float fsigmoid(float x) { return __builtin_amdgcn_rcpf(1.0f + __expf(-x)); }
__device__ __forceinline__ float fsilu(float x) { return x * fsigmoid(x); }
__device__ __forceinline__ float wave_sum(float v) {
#pragma unroll
    for (int o = 1; o < 64; o <<= 1) v += __shfl_xor(v, o);
    return v;
}
namespace pg8 {
#define PG8_LAS __attribute__((address_space(3)))
typedef unsigned short bf16_t;
typedef short bf16x8 __attribute__((ext_vector_type(8)));
typedef float f32x4 __attribute__((ext_vector_type(4)));
typedef unsigned u32x4 __attribute__((ext_vector_type(4)));
constexpr int BM = 256, BK = 64, HALF = 128, HTB = HALF * BK * 2  , STAGE_BYTES = 8 * HTB, NXCD = 8, WGM = 8;

__host__ __device__ __forceinline__ int lds_byte(int r, int c) { const int st = (r >> 4) * 2 + (c >> 5), rr = r & 15, cc = c & 31, ob = rr * 64 + cc * 2; return st * 1024 + (ob ^ (((ob >> 9) & 1) << 5)); }
__host__ __device__ __forceinline__ void stage_rc(int b, int& R, int& C) { const int st = b / 1024, sb = b % 1024, swz = sb ^ (((sb >> 9) & 1) << 5); R = (st >> 1) * 16 + swz / 64; C = (st & 1) * 32 + (swz % 64) / 2; }
__host__ __device__ __forceinline__ int perm32(int rho) { const int n = rho >> 4, i = rho & 15; return 8 * (i >> 2) + 4 * n + (i & 3); }

struct Unit { int pm, pn; };
struct Gemm { const bf16_t* A; const bf16_t* Bt; int M, N, K, pad; };

struct StaticOrder {
    int nM, nN, nwg, G, c;
    __host__ __device__ void init(int M, int N, int G_, int c_) { nM = M / BM; nN = N / BM; nwg = nM * nN; G = G_; c = c_; }
    __host__ __device__ bool next(int i, Unit& u) const {
        const long L = (long)i * G + c; if (L >= nwg) return false;
        int wgid = (int)L; { const int q = nwg / NXCD, r = nwg % NXCD, xcd = wgid % NXCD, off = wgid / NXCD; wgid = (xcd < r ? xcd * (q + 1) : r * (q + 1) + (xcd - r) * q) + off; }
        const int nig = WGM * nN, gid = wgid / nig, fm = gid * WGM, gsz = (nM - fm) < WGM ? (nM - fm) : WGM;
        u.pm = fm + ((wgid % nig) % gsz); u.pn = (wgid % nig) / gsz; return true;
    }
    __device__ __forceinline__ void a_ready(const Unit&) const {}
    __device__ __forceinline__ void done(const Unit&) const {}
};

__device__ __forceinline__ unsigned cvt_pk_bf16(float lo, float hi) { unsigned r; asm volatile("v_cvt_pk_bf16_f32 %0, %1, %2" : "=v"(r) : "v"(lo), "v"(hi)); return r; }
__device__ __forceinline__ float e_sigmoid(float x) { return __builtin_amdgcn_rcpf(1.0f + __expf(-x)); }

struct EpiF32 {
    static constexpr bool PERM = false, AFTER_DRAIN = false;
    float* C; int ldc, pad;
    __device__ __forceinline__ void operator()(const f32x4 (&acc)[2][2][4][2], const Unit& u, int wr, int wc, int fr, int fq) const {
        const int row0 = u.pm * BM + wr * 64 + fr, col0 = u.pn * BM + wc * 32 + 4 * fq;
#pragma unroll
        for (int ai = 0; ai < 2; ++ai)
#pragma unroll
            for (int m = 0; m < 4; ++m) { float* rowp = C + (size_t)(row0 + ai * HALF + m * 16) * ldc + col0;
#pragma unroll
                for (int bj = 0; bj < 2; ++bj)
#pragma unroll
                    for (int n = 0; n < 2; ++n) *(f32x4*)(rowp + bj * HALF + n * 16) = acc[ai][bj][m][n]; }
    }
};
struct EpiInProj {
    static constexpr bool PERM = true, AFTER_DRAIN = false;
    bf16_t *dnraw, *z, *fqkv, *mg;
    __device__ __forceinline__ void operator()(const f32x4 (&acc)[2][2][4][2], const Unit& u, int wr, int wc, int fr, int fq) const {
        const int pn = u.pn; bf16_t* base; int ldc, colt, act;
        if (pn < 32) { base = dnraw; ldc = 8192; colt = pn * BM; act = 0; }
        else if (pn < 48) { base = z; ldc = 4096; colt = (pn - 32) * BM; act = 1; }
        else if (pn < 72) { base = fqkv; ldc = 6144; colt = (pn - 48) * BM; act = 0; }
        else { base = mg; ldc = 4096; colt = (pn - 72) * BM; act = 2; }
        const int row0 = u.pm * BM + wr * 64 + fr, col0 = colt + wc * 32 + 8 * fq;
#pragma unroll
        for (int ai = 0; ai < 2; ++ai)
#pragma unroll
            for (int m = 0; m < 4; ++m) { bf16_t* rowp = base + (size_t)(row0 + ai * HALF + m * 16) * ldc + col0;
#pragma unroll
                for (int bj = 0; bj < 2; ++bj) { f32x4 v0 = acc[ai][bj][m][0], v1 = acc[ai][bj][m][1];
                    if (act == 1) {
#pragma unroll
                        for (int j = 0; j < 4; ++j) { v0[j] = v0[j] * e_sigmoid(v0[j]); v1[j] = v1[j] * e_sigmoid(v1[j]); } }
                    if (act == 2) {
#pragma unroll
                        for (int j = 0; j < 4; ++j) { v0[j] = e_sigmoid(v0[j]); v1[j] = e_sigmoid(v1[j]); } }
                    u32x4 w; w.x = cvt_pk_bf16(v0[0], v0[1]); w.y = cvt_pk_bf16(v0[2], v0[3]); w.z = cvt_pk_bf16(v1[0], v1[1]); w.w = cvt_pk_bf16(v1[2], v1[3]);
                    *(u32x4*)(rowp + bj * HALF) = w; } }
    }
};
struct EpiMerge {
    static constexpr bool PERM = true, AFTER_DRAIN = false;
    const float* ydn; const bf16_t* mg; bf16_t* mm;
    __device__ __forceinline__ void operator()(const f32x4 (&acc)[2][2][4][2], const Unit& u, int wr, int wc, int fr, int fq) const {
        const int row0 = u.pm * BM + wr * 64 + fr, col0 = u.pn * BM + wc * 32 + 8 * fq;
#pragma unroll
        for (int ai = 0; ai < 2; ++ai)
#pragma unroll
            for (int m = 0; m < 4; ++m) { const size_t row = (size_t)(row0 + ai * HALF + m * 16);
#pragma unroll
                for (int bj = 0; bj < 2; ++bj) { const int col = col0 + bj * HALF;
                    const f32x4 y0 = *(const f32x4*)(ydn + row * 2048 + col), y1 = *(const f32x4*)(ydn + row * 2048 + col + 4);
                    const u32x4 gd = *(const u32x4*)(mg + row * 4096 + col), gf = *(const u32x4*)(mg + row * 4096 + 2048 + col);
                    const f32x4 a0 = acc[ai][bj][m][0], a1 = acc[ai][bj][m][1];
                    float o[8];
                    o[0] = __uint_as_float(gd.x << 16) * y0[0] + __uint_as_float(gf.x << 16) * a0[0];
                    o[1] = __uint_as_float(gd.x & 0xffff0000u) * y0[1] + __uint_as_float(gf.x & 0xffff0000u) * a0[1];
                    o[2] = __uint_as_float(gd.y << 16) * y0[2] + __uint_as_float(gf.y << 16) * a0[2];
                    o[3] = __uint_as_float(gd.y & 0xffff0000u) * y0[3] + __uint_as_float(gf.y & 0xffff0000u) * a0[3];
                    o[4] = __uint_as_float(gd.z << 16) * y1[0] + __uint_as_float(gf.z << 16) * a1[0];
                    o[5] = __uint_as_float(gd.z & 0xffff0000u) * y1[1] + __uint_as_float(gf.z & 0xffff0000u) * a1[1];
                    o[6] = __uint_as_float(gd.w << 16) * y1[2] + __uint_as_float(gf.w << 16) * a1[2];
                    o[7] = __uint_as_float(gd.w & 0xffff0000u) * y1[3] + __uint_as_float(gf.w & 0xffff0000u) * a1[3];
                    u32x4 w; w.x = cvt_pk_bf16(o[0], o[1]); w.y = cvt_pk_bf16(o[2], o[3]); w.z = cvt_pk_bf16(o[4], o[5]); w.w = cvt_pk_bf16(o[6], o[7]);
                    *(u32x4*)(mm + row * 2048 + col) = w; } }
    }
};
struct EpiSwiGLU {
    static constexpr bool PERM = true, AFTER_DRAIN = false;
    bf16_t* hid; int ldc, pad;
    __device__ __forceinline__ void operator()(const f32x4 (&acc)[2][2][4][2], const Unit& u, int wr, int wc, int fr, int fq) const {
        const int row0 = u.pm * BM + wr * 64 + fr, col0 = u.pn * HALF + wc * 32 + 8 * fq;
#pragma unroll
        for (int ai = 0; ai < 2; ++ai)
#pragma unroll
            for (int m = 0; m < 4; ++m) { bf16_t* rowp = hid + (size_t)(row0 + ai * HALF + m * 16) * ldc + col0;
                const f32x4 g0 = acc[ai][0][m][0], g1 = acc[ai][0][m][1], u0 = acc[ai][1][m][0], u1 = acc[ai][1][m][1];
                float o[8];
#pragma unroll
                for (int j = 0; j < 4; ++j) { o[j] = g0[j] * e_sigmoid(g0[j]) * u0[j]; o[4 + j] = g1[j] * e_sigmoid(g1[j]) * u1[j]; }
                u32x4 w; w.x = cvt_pk_bf16(o[0], o[1]); w.y = cvt_pk_bf16(o[2], o[3]); w.z = cvt_pk_bf16(o[4], o[5]); w.w = cvt_pk_bf16(o[6], o[7]);
                *(u32x4*)rowp = w; }
    }
};

template <class Epi, class Sched, bool ALIGN_EPI = false, bool SP2 = false>
__device__ __forceinline__ void gemm_phase(PG8_LAS unsigned char* lds, const Gemm g, const Sched& S, const Epi& E) {
    int tid_ = threadIdx.x; asm volatile("" : "+v"(tid_)); const int tid = tid_, wid = __builtin_amdgcn_readfirstlane(tid >> 6), lane = tid & 63, wr = wid >> 2, wc = wid & 3, fr = lane & 15, fq = lane >> 4;
    const int K = g.K, nt = K / BK;
    unsigned voffA[2], voffB[2];
#pragma unroll
    for (int i = 0; i < 2; ++i) { int R, C; stage_rc(tid * 16 + i * 8192, R, C); const int Rb = Epi::PERM ? ((R & ~31) + perm32(R & 31)) : R;
        voffA[i] = (unsigned)(R * K + C) * 2u; voffB[i] = (unsigned)(Rb * K + C) * 2u; }
    const size_t kstep = (size_t)(BK * 2);
    const size_t hstep = (size_t)HALF * K * 2;
    const size_t tstep = 2 * hstep;
    const unsigned ldsw = (unsigned)wid * 1024u;
    const int aoff = lds_byte(wr * 64 + fr, fq * 8), boff = lds_byte(wc * 32 + fr, fq * 8);
#define PG8_SA(b, h) (((b) * 2 + (h)) * HTB)
#define PG8_SB(b, h) ((4 + (b) * 2 + (h)) * HTB)
#define PG8_STAGE(bufoff, gbase, voff) do { _Pragma("unroll") for (int _i = 0; _i < 2; ++_i) \
        __builtin_amdgcn_global_load_lds((const unsigned*)((const char*)(gbase) + (voff)[_i]), (PG8_LAS unsigned*)(lds + (bufoff) + ldsw + _i * 8192), 16, 0, 0); } while (0)
#define PG8_LDA(dst, b, h) do { _Pragma("unroll") for (int m = 0; m < 4; ++m) _Pragma("unroll") for (int k = 0; k < 2; ++k) dst[m][k] = *(const PG8_LAS bf16x8*)(lds + PG8_SA(b, h) + aoff + m * 2048 + k * 1024); } while (0)
#define PG8_LDB(dst, b, h) do { _Pragma("unroll") for (int n = 0; n < 2; ++n) _Pragma("unroll") for (int k = 0; k < 2; ++k) dst[n][k] = *(const PG8_LAS bf16x8*)(lds + PG8_SB(b, h) + boff + n * 2048 + k * 1024); } while (0)
#define PG8_MMA(ai, bj, At, Bt) do { __builtin_amdgcn_s_setprio(1); _Pragma("unroll") for (int m = 0; m < 4; ++m) _Pragma("unroll") for (int n = 0; n < 2; ++n) _Pragma("unroll") for (int k = 0; k < 2; ++k) \
        acc[ai][bj][m][n] = __builtin_amdgcn_mfma_f32_16x16x32_bf16(Bt[n][k], At[m][k], acc[ai][bj][m][n], 0, 0, 0); __builtin_amdgcn_s_setprio(0); } while (0)
#define PG8_WAIT_V(n) asm volatile("s_waitcnt vmcnt(" #n ")" ::: "memory")
#define PG8_WAIT_L(n) asm volatile("s_waitcnt lgkmcnt(" #n ")" ::: "memory")
#define PG8_BAR __builtin_amdgcn_s_barrier()
#define PG8_SCHED __builtin_amdgcn_sched_barrier(0)
    Unit cur, nxt; int ui = 0;
    if (!S.next(0, cur)) return;
    f32x4 acc[2][2][4][2];
#pragma unroll
    for (int a = 0; a < 2; ++a)
#pragma unroll
        for (int b = 0; b < 2; ++b)
#pragma unroll
            for (int m = 0; m < 4; ++m)
#pragma unroll
                for (int n = 0; n < 2; ++n) acc[a][b][m][n] = (f32x4){0.f, 0.f, 0.f, 0.f};
    bf16x8 At[4][2], B0[2][2], B1[2][2];
    const char* cA = (const char*)g.A + (size_t)cur.pm * tstep; const char* cB = (const char*)g.Bt + (size_t)cur.pn * tstep;
    S.a_ready(cur);
    if constexpr (SP2) {
        PG8_STAGE(PG8_SB(0, 0), cB, voffB); PG8_STAGE(PG8_SB(0, 1), cB + hstep, voffB); PG8_STAGE(PG8_SA(0, 0), cA, voffA); PG8_STAGE(PG8_SA(0, 1), cA + hstep, voffA);
        if (wr == 1) PG8_BAR;
        PG8_WAIT_V(2); PG8_BAR;
        PG8_STAGE(PG8_SB(1, 0), cB + kstep, voffB); PG8_STAGE(PG8_SA(1, 0), cA + kstep, voffA); PG8_STAGE(PG8_SB(1, 1), cB + hstep + kstep, voffB);
        PG8_WAIT_V(6); PG8_BAR;
    } else {
        PG8_STAGE(PG8_SB(0, 0), cB, voffB); PG8_STAGE(PG8_SA(0, 0), cA, voffA); PG8_STAGE(PG8_SB(0, 1), cB + hstep, voffB); PG8_STAGE(PG8_SA(0, 1), cA + hstep, voffA);
        if (wr == 1) PG8_BAR;
        PG8_WAIT_V(4); PG8_BAR;
        PG8_STAGE(PG8_SB(1, 0), cB + kstep, voffB); PG8_STAGE(PG8_SA(1, 0), cA + kstep, voffA); PG8_STAGE(PG8_SB(1, 1), cB + hstep + kstep, voffB);
        PG8_WAIT_V(6); PG8_BAR;
    }
    for (;;) {
        const bool has_next = S.next(ui + 1, nxt);
        const char* nA = has_next ? (const char*)g.A + (size_t)nxt.pm * tstep : cA; const char* nB = has_next ? (const char*)g.Bt + (size_t)nxt.pn * tstep : cB;
        for (int t = 0; t < nt; t += 2) {
            const bool last = (t == nt - 2);
            const char* a1 = cA + (size_t)(t + 1) * kstep;
            const char* a2 = last ? nA : cA + (size_t)(t + 2) * kstep; const char* b2 = last ? nB : cB + (size_t)(t + 2) * kstep;
            const char* a3 = a2 + kstep; const char* b3 = b2 + kstep;
            if (last && has_next) S.a_ready(nxt);
            if constexpr (SP2) {
            PG8_LDB(B0, 0, 0); PG8_LDB(B1, 0, 1); PG8_SCHED; PG8_LDA(At, 0, 0); PG8_STAGE(PG8_SA(1, 1), a1 + hstep, voffA);
            PG8_WAIT_V(8); PG8_WAIT_L(0); PG8_BAR; PG8_MMA(0, 0, At, B0); PG8_MMA(0, 1, At, B1); PG8_BAR; PG8_SCHED;
            PG8_LDA(At, 0, 1); PG8_STAGE(PG8_SB(0, 0), b2, voffB); PG8_STAGE(PG8_SB(0, 1), b2 + hstep, voffB); PG8_STAGE(PG8_SA(0, 0), a2, voffA);
            PG8_WAIT_V(8); PG8_WAIT_L(0); PG8_BAR; PG8_MMA(1, 0, At, B0); PG8_MMA(1, 1, At, B1); PG8_BAR; PG8_SCHED;
            PG8_LDB(B0, 1, 0); PG8_LDB(B1, 1, 1); PG8_SCHED; PG8_LDA(At, 1, 0); PG8_STAGE(PG8_SA(0, 1), a2 + hstep, voffA);
            PG8_WAIT_V(8); PG8_WAIT_L(0); PG8_BAR; PG8_MMA(0, 0, At, B0); PG8_MMA(0, 1, At, B1); PG8_BAR; PG8_SCHED;
            PG8_LDA(At, 1, 1); PG8_STAGE(PG8_SB(1, 0), b3, voffB); PG8_STAGE(PG8_SB(1, 1), b3 + hstep, voffB); PG8_STAGE(PG8_SA(1, 0), a3, voffA);
            PG8_WAIT_V(8); PG8_WAIT_L(0); PG8_BAR; PG8_MMA(1, 0, At, B0); PG8_MMA(1, 1, At, B1); PG8_BAR; PG8_SCHED;
            } else {
            PG8_LDB(B0, 0, 0); PG8_SCHED; PG8_LDA(At, 0, 0); PG8_STAGE(PG8_SA(1, 1), a1 + hstep, voffA);
            PG8_WAIT_L(8); PG8_BAR; PG8_WAIT_L(0); PG8_MMA(0, 0, At, B0); PG8_BAR; PG8_SCHED;
            PG8_LDB(B1, 0, 1); PG8_STAGE(PG8_SB(0, 0), b2, voffB);
            PG8_BAR; PG8_WAIT_L(0); PG8_MMA(0, 1, At, B1); PG8_BAR;
            PG8_LDA(At, 0, 1); PG8_STAGE(PG8_SA(0, 0), a2, voffA);
            PG8_BAR; PG8_WAIT_L(0); PG8_MMA(1, 0, At, B0); PG8_BAR; PG8_SCHED;
            PG8_STAGE(PG8_SB(0, 1), b2 + hstep, voffB);
            PG8_WAIT_V(6); PG8_BAR; PG8_MMA(1, 1, At, B1); PG8_BAR;
            PG8_LDB(B0, 1, 0); PG8_SCHED; PG8_LDA(At, 1, 0); PG8_STAGE(PG8_SA(0, 1), a2 + hstep, voffA);
            PG8_WAIT_L(8); PG8_BAR; PG8_WAIT_L(0); PG8_MMA(0, 0, At, B0); PG8_BAR; PG8_SCHED;
            PG8_LDB(B1, 1, 1); PG8_STAGE(PG8_SB(1, 0), b3, voffB);
            PG8_BAR; PG8_WAIT_L(0); PG8_MMA(0, 1, At, B1); PG8_BAR;
            PG8_LDA(At, 1, 1); PG8_STAGE(PG8_SA(1, 0), a3, voffA);
            PG8_BAR; PG8_WAIT_L(0); PG8_MMA(1, 0, At, B0); PG8_BAR; PG8_SCHED;
            PG8_STAGE(PG8_SB(1, 1), b3 + hstep, voffB);
            PG8_WAIT_V(6); PG8_BAR; PG8_MMA(1, 1, At, B1); PG8_BAR;
            }
        }
        if constexpr (ALIGN_EPI) { if (wr == 0) PG8_BAR; }
        if constexpr (!Epi::AFTER_DRAIN) { E(acc, cur, wr, wc, fr, fq); S.done(cur); }
        if (!has_next) break;
#pragma unroll
        for (int a = 0; a < 2; ++a)
#pragma unroll
            for (int b = 0; b < 2; ++b)
#pragma unroll
                for (int m = 0; m < 4; ++m)
#pragma unroll
                    for (int n = 0; n < 2; ++n) acc[a][b][m][n] = (f32x4){0.f, 0.f, 0.f, 0.f};
        cur = nxt; cA = nA; cB = nB; ++ui;
        if constexpr (ALIGN_EPI) { if (wr == 1) PG8_BAR; }
    }
    PG8_WAIT_V(0);
    if constexpr (!ALIGN_EPI) { if (wr == 0) PG8_BAR; }
    PG8_BAR;
    if constexpr (Epi::AFTER_DRAIN) { E.fused(acc, cur, wr, wc, fr, fq, lds, wid, lane); S.done(cur); }
#undef PG8_SA
#undef PG8_SB
#undef PG8_STAGE
#undef PG8_LDA
#undef PG8_LDB
#undef PG8_MMA
#undef PG8_WAIT_V
#undef PG8_WAIT_L
#undef PG8_BAR
#undef PG8_SCHED
}
}
#define XB_TMO      128
#define XB_XCNT(j)  (256  + 64 * (j))
#define XB_XSUB(j)  (1280 + 64 * (j))
#define XB_XGEN(j)  (2304 + 64 * (j))
#define XB_TOP      3328
#define XB_TOPGEN   3392
#define XCD_BAR_WORDS 3456
#define XB_SPIN_CAP (1u << 21)


__device__ __forceinline__ unsigned xb_ld(unsigned* p)              { return __hip_atomic_load(p, __ATOMIC_RELAXED, __HIP_MEMORY_SCOPE_AGENT); }
__device__ __forceinline__ unsigned xb_add(unsigned* p, unsigned v) { return __hip_atomic_fetch_add(p, v, __ATOMIC_RELAXED, __HIP_MEMORY_SCOPE_AGENT); }
__device__ __forceinline__ unsigned xb_xcc_id() { return (unsigned)__builtin_amdgcn_s_getreg((3 << 11) | 20) & 0xFu; }
#define XB_SPIN(cond, bar) do { unsigned _sp = 0; while (cond) { __builtin_amdgcn_s_sleep(1); \
    if ((++_sp & 255u) == 0u) { if (xb_ld(&(bar)[XB_TMO])) break; if (_sp > XB_SPIN_CAP) { atomicAdd(&(bar)[XB_TMO], 1u); break; } } } } while (0)

struct XcdBarrier {
    unsigned* bar; unsigned x;
    volatile LAS unsigned* st;
};

__device__ __forceinline__ XcdBarrier xcd_barrier_post(unsigned* bar, volatile LAS unsigned* st) {
    XcdBarrier b; b.bar = bar; b.x = xb_xcc_id(); b.st = st;
    if (threadIdx.x == 0) (void)xb_add(&bar[XB_XCNT(b.x)], 1u);
    return b;
}
__device__ __forceinline__ void xcd_barrier_complete(unsigned* bar, unsigned x, unsigned& nloc, unsigned& nx) {
    const unsigned G = gridDim.x * gridDim.y * gridDim.z;
    unsigned sum, cnt, mine, sp = 0u;
    for (;;) {
        sum = 0u; cnt = 0u; mine = 0u;
#pragma unroll
        for (unsigned j = 0; j < 16; ++j) { const unsigned c = xb_ld(&bar[XB_XCNT(j)]); sum += c; cnt += (c > 0u) ? 1u : 0u; mine = (j == x) ? c : mine; }
        if (sum == G) break;
        __builtin_amdgcn_s_sleep(1);
        if ((++sp & 255u) == 0u) { if (xb_ld(&bar[XB_TMO])) break; if (sp > XB_SPIN_CAP) { atomicAdd(&bar[XB_TMO], 1u); break; } }
    }
    nloc = mine > 0u ? mine : 1u; nx = cnt > 0u ? cnt : 1u;
}

__device__ __forceinline__ void xcd_barrier(const XcdBarrier& b) {
    asm volatile("s_waitcnt vmcnt(0)" ::: "memory");
    __syncthreads();
    if (threadIdx.x == 0) {
        unsigned* bar = b.bar;
        __builtin_amdgcn_s_waitcnt(0);
        unsigned nloc = b.st[0], nx = b.st[1];
        if (nloc == 0u) { xcd_barrier_complete(bar, b.x, nloc, nx); b.st[0] = nloc; b.st[1] = nx; }
        const unsigned old = xb_add(&bar[XB_XSUB(b.x)], 1u);
        const unsigned gen = old / nloc;
        if (old + 1u == (gen + 1u) * nloc) {
            __builtin_amdgcn_fence(__ATOMIC_RELEASE, "agent");
            asm volatile("s_waitcnt vmcnt(0)" ::: "memory");
            const unsigned og = xb_add(&bar[XB_TOP], 1u);
            const unsigned tg = og / nx;
            if (og + 1u == (tg + 1u) * nx) xb_add(&bar[XB_TOPGEN], 1u);
            else XB_SPIN(xb_ld(&bar[XB_TOPGEN]) == tg, bar);
            __builtin_amdgcn_fence(__ATOMIC_ACQUIRE, "agent");
            xb_add(&bar[XB_XGEN(b.x)], 1u);
            asm volatile("s_waitcnt vmcnt(0)" ::: "memory");
        } else {
            XB_SPIN(xb_ld(&bar[XB_XGEN(b.x)]) == gen, bar);
            __builtin_amdgcn_fence(__ATOMIC_ACQUIRE, "agent");
            asm volatile("s_waitcnt vmcnt(0)" ::: "memory");
        }
    }
    __syncthreads();
}

namespace fox {
constexpr int D = 128, QP = 6144, KVP = 6144, OP = 2048;
constexpr float THR = 8.f;
constexpr bool WSKIP = false;
using bf16 = unsigned short;
constexpr float SCALE = 0.08838834764831845f;
constexpr int NW = 8, QBLK = 32, KVBLK = 64, QB = NW * QBLK;
constexpr int SHM_V = KVBLK * D * 2, SHM_K = KVBLK * D * 2;
constexpr int BIAS_OFF = 2 * SHM_V + 2 * SHM_K + NW * 64 * 4;
constexpr int MB_OFF = BIAS_OFF + 2 * 4096 * 4;
constexpr int LDS_BYTES = MB_OFF + 64;

typedef short bf16x8 __attribute__((ext_vector_type(8)));
typedef short s16x4 __attribute__((ext_vector_type(4)));
typedef float f32x16 __attribute__((ext_vector_type(16)));
typedef float f32x4 __attribute__((ext_vector_type(4)));
typedef unsigned u32x4 __attribute__((ext_vector_type(4)));
template <class A, class Bt> struct same_t { static constexpr bool v = false; };
template <class A> struct same_t<A, A> { static constexpr bool v = true; };

#define KSWZ(row, colB) ((row) * 256 + ((colB) ^ (((row) & 7) << 4)))
#define SBAR() __builtin_amdgcn_sched_barrier(0)
__device__ __forceinline__ int v_st(int k, int c) { const int kk = (k & ~0xC) | ((k & 4) << 1) | ((k & 8) >> 1); return ((kk >> 3) * 4 + (c >> 5)) * 512 + ((kk & 7) * 32 + (c & 31)) * 2; }
__device__ __forceinline__ int v_rd_base(int lane) { return ((lane & 3) << 3) | (((lane >> 2) & 3) << 6) | (((lane >> 4) & 1) << 5) | (((lane >> 5) & 1) << 8); }
constexpr int v_rd_off(int d0, int ks, int half) { return d0 * 512 + ks * 4096 + half * 2048; }
__device__ __forceinline__ int crow(int r, int hi) { return (r & 3) + 8 * (r >> 2) + 4 * hi; }
__device__ __forceinline__ unsigned cvtpk(float lo, float hi) {
    unsigned r; asm volatile("v_cvt_pk_bf16_f32 %0, %1, %2" : "=v"(r) : "v"(lo), "v"(hi)); return r;
}
__device__ __forceinline__ bf16x8 pack8(f32x4 a, f32x4 b) {
    u32x4 w = {cvtpk(a[0], a[1]), cvtpk(a[2], a[3]), cvtpk(b[0], b[1]), cvtpk(b[2], b[3])};
    return *reinterpret_cast<bf16x8*>(&w);
}
template <class T> __device__ __forceinline__ bf16x8 load8(const T* p) {
    if constexpr (same_t<T, float>::v) { return pack8(*(const f32x4*)p, *(const f32x4*)(p + 4)); }
    else { return *reinterpret_cast<const bf16x8*>(p); }
}
__device__ __forceinline__ void mask_tile(f32x16& p0, f32x16& p1, int dq, unsigned W) {
    const float NEG = -__builtin_inff();
#pragma unroll
    for (int r = 0; r < 16; ++r) {
        const int c = (r & 3) + 8 * (r >> 2);
        if ((unsigned)(dq - c) >= W) p0[r] = NEG;
        if ((unsigned)(dq - c - 32) >= W) p1[r] = NEG;
    }
}
__device__ __forceinline__ void partialSM(f32x16& p0, f32x16& p1, float& m_reg, float& mn, float& alpha) {
    float pmax = p0[0]; for (int r = 1; r < 16; ++r) pmax = fmaxf(pmax, p0[r]); for (int r = 0; r < 16; ++r) pmax = fmaxf(pmax, p1[r]);
    { auto rr = __builtin_amdgcn_permlane32_swap(__float_as_uint(pmax), __float_as_uint(pmax), false, false);
      pmax = fmaxf(__uint_as_float(rr[0]), __uint_as_float(rr[1])); }
    constexpr float C2 = 1.4426950408889634f * SCALE;
    if (__builtin_expect(__all((pmax - m_reg) * SCALE <= THR), 1)) { mn = m_reg; alpha = 1.f; }
    else { mn = fmaxf(m_reg, pmax); alpha = __builtin_amdgcn_exp2f((m_reg - mn) * C2); m_reg = mn; }
    const float mnL = -mn * C2;
    for (int r = 0; r < 16; ++r) p0[r] = fmaf(p0[r], C2, mnL); for (int r = 0; r < 16; ++r) p1[r] = fmaf(p1[r], C2, mnL);
    for (int r = 0; r < 16; ++r) p0[r] = __builtin_amdgcn_exp2f(p0[r]);
}
__device__ __forceinline__ void finishSM(f32x16& p0, f32x16& p1, float alpha, float& l_reg, bf16x8& pa0, bf16x8& pa1, bf16x8& pa2, bf16x8& pa3) {
    for (int r = 0; r < 16; ++r) p1[r] = __builtin_amdgcn_exp2f(p1[r]);
    float ps = 0; for (int r = 0; r < 16; ++r) ps += p0[r]; for (int r = 0; r < 16; ++r) ps += p1[r];
    { auto rr = __builtin_amdgcn_permlane32_swap(__float_as_uint(ps), __float_as_uint(ps), false, false);
      ps = __uint_as_float(rr[0]) + __uint_as_float(rr[1]); }
    l_reg = l_reg * alpha + ps;
#define PK4(P, B_, OUT) do { unsigned a0 = cvtpk(P[B_+0], P[B_+1]), a1 = cvtpk(P[B_+2], P[B_+3]);                          \
        unsigned b0 = cvtpk(P[B_+4], P[B_+5]), b1 = cvtpk(P[B_+6], P[B_+7]);                                             \
        auto r0 = __builtin_amdgcn_permlane32_swap(a0, b0, false, false); auto r1 = __builtin_amdgcn_permlane32_swap(a1, b1, false, false); \
        u32x4 w = {r0[0], r1[0], r0[1], r1[1]}; OUT = *reinterpret_cast<bf16x8*>(&w); } while (0)
    PK4(p0, 0, pa0); PK4(p0, 8, pa1); PK4(p1, 0, pa2); PK4(p1, 8, pa3);
#undef PK4
}
template <int KB, bool SK>
__device__ __forceinline__ void qkt(f32x16& p0, f32x16& p1, const char* K_lds, int r32, int hi, const bf16x8* qr, bool act, const float* bl  ) {
    if (SK && !act) { const float NEG = -__builtin_inff();
#pragma unroll
        for (int r = 0; r < 16; ++r) { p0[r] = NEG; p1[r] = NEG; } return; }
    { const f32x4 a0 = *(const f32x4*)(bl), a1 = *(const f32x4*)(bl + 8), a2 = *(const f32x4*)(bl + 16), a3 = *(const f32x4*)(bl + 24);
      const f32x4 c0 = *(const f32x4*)(bl + 32), c1 = *(const f32x4*)(bl + 40), c2 = *(const f32x4*)(bl + 48), c3 = *(const f32x4*)(bl + 56);
      p0 = (f32x16){a0[0], a0[1], a0[2], a0[3], a1[0], a1[1], a1[2], a1[3], a2[0], a2[1], a2[2], a2[3], a3[0], a3[1], a3[2], a3[3]};
      p1 = (f32x16){c0[0], c0[1], c0[2], c0[3], c1[0], c1[1], c1[2], c1[3], c2[0], c2[1], c2[2], c2[3], c3[0], c3[1], c3[2], c3[3]}; }
    const char* kb[4];
#pragma unroll
    for (int dd = 0; dd < 4; ++dd) kb[dd] = K_lds + KB * SHM_K + KSWZ(r32, (dd * 16 + hi * 8) * 2);
#pragma unroll
    for (int d0 = 0; d0 < 8; ++d0) { const char* a = kb[d0 & 3] + (d0 >> 2) * 128;
        bf16x8 b0 = *reinterpret_cast<const bf16x8*>(a);
        bf16x8 b1 = *reinterpret_cast<const bf16x8*>(a + 32 * 256);
        p0 = __builtin_amdgcn_mfma_f32_32x32x16_bf16(b0, qr[d0], p0, 0, 0, 0);
        p1 = __builtin_amdgcn_mfma_f32_32x32x16_bf16(b1, qr[d0], p1, 0, 0, 0); }
}
template <int VB, bool SK>
__device__ __forceinline__ void pv_tile(f32x16* o, int vb0, bf16x8 pa0, bf16x8 pa1, bf16x8 pa2, bf16x8 pa3, bool act) {
    if (SK && !act) return;
#define TRRD(dst, off) asm volatile("ds_read_b64_tr_b16 %0, %1 offset:%2" : "=&v"(dst) : "v"(vb0), "i"(off) : "memory")
#define PV_D0(d0) do { s16x4 l0, l1, l2, l3, h0, h1, h2, h3; constexpr int b_ = VB * SHM_V + v_rd_off(d0, 0, 0);     \
        TRRD(l0, b_); TRRD(h0, b_ + 2048); TRRD(l1, b_ + 4096); TRRD(h1, b_ + 6144); TRRD(l2, b_ + 8192); TRRD(h2, b_ + 10240); TRRD(l3, b_ + 12288); TRRD(h3, b_ + 14336); \
        asm volatile("s_waitcnt lgkmcnt(0)" ::: "memory"); SBAR();                 \
        o[d0] = __builtin_amdgcn_mfma_f32_32x32x16_bf16(pa0, (bf16x8){l0[0], l0[1], l0[2], l0[3], h0[0], h0[1], h0[2], h0[3]}, o[d0], 0, 0, 0);   \
        o[d0] = __builtin_amdgcn_mfma_f32_32x32x16_bf16(pa1, (bf16x8){l1[0], l1[1], l1[2], l1[3], h1[0], h1[1], h1[2], h1[3]}, o[d0], 0, 0, 0);   \
        o[d0] = __builtin_amdgcn_mfma_f32_32x32x16_bf16(pa2, (bf16x8){l2[0], l2[1], l2[2], l2[3], h2[0], h2[1], h2[2], h2[3]}, o[d0], 0, 0, 0);   \
        o[d0] = __builtin_amdgcn_mfma_f32_32x32x16_bf16(pa3, (bf16x8){l3[0], l3[1], l3[2], l3[3], h3[0], h3[1], h3[2], h3[3]}, o[d0], 0, 0, 0); } while (0)
    PV_D0(0); PV_D0(1); PV_D0(2); PV_D0(3);
#undef PV_D0
#undef TRRD
}

template <class TIn, class TOut> struct BlockRef { const TIn* Q; const TIn* K; const TIn* V; TOut* O; const float* bt; int P0; };
template <class TIn> struct Seam {
    bf16x8 qr[8];
    bf16x8 st_k0, st_k1;
};
__device__ __forceinline__ int swa_jlo(int P0, int W) { const int lowk = P0 - W + 1; return lowk > 0 ? lowk / KVBLK : 0; }
#define ROW(p, k0, rr) ((p) + (unsigned)(((k0) + (rr)) * KVP + sc))
#define VMW() asm volatile("s_waitcnt vmcnt(0)" ::: "memory")
#define VMWN(n) asm volatile("s_waitcnt vmcnt(%0)" :: "i"(n) : "memory")
#define SLOAD_F(p, k0) do { S.st_k0 = load8<TIn>(ROW(p, k0, sr)); S.st_k1 = load8<TIn>(ROW(p, k0, 32 + sr)); } while (0)
#define SWRITE_KF(bf) do { *(bf16x8*)(K_lds + (bf) * SHM_K + kws) = S.st_k0; *(bf16x8*)(K_lds + (bf) * SHM_K + kws + 32 * 256) = S.st_k1; } while (0)
#define SWRITE_VF(bf) do { *(bf16x8*)(V_lds + (bf) * SHM_V + vst0) = S.st_k0; *(bf16x8*)(V_lds + (bf) * SHM_V + vst1) = S.st_k1; } while (0)
template <class TIn, class TOut>
__device__ __forceinline__ void causal_swa_prime(const BlockRef<TIn, TOut>& cur, int W, char* lds, Seam<TIn>& S) {
    int tid_ = threadIdx.x; asm volatile("" : "+v"(tid_));
    const int tid = tid_, wid = __builtin_amdgcn_readfirstlane(tid >> 6), lane = tid & 63, r32 = lane & 31, hi = lane >> 5;
    const int sr = tid >> 4, sc = (tid & 15) * 8, kws = KSWZ(sr, sc * 2); char* K_lds = lds + 2 * SHM_V;
    const int kb0 = swa_jlo(cur.P0, W) * KVBLK;
    for (int d0 = 0; d0 < 8; ++d0) S.qr[d0] = load8<TIn>(cur.Q + (unsigned)((wid * QBLK + r32) * QP + hi * 8) + d0 * 16);
    SLOAD_F(cur.K, kb0); VMW(); SWRITE_KF(0); SBAR(); SLOAD_F(cur.V, kb0);
    __syncthreads();
}
template <class TIn, class TOut>
__device__ __forceinline__ void causal_swa_block(const BlockRef<TIn, TOut>& cur, const BlockRef<TIn, TOut>& nxt, int skv, int W, char* lds, Seam<TIn>& S) {
    int tid_ = threadIdx.x; asm volatile("" : "+v"(tid_));
    const int tid = tid_, wid = __builtin_amdgcn_readfirstlane(tid >> 6), lane = tid & 63, r32 = lane & 31, hi = lane >> 5;
    const int j_lo = swa_jlo(cur.P0, W);
    int j_hi = (cur.P0 + QB - 1) / KVBLK + 1; if (j_hi > skv / KVBLK) j_hi = skv / KVBLK;
    const int NT = j_hi - j_lo;
    const int kbn = swa_jlo(nxt.P0, W) * KVBLK;
    const int qlo = cur.P0 + wid * QBLK, qm = qlo + r32 - 4 * hi;
    char* V_lds = lds; char* K_lds = lds + 2 * SHM_V;
    float* ws = (float*)(lds + 2 * SHM_V + 2 * SHM_K) + wid * 64; float* li_l = ws, * al_l = ws + 32;
    float m_reg = -1e30f, l_reg = 0; f32x16 o[4] = {};
    const int sr = tid >> 4, sc = (tid & 15) * 8, vst0 = v_st(sr, sc), vst1 = v_st(32 + sr, sc), kws = KSWZ(sr, sc * 2);
    const int vb0 = (int)(uintptr_t)V_lds + v_rd_base(lane);
    const TIn* Kh = cur.K; const TIn* Vh = cur.V;
    const float* btab = cur.bt + 4 * hi;
#define RESC(a) do { if (__any((a) < 1.f)) { if (hi == 0) al_l[r32] = (a); asm volatile("s_waitcnt lgkmcnt(0)" ::: "memory");              \
                     for (int d_ = 0; d_ < 4; ++d_) for (int r = 0; r < 16; ++r) o[d_][r] *= al_l[crow(r, hi)]; } } while (0)
#define KBASE(t) ((j_lo + (t)) * KVBLK)
#define ACT(t) (KBASE(t) <= qlo + QBLK - 1 && KBASE(t) + KVBLK - 1 >= qlo - W + 1)
#define MASKT(P0_, P1_, t) do { const int kb_ = KBASE(t); if ((!SK || ACT(t)) && (kb_ + KVBLK - 1 > qlo || kb_ <= qlo + QBLK - 1 - W)) mask_tile(P0_, P1_, qm - kb_, (unsigned)W); } while (0)
    constexpr int NQL = 8;
    constexpr bool SK = WSKIP;
#define SEAM_K0() do { VMWN(NQL); SWRITE_KF(0); SBAR(); SLOAD_F(nxt.V, kbn); SBAR(); } while (0)
    f32x16 pA0, pA1, pB0, pB1; float mnA, mnB, alA, alB; bf16x8 pa0, pa1, pa2, pa3;
    VMW(); SWRITE_VF(0); SBAR();
    if (NT > 1) { SLOAD_F(Kh, KBASE(1)); }
    SBAR(); qkt<0, SK>(pA0, pA1, K_lds, r32, hi, S.qr, ACT(0), btab + KBASE(0));
    if (NT > 1) { VMW(); SWRITE_KF(1); SBAR(); SLOAD_F(Vh, KBASE(1)); }
    MASKT(pA0, pA1, 0); partialSM(pA0, pA1, m_reg, mnA, alA);
    if (NT > 1) { VMW(); SWRITE_VF(1); SBAR(); if (NT > 2) SLOAD_F(Kh, KBASE(2)); }
    __syncthreads();
#define HALF_STEP(PX0, PX1, mnX, alX, PY0, PY1, alY, t, KB, VB, SB) do {                                                      \
        SBAR(); qkt<KB, SK>(PX0, PX1, K_lds, r32, hi, S.qr, ACT(t), btab + KBASE(t));                                             \
        finishSM(PY0, PY1, alY, l_reg, pa0, pa1, pa2, pa3); SBAR();                                                           \
        if ((t) + 1 < NT) { VMW(); SWRITE_KF(SB); SBAR(); SLOAD_F(Vh, KBASE((t) + 1)); SBAR(); }                              \
        pv_tile<VB, SK>(o, vb0, pa0, pa1, pa2, pa3, ACT((t) - 1)); MASKT(PX0, PX1, (t)); partialSM(PX0, PX1, m_reg, mnX, alX);                                        \
        __syncthreads();                                                                                                      \
        if ((t) + 1 < NT) { VMW(); SWRITE_VF(SB); SBAR(); if ((t) + 2 < NT) SLOAD_F(Kh, KBASE((t) + 2)); }                    \
        RESC(alX); __syncthreads(); } while (0)
    for (int t = 1; t + 1 < NT; t += 2) {
        HALF_STEP(pB0, pB1, mnB, alB, pA0, pA1, alA, t, 1, 0, 0);
        HALF_STEP(pA0, pA1, mnA, alA, pB0, pB1, alB, t + 1, 0, 1, 1);
    }
    const bool even = (NT & 1) == 0;
    if (even) { SBAR(); qkt<1, SK>(pB0, pB1, K_lds, r32, hi, S.qr, ACT(NT - 1), btab + KBASE(NT - 1)); SBAR(); }
    SLOAD_F(nxt.K, kbn); SBAR();
#pragma unroll
    for (int d0 = 0; d0 < 8; ++d0) S.qr[d0] = load8<TIn>(nxt.Q + (unsigned)((wid * QBLK + r32) * QP + hi * 8) + d0 * 16);
    SBAR();
    finishSM(pA0, pA1, alA, l_reg, pa0, pa1, pa2, pa3); SBAR();
    pv_tile<0, SK>(o, vb0, pa0, pa1, pa2, pa3, ACT(even ? NT - 2 : NT - 1));
    if (even) { MASKT(pB0, pB1, NT - 1); partialSM(pB0, pB1, m_reg, mnB, alB); __syncthreads(); RESC(alB);
        finishSM(pB0, pB1, alB, l_reg, pa0, pa1, pa2, pa3); SBAR(); pv_tile<1, SK>(o, vb0, pa0, pa1, pa2, pa3, ACT(NT - 1)); }
    SBAR(); SEAM_K0();
    if (hi == 0) li_l[r32] = l_reg; asm volatile("s_waitcnt lgkmcnt(0)" ::: "memory");
    float rli[16];
#pragma unroll
    for (int r = 0; r < 16; ++r) rli[r] = __builtin_amdgcn_rcpf(li_l[crow(r, hi)]);
    TOut* Ow = cur.O + (unsigned)(wid * QBLK * OP);
#pragma unroll
    for (int r = 0; r < 16; ++r) { const int orow = crow(r, hi);
#pragma unroll
        for (int d0 = 0; d0 < 4; ++d0) { const float v = o[d0][r] * rli[r];
            if constexpr (same_t<TOut, float>::v) { Ow[(unsigned)(orow * OP + d0 * 32 + r32)] = v; }
            else { const float vn = __shfl_xor(v, 1);
                   if ((r32 & 1) == 0) *(unsigned*)(Ow + (unsigned)(orow * OP + d0 * 32 + r32)) = cvtpk(v, vn); } } }
    __syncthreads();
#undef RESC
#undef KBASE
#undef ACT
#undef MASKT
#undef SEAM_K0
#undef HALF_STEP
}
#undef ROW
#undef VMW
#undef VMWN
#undef SLOAD_F
#undef SWRITE_KF
#undef SWRITE_VF
constexpr int NONE = 1 << 20;
__device__ __forceinline__ BlockRef<bf16, bf16> fox_ref(int id, const bf16* FQKV, bf16* OFOX, const float* bt) {
    const int q = id >> 6, i = id & 63, qb = 15 - (i >> 2), bh = 4 * q + (i & 3), b = bh >> 4, h = bh & 15;
    BlockRef<bf16, bf16> r; const size_t row0 = (size_t)b * 4096;
    r.Q = FQKV + (row0 + (size_t)qb * QB) * QP + h * 128; r.K = FQKV + row0 * KVP + 2048 + h * 128; r.V = FQKV + row0 * KVP + 4096 + h * 128;
    r.O = OFOX + (row0 + (size_t)qb * QB) * OP + h * 128; r.bt = bt; r.P0 = qb * QB; return r;
}
__device__ __forceinline__ int fox_grab(unsigned* qctr, int x, int& qoff) {
    while (qoff < 8) { const int q = (x + qoff) & 7; const unsigned i = __hip_atomic_fetch_add(qctr + 64 * q, 1u, __ATOMIC_RELAXED, __HIP_MEMORY_SCOPE_AGENT);
        if (i < 64u) return q * 64 + (int)i; ++qoff; }
    return NONE;
}
__device__ __forceinline__ void fox_table(char* lds, int slot, int id, const float* FB) {
    int tid = threadIdx.x; asm volatile("" : "+v"(tid));
    const int q = id >> 6, i = id & 63, qb = 15 - (i >> 2), bh = 4 * q + (i & 3);
    if (8 * tid < 256 * (qb + 1)) { const float* fb = FB + (size_t)bh * 4096 + tid * 8; float* tb = (float*)(lds + BIAS_OFF) + slot * 4096 + tid * 8;
        const f32x4 v0 = *(const f32x4*)fb, v1 = *(const f32x4*)(fb + 4); *(f32x4*)tb = v0; *(f32x4*)(tb + 4) = v1; }
}
__device__ __forceinline__ void fox_phase(char* lds, unsigned* qctr, int x, const bf16* FQKV, bf16* OFOX, const float* FB) {
    constexpr int SKV_ = 4096, W = 4096;
    volatile int* mb = (volatile int*)(lds + MB_OFF);
    int qoff = 0;
    __syncthreads();
    if (threadIdx.x == 0) { mb[0] = fox_grab(qctr, x, qoff); mb[1] = fox_grab(qctr, x, qoff); }
    __syncthreads();
    int cur = mb[0], nxt = mb[1], slot = 0, k = 0;
    if (cur == NONE) return;
    fox_table(lds, 0, cur, FB);
    Seam<bf16> S;
    { const BlockRef<bf16, bf16> r0 = fox_ref(cur, FQKV, OFOX, (const float*)(lds + BIAS_OFF));
      causal_swa_prime<bf16, bf16>(r0, W, lds, S); }
    for (;;) {
        if (threadIdx.x == 0) mb[k & 1] = fox_grab(qctr, x, qoff);
        if (nxt != NONE) fox_table(lds, slot ^ 1, nxt, FB);
        const BlockRef<bf16, bf16> rc = fox_ref(cur, FQKV, OFOX, (const float*)(lds + BIAS_OFF) + slot * 4096);
        const BlockRef<bf16, bf16> rn = (nxt != NONE) ? fox_ref(nxt, FQKV, OFOX, (const float*)(lds + BIAS_OFF) + (slot ^ 1) * 4096) : rc;
        causal_swa_block<bf16, bf16>(rc, rn, SKV_, W, lds, S);
        const int g = mb[k & 1];
        cur = nxt; nxt = g; slot ^= 1; ++k;
        if (cur == NONE) break;
    }
}
}

struct Ctx { LAS unsigned char* lds; int wave, gw, NW, G; };

__device__ __forceinline__ void transpose_item(const float* W, int ldw, int k0, int c0, bf16* WT, int K, int r0, LAS float* scr, int lane) {
#pragma unroll
    for (int i = 0; i < 32; ++i) { const int kk = 2 * i + (lane >> 5); scr[kk * 33 + (lane & 31)] = W[(size_t)(k0 + kk) * ldw + c0 + (lane & 31)]; }
    asm volatile("s_waitcnt lgkmcnt(0)" ::: "memory");
    const int c = lane & 7;
#pragma unroll
    for (int j = 0; j < 4; ++j) { const int n = (lane >> 3) + 8 * j; const LAS float* s = scr + (8 * c) * 33 + n;
        u32x4 o; o.x = pk2(s[0 * 33], s[1 * 33]); o.y = pk2(s[2 * 33], s[3 * 33]); o.z = pk2(s[4 * 33], s[5 * 33]); o.w = pk2(s[6 * 33], s[7 * 33]);
        *(u32x4*)(WT + (size_t)(r0 + n) * K + k0 + 8 * c) = o; }
    asm volatile("s_waitcnt lgkmcnt(0)" ::: "memory");
}
__device__ __forceinline__ void map_rows(int mode, int nb, int& c0, int& r0) {
    const int n0 = nb * 32;
    if (mode == 0) { c0 = n0; r0 = n0; }
    else if (mode == 1) { r0 = n0; c0 = n0 < 12288 ? n0 : (n0 < 18432 ? SRC_FQKV + (n0 - 12288) : SRC_MERGE + (n0 - 18432)); }
    else { c0 = n0; r0 = (n0 >> 7) * 256 + (n0 & 127) + (mode == 3 ? 128 : 0); }
}
__device__ __forceinline__ void ph_transpose(const Ctx& c, const float* W, int K, int ldw, int ncols, bf16* WT, int mode) {
    LAS float* scr = (LAS float*)(c.lds + c.wave * 16384); int lane = threadIdx.x & 63; asm volatile("" : "+v"(lane));
    const int nblk = ncols / 32, nitems = (K / 64) * nblk;
    for (int it = c.gw; it < nitems; it += c.NW) { const int kb = it / nblk, nb = it % nblk; int c0, r0; map_rows(mode, nb, c0, r0);
        transpose_item(W, ldw, kb * 64, c0, WT, K, r0, scr, lane); }
}
__device__ __forceinline__ void ph_wsmall(const Ctx& c, const float* w_in, bf16* wsm) {
    int lane = threadIdx.x & 63; asm volatile("" : "+v"(lane));
    for (int idx = c.gw * 64 + lane; idx < DEPTH * D * 96; idx += c.NW * 64) {
        const int j = idx % 96, k = (idx / 96) % D, l = idx / (96 * D);
        const int sc = j < 32 ? SRC_B + j : (j < 64 ? SRC_A + (j - 32) : SRC_F + (j - 64));
        wsm[((size_t)l * 96 + j) * D + k] = j < NSM ? (bf16)f2bf(w_in[((size_t)l * D + k) * NIN + sc]) : (bf16)0; }
}
__device__ __forceinline__ void ph_smallproj(const Ctx& c, const bf16* H, const bf16* wsm, float* baf) {
    typedef short bf16x8s __attribute__((ext_vector_type(8))); typedef float f32x16s __attribute__((ext_vector_type(16)));
    int tid = threadIdx.x; asm volatile("" : "+v"(tid)); const int lane = tid & 63, r = lane & 31, kq = lane >> 5;
    LAS float* part = (LAS float*)c.lds;
    for (int task = blockIdx.x; task < M / 32; task += c.G) {
        const bf16* ap = H + (size_t)(32 * task + r) * D + 256 * c.wave + 8 * kq; const bf16* bp = wsm + (size_t)r * D + 256 * c.wave + 8 * kq;
        f32x16s acc[3] = {};
#pragma unroll
        for (int s8 = 0; s8 < 16; ++s8) { const bf16x8s a = *(const bf16x8s*)(ap + 16 * s8);
#pragma unroll
            for (int j = 0; j < 3; ++j) acc[j] = __builtin_amdgcn_mfma_f32_32x32x16_bf16(a, *(const bf16x8s*)(bp + (size_t)(32 * j) * D + 16 * s8), acc[j], 0, 0, 0); }
        __syncthreads();
#pragma unroll
        for (int j = 0; j < 3; ++j)
#pragma unroll
            for (int rr = 0; rr < 16; ++rr) part[((c.wave * 3 + j) * 16 + rr) * 64 + lane] = acc[j][rr];
        __syncthreads();
#pragma unroll
        for (int i = 0; i < 6; ++i) { const int idx = tid + 512 * i, j = idx >> 10, rr = (idx >> 6) & 15, ln = idx & 63; float sum = 0.f;
#pragma unroll
            for (int w = 0; w < 8; ++w) sum += part[w * 3072 + idx];
            const int col = 32 * j + (ln & 31), row = (rr & 3) + 8 * (rr >> 2) + 4 * (ln >> 5);
            if (col < NSM) baf[(size_t)(32 * task + row) * NSM + col] = sum; }
    }
}
__device__ __forceinline__ void ph_adaln(const Ctx& c, const float* cin, const float* w_ada, const float* b_ada, float* mod) {
    LAS float* cond = (LAS float*)c.lds;
    LAS float* red = (LAS float*)(c.lds + 16384);
    int tid = threadIdx.x; asm volatile("" : "+v"(tid)); const int lane = tid & 63;
    for (int i = tid; i < 2 * D; i += 512) cond[i] = fsilu(cin[i]);
    __syncthreads();
    const int ntask = DEPTH * (6 * D / 64);
    for (int task = blockIdx.x; task < ntask; task += c.G) {
        const int l = task / (6 * D / 64), n = (task % (6 * D / 64)) * 64 + lane;
        const float* w = w_ada + (size_t)l * D * (6 * D) + n; float a0 = 0.f, a1 = 0.f;
#pragma unroll 8
        for (int k = c.wave * 256; k < c.wave * 256 + 256; ++k) { const float wv = w[(size_t)k * (6 * D)]; a0 += cond[k] * wv; a1 += cond[D + k] * wv; }
        red[(c.wave * 2 + 0) * 64 + lane] = a0; red[(c.wave * 2 + 1) * 64 + lane] = a1;
        __syncthreads();
        if (tid < 128) { const int b = tid >> 6; float s = b_ada[(size_t)l * 6 * D + n];
#pragma unroll
            for (int w8 = 0; w8 < 8; ++w8) s += red[(w8 * 2 + b) * 64 + lane];
            mod[((size_t)l * 2 + b) * (6 * D) + n] = s; }
        __syncthreads();
    }
}

struct RowArgs { const float* xin; float* x; const float* Y; const float* gy; const float* gate; const float* gn; const float* scale; const float* shift; bf16* H; int has_y, has_h; };
__device__ __forceinline__ void ph_rowpass(const Ctx& c, const RowArgs& a) {
    int lane = threadIdx.x & 63; asm volatile("" : "+v"(lane));
    for (int m = c.gw; m < M; m += c.NW) {
        const int b = m / T; const size_t ro = (size_t)m * D; const int mo = b * 6 * D;
        f32x4 v[8];
#pragma unroll
        for (int i = 0; i < 8; ++i) v[i] = *(const f32x4*)(a.xin + ro + 4 * lane + 256 * i);
        if (a.has_y) {
            f32x4 y[8]; float ss = 0.f;
#pragma unroll
            for (int i = 0; i < 8; ++i) { y[i] = *(const f32x4*)(a.Y + ro + 4 * lane + 256 * i); ss += (y[i][0] * y[i][0] + y[i][1] * y[i][1]) + (y[i][2] * y[i][2] + y[i][3] * y[i][3]); }
            const float r = rsqrtf(wave_sum(ss) * (1.0f / D) + EPS);
#pragma unroll
            for (int i = 0; i < 8; ++i) { const int cc = 4 * lane + 256 * i; const f32x4 g = *(const f32x4*)(a.gy + cc), gt = *(const f32x4*)(a.gate + mo + cc);
                v[i] = v[i] + gt * (y[i] * r * g); }
        }
#pragma unroll
        for (int i = 0; i < 8; ++i) *(f32x4*)(a.x + ro + 4 * lane + 256 * i) = v[i];
        if (!a.has_h) continue;
        float ss = 0.f;
#pragma unroll
        for (int i = 0; i < 8; ++i) ss += (v[i][0] * v[i][0] + v[i][1] * v[i][1]) + (v[i][2] * v[i][2] + v[i][3] * v[i][3]);
        const float r = rsqrtf(wave_sum(ss) * (1.0f / D) + EPS);
#pragma unroll
        for (int i = 0; i < 8; ++i) { const int cc = 4 * lane + 256 * i; const f32x4 g = *(const f32x4*)(a.gn + cc), sc = *(const f32x4*)(a.scale + mo + cc), sh = *(const f32x4*)(a.shift + mo + cc);
            v[i] = v[i] * r * g * (sc + 1.0f) + sh;
            u32x2 w; w.x = pk2(v[i][0], v[i][1]); w.y = pk2(v[i][2], v[i][3]); *(u32x2*)(a.H + ro + cc) = w; }
    }
}

__device__ __forceinline__ void ph_conv(const Ctx& c, const bf16* raw, const float* convw  , bf16* dnc) {
    int lane = threadIdx.x & 63; asm volatile("" : "+v"(lane));
    constexpr int NTASK = (M / 8) * 64;
    unsigned ua[11], ub[11]; f32x4 wa0, wa1, wb0, wb1;
#define CONV_LOAD(task, U, W0, W1) do { const int hv_ = (task) & 63, m0_ = ((task) >> 6) * 8, t0_ = m0_ % T, ch_ = hv_ * 128 + 2 * lane; \
        W0 = *(const f32x4*)(convw + (size_t)ch_ * 4); W1 = *(const f32x4*)(convw + (size_t)ch_ * 4 + 4); \
        _Pragma("unroll") for (int i = 0; i < 11; ++i) U[i] = ((t0_ + i - 3) >= 0) ? *(const unsigned*)(raw + (size_t)(m0_ + i - 3) * DN_CONV + ch_) : 0u; } while (0)
    int task = c.gw;
    if (task < NTASK) CONV_LOAD(task, ua, wa0, wa1);
    for (; task < NTASK; task += c.NW) {
        const int nxt = task + c.NW;
        if (nxt < NTASK) CONV_LOAD(nxt, ub, wb0, wb1);
        const int hv = task & 63, m0 = (task >> 6) * 8, ch = hv * 128 + 2 * lane;
        float a0[8], a1[8];
#pragma unroll
        for (int i = 0; i < 8; ++i) { a0[i] = fsilu(wa0[0] * bf_lo(ua[i]) + wa0[1] * bf_lo(ua[i + 1]) + wa0[2] * bf_lo(ua[i + 2]) + wa0[3] * bf_lo(ua[i + 3]));
                                      a1[i] = fsilu(wa1[0] * bf_hi(ua[i]) + wa1[1] * bf_hi(ua[i + 1]) + wa1[2] * bf_hi(ua[i + 2]) + wa1[3] * bf_hi(ua[i + 3])); }
        if (hv < 32) { float ss[8];
#pragma unroll
            for (int i = 0; i < 8; ++i) ss[i] = a0[i] * a0[i] + a1[i] * a1[i];
#pragma unroll
            for (int o = 1; o < 64; o <<= 1)
#pragma unroll
                for (int i = 0; i < 8; ++i) ss[i] += __shfl_xor(ss[i], o);
#pragma unroll
            for (int i = 0; i < 8; ++i) { float rr = rsqrtf(ss[i] + EPS); if (hv < 16) rr *= 0.08838834764831845f; a0[i] *= rr; a1[i] *= rr; } }
#pragma unroll
        for (int i = 0; i < 8; ++i) *(unsigned*)(dnc + (size_t)(m0 + i) * DN_CONV + ch) = pk2(a0[i], a1[i]);
#pragma unroll
        for (int i = 0; i < 11; ++i) ua[i] = ub[i];
        wa0 = wb0; wa1 = wb1;
    }
#undef CONV_LOAD
}
__device__ __forceinline__ float softplus_f(float x) { return fmaxf(x, 0.f) + log1pf(__expf(-fabsf(x))); }
__device__ __forceinline__ void ph_gates(const Ctx& c, const float* baf, const float* a_log, const float* dt_bias, const float* f_bias, float* beta, float* g, float* logf) {
    int lane = threadIdx.x & 63; asm volatile("" : "+v"(lane));
    for (int idx = c.gw * 64 + lane; idx < M * NSM; idx += c.NW * 64) {
        const int m = idx / NSM, j = idx % NSM; const float v = baf[idx];
        if (j < 32) beta[(size_t)m * 32 + j] = 1.0f / (1.0f + expf(-v));
        else if (j < 64) { const int h = j - 32; g[(size_t)m * 32 + h] = -expf(a_log[h]) * softplus_f(v + dt_bias[h]); }
        else { const int h = j - 64; logf[(size_t)m * 16 + h] = -softplus_f(-(v + f_bias[h])); } }
}
__device__ __forceinline__ void ph_fcum(const Ctx& c, const float* logf, float* fc) {
    int lane = threadIdx.x & 63; asm volatile("" : "+v"(lane));
    for (int bh = c.gw; bh < NB * FOXH; bh += c.NW) { const int b = bh / FOXH, h = bh % FOXH; float carry = 0.f; float v[64];
#pragma unroll
        for (int i = 0; i < 64; ++i) v[i] = logf[(size_t)(b * T + 64 * i + lane) * 16 + h];
#pragma unroll
        for (int i = 0; i < 64; ++i) { float x = v[i];
#pragma unroll
            for (int o = 1; o < 64; o <<= 1) { const float u = __shfl_up(x, o); if (lane >= o) x += u; }
            x += carry; fc[(size_t)bh * T + 64 * i + lane] = x * (-11.313708498984761f); carry = __shfl(x, 63); } }
}
__device__ __forceinline__ void ph_dn_naive(const Ctx& c, const bf16* dnc, const float* g, const float* beta, float* o) {
    int lane = threadIdx.x & 63; asm volatile("" : "+v"(lane));
    constexpr int TB = 16;
    for (int gw = c.gw; gw < NB * 32 * 128; gw += c.NW) {
        const int j = gw & 127, hv = (gw >> 7) & 31, b = gw >> 12, hq = hv >> 1;
        const bf16* rowq = dnc + (size_t)b * T * DN_CONV + hq * 128 + 2 * lane; const bf16* rowv = dnc + (size_t)b * T * DN_CONV + 4096 + hv * 128 + j;
        const float* gp = g + (size_t)b * T * 32 + hv; const float* bp = beta + (size_t)b * T * 32 + hv;
        unsigned qa[TB], ka[TB]; float va[TB], ga[TB], ba[TB];
#pragma unroll
        for (int i = 0; i < TB; ++i) { qa[i] = *(const unsigned*)(rowq + (size_t)i * DN_CONV); ka[i] = *(const unsigned*)(rowq + (size_t)i * DN_CONV + 2048); va[i] = bf2f(rowv[(size_t)i * DN_CONV]); ga[i] = gp[i * 32]; ba[i] = bp[i * 32]; }
        float s0 = 0.f, s1 = 0.f;
        for (int t0 = 0; t0 < T; t0 += TB) {
            unsigned qn[TB], kn[TB]; float vn[TB], gn[TB], bn[TB];
            const int tn = (t0 + TB < T) ? t0 + TB : t0;
#pragma unroll
            for (int i = 0; i < TB; ++i) { const size_t tt = (size_t)(tn + i); qn[i] = *(const unsigned*)(rowq + tt * DN_CONV); kn[i] = *(const unsigned*)(rowq + tt * DN_CONV + 2048); vn[i] = bf2f(rowv[tt * DN_CONV]); gn[i] = gp[tt * 32]; bn[i] = bp[tt * 32]; }
#pragma unroll
            for (int i = 0; i < TB; ++i) {
                const float q0 = bf_lo(qa[i]), q1 = bf_hi(qa[i]), k0 = bf_lo(ka[i]), k1 = bf_hi(ka[i]), eg = __expf(ga[i]);
                s0 *= eg; s1 *= eg;
                float dk = s0 * k0 + s1 * k1, dq = s0 * q0 + s1 * q1, kq = k0 * q0 + k1 * q1;
#pragma unroll
                for (int of = 1; of < 64; of <<= 1) { dk += __shfl_xor(dk, of); dq += __shfl_xor(dq, of); kq += __shfl_xor(kq, of); }
                const float cc = ba[i] * (va[i] - dk);
                s0 += cc * k0; s1 += cc * k1;
                if (lane == 0) o[((size_t)b * T + t0 + i) * 4096 + hv * 128 + j] = dq + cc * kq; }
#pragma unroll
            for (int i = 0; i < TB; ++i) { qa[i] = qn[i]; ka[i] = kn[i]; va[i] = vn[i]; ga[i] = gn[i]; ba[i] = bn[i]; }
        }
    }
}
__device__ __forceinline__ void ph_dn_norm(const Ctx& c, const float* o, const float* norm_w, const bf16* zs, bf16* odn) {
    int lane = threadIdx.x & 63; asm volatile("" : "+v"(lane));
    for (int gw = c.gw; gw < M * 32; gw += c.NW) { const size_t off = (size_t)gw * 128 + 2 * lane;
        const float a0 = o[off], a1 = o[off + 1]; const float r = rsqrtf(wave_sum(a0 * a0 + a1 * a1) * (1.0f / 128.0f) + EPS);
        const unsigned zu = *(const unsigned*)(zs + off);
        *(unsigned*)(odn + off) = pk2(a0 * r * norm_w[2 * lane] * bf_lo(zu), a1 * r * norm_w[2 * lane + 1] * bf_hi(zu)); }
}
constexpr int RING_BYTES = 131072;
constexpr int LDSCTL_OFF = RING_BYTES, MISC_OFF = LDSCTL_OFF + 320;
constexpr int LDS_BYTES = 147456;


namespace dn {
typedef short bf16x8 __attribute__((ext_vector_type(8)));
typedef short s16x4 __attribute__((ext_vector_type(4)));
typedef float f32x16 __attribute__((ext_vector_type(16)));
typedef float f32x8 __attribute__((ext_vector_type(8)));
typedef __bf16 bf16x8_t __attribute__((ext_vector_type(8)));
#define DN_MFMA(a, b, c) __builtin_amdgcn_mfma_f32_32x32x16_bf16((a), (b), (c), 0, 0, 0)
constexpr int UNIT_FRAGS = 54;
constexpr int F_NW = 0, F_QG = 16, F_KGT = 32, F_AT = 48;
constexpr int UNIT_BYTES = UNIT_FRAGS * 1024;
constexpr int DU_UNIT = 4 * 2 * 64 * 16;

template <int S> __device__ __forceinline__ bf16x8 pack_step(const f32x16& x) {
    const f32x8 v = {x[8 * S + 0], x[8 * S + 1], x[8 * S + 2], x[8 * S + 3], x[8 * S + 4], x[8 * S + 5], x[8 * S + 6], x[8 * S + 7]};
    return __builtin_bit_cast(bf16x8, __builtin_convertvector(v, bf16x8_t));
}
__device__ __forceinline__ bf16x8 pack8(const f32x8& v) { return __builtin_bit_cast(bf16x8, __builtin_convertvector(v, bf16x8_t)); }
__device__ __forceinline__ f32x8 unpack8(const bf16x8& b) { f32x8 v;
#pragma unroll
    for (int j = 0; j < 8; ++j) v[j] = __uint_as_float(((unsigned)(unsigned short)b[j]) << 16);
    return v; }
__device__ __forceinline__ bf16x8 tr_frag(LAS unsigned char* a0  , int col0, int kb, int st) {
    LAS s16x4* p = (LAS s16x4*)(a0 + (32 * kb + 16 * st) * 256 + col0 * 2);
    const s16x4 lo = __builtin_amdgcn_ds_read_tr16_b64_v4i16(p), hi = __builtin_amdgcn_ds_read_tr16_b64_v4i16(p + 256);
    return __builtin_shufflevector(lo, hi, 0, 1, 2, 3, 4, 5, 6, 7);
}
__device__ __forceinline__ LAS unsigned char* tr_base(LAS unsigned char* img, int lane) {
    const int i16 = lane & 15, q = i16 >> 2, p = i16 & 3, cblk = (lane >> 4) & 1, h = lane >> 5;
    return img + (4 * h + q) * 256 + cblk * 32 + 8 * p;
}

__device__ __forceinline__ f32x16 mm2(const bf16x8& a0, const bf16x8& a1, const bf16x8& b0, const bf16x8& b1, f32x16 c) { c = DN_MFMA(a0, b0, c); c = DN_MFMA(a1, b1, c); return c; }
__device__ __forceinline__ void inv_diag(const f32x16& Y, const f32x16& Yt, int r, int h, f32x16& R, f32x16& Rt) {
    f32x16 Yd = Y, Ysub = {}, Ytd = Yt, Ytsub = {};
#pragma unroll
    for (int rr = 8; rr < 16; ++rr) { if (r < 16) { Ysub[rr] = Yd[rr]; Yd[rr] = 0.f; } }
#pragma unroll
    for (int rr = 0; rr < 8; ++rr) { if (r >= 16) { Ytsub[rr] = Ytd[rr]; Ytd[rr] = 0.f; } }
    f32x16 D = Yd, Dt = Ytd;
#pragma unroll
    for (int rr = 0; rr < 16; ++rr) { const float e = ((rr & 3) + 8 * (rr >> 2) + 4 * h == r) ? 1.f : 0.f; D[rr] += e; Dt[rr] += e; }
    bf16x8 Zp0 = pack_step<0>(Yd), Zp1 = pack_step<1>(Yd), Ztp0 = pack_step<0>(Ytd), Ztp1 = pack_step<1>(Ytd);
#pragma unroll 1
    for (int it = 0; it < 3; ++it) {
        const f32x16 zn = mm2(Ztp0, Ztp1, Zp0, Zp1, (f32x16){}), ztn = mm2(Zp0, Zp1, Ztp0, Ztp1, (f32x16){});
        Zp0 = pack_step<0>(zn); Zp1 = pack_step<1>(zn); Ztp0 = pack_step<0>(ztn); Ztp1 = pack_step<1>(ztn);
        const bf16x8 dp0 = pack_step<0>(D), dp1 = pack_step<1>(D), dtp0 = pack_step<0>(Dt), dtp1 = pack_step<1>(Dt);
        Dt = mm2(Zp0, Zp1, dtp0, dtp1, Dt); D = mm2(Ztp0, Ztp1, dp0, dp1, D);
        __builtin_amdgcn_sched_barrier(0);
    }
    const bf16x8 dp0 = pack_step<0>(D), dp1 = pack_step<1>(D), dtp0 = pack_step<0>(Dt), dtp1 = pack_step<1>(Dt);
    const f32x16 M1 = mm2(pack_step<0>(Ytsub), pack_step<1>(Ytsub), dp0, dp1, (f32x16){});
    const f32x16 M1t = mm2(pack_step<0>(Ysub), pack_step<1>(Ysub), dtp0, dtp1, (f32x16){});
    R = mm2(dtp0, dtp1, pack_step<0>(M1), pack_step<1>(M1), D);
    Rt = mm2(dp0, dp1, pack_step<0>(M1t), pack_step<1>(M1t), Dt);
}

__device__ __forceinline__ void prep_unit(int u, const bf16* DNC, const float* GG, const float* BETA, unsigned char* DNP, float* DU, float* EGL,
                                          LAS unsigned char* img, LAS float* tbl, int lane) {
    const int b = u >> 11, hv = (u >> 6) & 31, n = u & 63, hq = hv >> 1, m0 = b * T + n * 64, r = lane & 31, h = lane >> 5;
    const bf16* qbase = DNC + (size_t)m0 * DN_CONV + hq * 128; const bf16* kbase = qbase + 2048; const bf16* vbase = DNC + (size_t)m0 * DN_CONV + 4096 + hv * 128;
    unsigned char* outp = DNP + (size_t)u * UNIT_BYTES + lane * 16;
    float gc = GG[(size_t)(m0 + lane) * 32 + hv]; const float be = BETA[(size_t)(m0 + lane) * 32 + hv];
#pragma unroll
    for (int o = 1; o < 64; o <<= 1) { const float t = __shfl_up(gc, o); if (lane >= o) gc += t; }
    const float glast = __shfl(gc, 63);
    tbl[lane] = gc; tbl[64 + lane] = be;
    if (lane == 0) EGL[u] = __expf(glast);
    asm volatile("s_waitcnt lgkmcnt(0)" ::: "memory");
    const float gcol[2] = {tbl[r], tbl[32 + r]}, bcol[2] = {tbl[64 + r], tbl[96 + r]};
    bf16x8 kf[2][8];
#pragma unroll
    for (int i = 0; i < 2; ++i)
#pragma unroll
        for (int s = 0; s < 8; ++s) kf[i][s] = *(const bf16x8*)(kbase + (unsigned)((32 * i + r) * DN_CONV + 16 * s + 8 * h));
    {
        bf16x8 qf[2][8];
#pragma unroll
        for (int i = 0; i < 2; ++i)
#pragma unroll
            for (int s = 0; s < 8; ++s) qf[i][s] = *(const bf16x8*)(qbase + (unsigned)((32 * i + r) * DN_CONV + 16 * s + 8 * h));
#pragma unroll
        for (int t = 0; t < 3; ++t) { const int I = (t == 2) ? 1 : 0, J = (t == 0) ? 0 : 1;
            f32x16 acc = {};
#pragma unroll
            for (int s = 0; s < 8; ++s) acc = DN_MFMA(kf[I][s], qf[J][s], acc);
#pragma unroll
            for (int g4 = 0; g4 < 4; ++g4) { const f32x4 gs = *(const LAS f32x4*)(tbl + 32 * I + 8 * g4 + 4 * h);
#pragma unroll
                for (int j = 0; j < 4; ++j) { const int rr = 4 * g4 + j; const bool ok = (I != J) || (8 * g4 + 4 * h + j <= r);
                    acc[rr] = ok ? acc[rr] * __expf(gcol[J] - gs[j]) : 0.f; } }
            *(bf16x8*)(outp + (F_AT + t * 2 + 0) * 1024) = pack_step<0>(acc); *(bf16x8*)(outp + (F_AT + t * 2 + 1) * 1024) = pack_step<1>(acc); }
    }
    __builtin_amdgcn_sched_barrier(0);
    f32x16 Z[3], Zt[3], Rt[3];
    {
        f32x16 KK[2][2];
#pragma unroll
        for (int I = 0; I < 2; ++I)
#pragma unroll
            for (int J = 0; J < 2; ++J) { f32x16 acc = {};
#pragma unroll
                for (int s = 0; s < 8; ++s) acc = DN_MFMA(kf[I][s], kf[J][s], acc);
                KK[I][J] = acc; }
#pragma unroll
        for (int t = 0; t < 3; ++t) { const int I = (t == 2) ? 1 : 0, J = (t == 0) ? 0 : 1; f32x16 x;
#pragma unroll
            for (int g4 = 0; g4 < 4; ++g4) { const f32x4 gs = *(const LAS f32x4*)(tbl + 32 * I + 8 * g4 + 4 * h);
#pragma unroll
                for (int j = 0; j < 4; ++j) { const int rr = 4 * g4 + j; const bool ok = (I != J) || (8 * g4 + 4 * h + j < r);
                    x[rr] = ok ? -bcol[J] * KK[I][J][rr] * __expf(gcol[J] - gs[j]) : 0.f; } }
            Zt[t] = x; }
#pragma unroll
        for (int t = 0; t < 3; ++t) { const int I = (t == 0) ? 0 : 1, J = (t == 2) ? 1 : 0; f32x16 x;
#pragma unroll
            for (int g4 = 0; g4 < 4; ++g4) { const f32x4 gcr = *(const LAS f32x4*)(tbl + 32 * I + 8 * g4 + 4 * h), ber = *(const LAS f32x4*)(tbl + 64 + 32 * I + 8 * g4 + 4 * h);
#pragma unroll
                for (int j = 0; j < 4; ++j) { const int rr = 4 * g4 + j; const bool ok = (I != J) || (r < 8 * g4 + 4 * h + j);
                    x[rr] = ok ? -ber[j] * KK[I][J][rr] * __expf(gcr[j] - gcol[J]) : 0.f; } }
            Z[t] = x; }
    }
    __builtin_amdgcn_sched_barrier(0);
    {
        f32x16 R0, Rt0, R1, Rt1;
        inv_diag(Z[0], Zt[0], r, h, R0, Rt0);
        __builtin_amdgcn_sched_barrier(0);
        inv_diag(Z[2], Zt[2], r, h, R1, Rt1);
        __builtin_amdgcn_sched_barrier(0);
        const f32x16 Pm = mm2(pack_step<0>(Z[1]), pack_step<1>(Z[1]), pack_step<0>(Rt1), pack_step<1>(Rt1), (f32x16){});
        Rt[1] = mm2(pack_step<0>(R0), pack_step<1>(R0), pack_step<0>(Pm), pack_step<1>(Pm), (f32x16){});
        Rt[0] = Rt0; Rt[2] = Rt1;
    }
    __builtin_amdgcn_sched_barrier(0);
    bf16x8 Rp[3][2];
#pragma unroll
    for (int t = 0; t < 3; ++t) { Rp[t][0] = pack_step<0>(Rt[t]); Rp[t][1] = pack_step<1>(Rt[t]); }
    LAS unsigned char* a0 = tr_base(img, lane);
    __builtin_amdgcn_sched_barrier(0);
#pragma unroll
    for (int itr = 0; itr < 16; ++itr) { const int ci = itr * 64 + lane, row = ci >> 4, cch = ci & 15;
        const f32x8 v = unpack8(*(const bf16x8*)(kbase + (unsigned)(row * DN_CONV + cch * 8))) * (tbl[64 + row] * __expf(tbl[row]));
        *(LAS bf16x8*)(img + row * 256 + cch * 16) = pack8(v); }
    asm volatile("s_waitcnt lgkmcnt(0)" ::: "memory");
#pragma unroll
    for (int kb = 0; kb < 4; ++kb)
#pragma unroll
        for (int cb = 0; cb < 2; ++cb) { f32x16 acc = {};
            if (cb == 0) { acc = DN_MFMA(tr_frag(a0, 32 * kb, 0, 0), Rp[0][0], acc); acc = DN_MFMA(tr_frag(a0, 32 * kb, 0, 1), Rp[0][1], acc); }
            else { acc = DN_MFMA(tr_frag(a0, 32 * kb, 0, 0), Rp[1][0], acc); acc = DN_MFMA(tr_frag(a0, 32 * kb, 0, 1), Rp[1][1], acc);
                   acc = DN_MFMA(tr_frag(a0, 32 * kb, 1, 0), Rp[2][0], acc); acc = DN_MFMA(tr_frag(a0, 32 * kb, 1, 1), Rp[2][1], acc); }
            acc = -acc;
            *(bf16x8*)(outp + (F_NW + (cb * 4 + kb) * 2 + 0) * 1024) = pack_step<0>(acc); *(bf16x8*)(outp + (F_NW + (cb * 4 + kb) * 2 + 1) * 1024) = pack_step<1>(acc); }
    asm volatile("s_waitcnt lgkmcnt(0)" ::: "memory");
    __builtin_amdgcn_sched_barrier(0);
#pragma unroll
    for (int itr = 0; itr < 16; ++itr) { const int ci = itr * 64 + lane, row = ci >> 4, cch = ci & 15;
        const f32x8 v = unpack8(*(const bf16x8*)(kbase + (unsigned)(row * DN_CONV + cch * 8))) * __expf(glast - tbl[row]);
        *(LAS bf16x8*)(img + row * 256 + cch * 16) = pack8(v); }
    asm volatile("s_waitcnt lgkmcnt(0)" ::: "memory");
#pragma unroll
    for (int kb = 0; kb < 4; ++kb)
#pragma unroll
        for (int cb = 0; cb < 2; ++cb)
#pragma unroll
            for (int st = 0; st < 2; ++st) *(bf16x8*)(outp + (F_KGT + (kb * 2 + cb) * 2 + st) * 1024) = tr_frag(a0, 32 * kb, cb, st);
    asm volatile("s_waitcnt lgkmcnt(0)" ::: "memory");
    __builtin_amdgcn_sched_barrier(0);
#pragma unroll
    for (int itr = 0; itr < 16; ++itr) { const int ci = itr * 64 + lane, row = ci >> 4, cch = ci & 15;
        const f32x8 v = unpack8(*(const bf16x8*)(vbase + (unsigned)(row * DN_CONV + cch * 8))) * tbl[64 + row];
        *(LAS bf16x8*)(img + row * 256 + cch * 16) = pack8(v); }
    asm volatile("s_waitcnt lgkmcnt(0)" ::: "memory");
    float* dup = DU + (size_t)u * DU_UNIT + lane * 16;
#pragma unroll
    for (int dvb = 0; dvb < 4; ++dvb)
#pragma unroll
        for (int cb = 0; cb < 2; ++cb) { f32x16 acc = {};
            if (cb == 0) { acc = DN_MFMA(Rp[0][0], tr_frag(a0, 32 * dvb, 0, 0), acc); acc = DN_MFMA(Rp[0][1], tr_frag(a0, 32 * dvb, 0, 1), acc); }
            else { acc = DN_MFMA(Rp[1][0], tr_frag(a0, 32 * dvb, 0, 0), acc); acc = DN_MFMA(Rp[1][1], tr_frag(a0, 32 * dvb, 0, 1), acc);
                   acc = DN_MFMA(Rp[2][0], tr_frag(a0, 32 * dvb, 1, 0), acc); acc = DN_MFMA(Rp[2][1], tr_frag(a0, 32 * dvb, 1, 1), acc); }
            float* d = dup + (dvb * 2 + cb) * 1024;
#pragma unroll
            for (int g4 = 0; g4 < 4; ++g4) *(f32x4*)(d + 4 * g4) = (f32x4){acc[4 * g4], acc[4 * g4 + 1], acc[4 * g4 + 2], acc[4 * g4 + 3]}; }
    __builtin_amdgcn_sched_barrier(0);
#pragma unroll
    for (int cb = 0; cb < 2; ++cb) { const float eg = __expf(gcol[cb]); const bf16* qrow = qbase + (unsigned)((32 * cb + r) * DN_CONV + 4 * h);
#pragma unroll
        for (int kb = 0; kb < 4; ++kb)
#pragma unroll
            for (int st = 0; st < 2; ++st) { const u32x2 lo = *(const u32x2*)(qrow + 32 * kb + 16 * st), hi = *(const u32x2*)(qrow + 32 * kb + 16 * st + 8);
                const f32x8 v = {bf_lo(lo.x) * eg, bf_hi(lo.x) * eg, bf_lo(lo.y) * eg, bf_hi(lo.y) * eg, bf_lo(hi.x) * eg, bf_hi(hi.x) * eg, bf_lo(hi.y) * eg, bf_hi(hi.y) * eg};
                *(bf16x8*)(outp + (F_QG + (cb * 4 + kb) * 2 + st) * 1024) = pack8(v); } }
    asm volatile("s_waitcnt lgkmcnt(0)" ::: "memory");
}
__device__ __forceinline__ void prep_phase(const Ctx& c, const bf16* DNC, const float* GG, const float* BETA, unsigned char* DNP, float* DU, float* EGL) {
    int lane = threadIdx.x & 63; asm volatile("" : "+v"(lane));
    LAS unsigned char* img = c.lds + c.wave * 16384; LAS float* tbl = (LAS float*)(c.lds + LDSCTL_OFF + 1024 + c.wave * 1024);
    for (int u = c.gw; u < NB * DN_VH * 64; u += c.NW) { int l2 = lane; asm volatile("" : "+v"(l2));
        prep_unit(u, DNC, GG, BETA, DNP, DU, EGL, img, tbl, l2); }
}

#define DN_BAR() do { asm volatile("s_waitcnt vmcnt(0) lgkmcnt(0)" ::: "memory"); __builtin_amdgcn_s_barrier(); asm volatile("" ::: "memory"); } while (0)
#define DN_BAR_L() do { asm volatile("s_waitcnt lgkmcnt(0)" ::: "memory"); __builtin_amdgcn_s_barrier(); asm volatile("" ::: "memory"); } while (0)
__device__ __forceinline__ void scan_head(int bh, LAS unsigned char* lds, const unsigned char* DNP, const float* DU, const float* EGL, const float* norm_w, const bf16* ZS, bf16* ODN) {
    int tid = threadIdx.x; asm volatile("" : "+v"(tid));
    const int lane = tid & 63, wave = __builtin_amdgcn_readfirstlane(tid >> 6), r = lane & 31, h = lane >> 5;
    LAS float* red = (LAS float*)(lds + 2 * UNIT_BYTES);
    LAS float* nwl = red + 512;
    const int b = bh >> 5, hv = bh & 31;
    const unsigned char* src = DNP + (size_t)bh * 64 * UNIT_BYTES;
    if (tid < 128) nwl[tid] = norm_w[tid];
    if (wave >= 4) {
        const int lw = wave - 4;
        for (int n = -1; n < 63; ++n) {
            const unsigned char* s = src + (size_t)(n + 1) * UNIT_BYTES + lane * 16; LAS unsigned char* d = lds + ((n + 1) & 1) * UNIT_BYTES;
#pragma unroll
            for (int f = 0; f < 14; ++f) { const int fr = lw + 4 * f; if (fr < UNIT_FRAGS) __builtin_amdgcn_global_load_lds((const unsigned*)(s + fr * 1024), (LAS unsigned*)(d + fr * 1024), 16, 0, 0); }
            DN_BAR();
        }
        DN_BAR();
    } else {
        const int dvb = wave;
        f32x16 S[4] = {}, OT[2] = {}, UN[2];
        u32x2 zq[2][4] = {};
        const float* dup = DU + (size_t)bh * 64 * DU_UNIT + dvb * 2048 + lane * 16;
        const float eglv = EGL[bh * 64 + lane];
        const size_t orow0 = (size_t)b * T * 4096 + hv * 128 + 32 * dvb + 4 * h;
#pragma unroll
        for (int cb = 0; cb < 2; ++cb)
#pragma unroll
            for (int g4 = 0; g4 < 4; ++g4) { const f32x4 v = *(const f32x4*)(dup + cb * 1024 + 4 * g4); UN[cb][4 * g4] = v[0]; UN[cb][4 * g4 + 1] = v[1]; UN[cb][4 * g4 + 2] = v[2]; UN[cb][4 * g4 + 3] = v[3]; }
        for (int n = 0; n < 64; ++n) {
            DN_BAR_L();
            if (n > 0) {
                const LAS float* rp = red + ((n - 1) & 1) * 256;
#pragma unroll
                for (int cb = 0; cb < 2; ++cb) { const int cc = 32 * cb + r; const float ss = rp[cc] + rp[64 + cc] + rp[128 + cc] + rp[192 + cc];
                    const float rs = rsqrtf(ss * (1.0f / 128.0f) + EPS); bf16* op = ODN + orow0 + (size_t)((n - 1) * 64 + cc) * 4096;
#pragma unroll
                    for (int g4 = 0; g4 < 4; ++g4) { const u32x2 z = zq[cb][g4]; const f32x4 nw = *(const LAS f32x4*)(nwl + 32 * dvb + 8 * g4 + 4 * h);
                        u32x2 w; w.x = pk2(OT[cb][4 * g4] * rs * nw[0] * bf_lo(z.x), OT[cb][4 * g4 + 1] * rs * nw[1] * bf_hi(z.x));
                        w.y = pk2(OT[cb][4 * g4 + 2] * rs * nw[2] * bf_lo(z.y), OT[cb][4 * g4 + 3] * rs * nw[3] * bf_hi(z.y));
                        *(u32x2*)(op + 8 * g4) = w; } } }
            const float egl = __shfl(eglv, n);
            const LAS unsigned char* fb = lds + (n & 1) * UNIT_BYTES + lane * 16;
#define DN_F(idx) (*(const LAS bf16x8*)(fb + (idx) * 1024))
            bf16x8 Sp[4][2];
#pragma unroll
            for (int kb = 0; kb < 4; ++kb) { Sp[kb][0] = pack_step<0>(S[kb]); Sp[kb][1] = pack_step<1>(S[kb]); }
            f32x16 VN[2] = {UN[0], UN[1]};
#pragma unroll
            for (int cb = 0; cb < 2; ++cb)
#pragma unroll
                for (int kb = 0; kb < 4; ++kb) { VN[cb] = DN_MFMA(DN_F(F_NW + (cb * 4 + kb) * 2 + 0), Sp[kb][0], VN[cb]); VN[cb] = DN_MFMA(DN_F(F_NW + (cb * 4 + kb) * 2 + 1), Sp[kb][1], VN[cb]); }
            __builtin_amdgcn_sched_barrier(0);
            bf16x8 VNp[2][2];
#pragma unroll
            for (int cb = 0; cb < 2; ++cb) { VNp[cb][0] = pack_step<0>(VN[cb]); VNp[cb][1] = pack_step<1>(VN[cb]); }
            { const float* d = dup + (size_t)(n < 63 ? n + 1 : n) * DU_UNIT;
#pragma unroll
              for (int cb = 0; cb < 2; ++cb)
#pragma unroll
                for (int g4 = 0; g4 < 4; ++g4) { const f32x4 v = *(const f32x4*)(d + cb * 1024 + 4 * g4); UN[cb][4 * g4] = v[0]; UN[cb][4 * g4 + 1] = v[1]; UN[cb][4 * g4 + 2] = v[2]; UN[cb][4 * g4 + 3] = v[3]; } }
            __builtin_amdgcn_sched_barrier(0);
#pragma unroll
            for (int cb = 0; cb < 2; ++cb) { f32x16 acc = {};
#pragma unroll
                for (int kb = 0; kb < 4; ++kb) { acc = DN_MFMA(Sp[kb][0], DN_F(F_QG + (cb * 4 + kb) * 2 + 0), acc); acc = DN_MFMA(Sp[kb][1], DN_F(F_QG + (cb * 4 + kb) * 2 + 1), acc); }
                if (cb == 0) { acc = DN_MFMA(VNp[0][0], DN_F(F_AT + 0), acc); acc = DN_MFMA(VNp[0][1], DN_F(F_AT + 1), acc); }
                else { acc = DN_MFMA(VNp[0][0], DN_F(F_AT + 2), acc); acc = DN_MFMA(VNp[0][1], DN_F(F_AT + 3), acc); acc = DN_MFMA(VNp[1][0], DN_F(F_AT + 4), acc); acc = DN_MFMA(VNp[1][1], DN_F(F_AT + 5), acc); }
                OT[cb] = acc; }
            __builtin_amdgcn_sched_barrier(0);
#pragma unroll
            for (int cb = 0; cb < 2; ++cb)
#pragma unroll
                for (int g4 = 0; g4 < 4; ++g4) zq[cb][g4] = *(const u32x2*)(ZS + orow0 + (size_t)(n * 64 + 32 * cb + r) * 4096 + 8 * g4);
#pragma unroll
            for (int kb = 0; kb < 4; ++kb) { f32x16 acc = S[kb] * egl;
#pragma unroll
                for (int cb = 0; cb < 2; ++cb) { acc = DN_MFMA(DN_F(F_KGT + (kb * 2 + cb) * 2 + 0), VNp[cb][0], acc); acc = DN_MFMA(DN_F(F_KGT + (kb * 2 + cb) * 2 + 1), VNp[cb][1], acc); }
                S[kb] = acc; }
#undef DN_F
            __builtin_amdgcn_sched_barrier(0);
            LAS float* wp = red + (n & 1) * 256 + dvb * 64;
#pragma unroll
            for (int cb = 0; cb < 2; ++cb) { float ss = 0.f;
#pragma unroll
                for (int rr = 0; rr < 16; ++rr) ss += OT[cb][rr] * OT[cb][rr];
                ss += __shfl_xor(ss, 32);
                if (h == 0) wp[32 * cb + r] = ss; }
        }
        DN_BAR_L();
        {   const LAS float* rp = red + 256;
#pragma unroll
            for (int cb = 0; cb < 2; ++cb) { const int cc = 32 * cb + r; const float ss = rp[cc] + rp[64 + cc] + rp[128 + cc] + rp[192 + cc];
                const float rs = rsqrtf(ss * (1.0f / 128.0f) + EPS); bf16* op = ODN + orow0 + (size_t)(63 * 64 + cc) * 4096;
#pragma unroll
                for (int g4 = 0; g4 < 4; ++g4) { const u32x2 z = zq[cb][g4]; const f32x4 nw = *(const LAS f32x4*)(nwl + 32 * dvb + 8 * g4 + 4 * h);
                    u32x2 w; w.x = pk2(OT[cb][4 * g4] * rs * nw[0] * bf_lo(z.x), OT[cb][4 * g4 + 1] * rs * nw[1] * bf_hi(z.x));
                    w.y = pk2(OT[cb][4 * g4 + 2] * rs * nw[2] * bf_lo(z.y), OT[cb][4 * g4 + 3] * rs * nw[3] * bf_hi(z.y));
                    *(u32x2*)(op + 8 * g4) = w; } } }
    }
}
#undef DN_BAR
#undef DN_BAR_L
}

constexpr size_t al256(size_t x) { return (x + 255) & ~(size_t)255; }
constexpr size_t WS_CTL = 0, CTL_ZERO_BYTES = 1u << 20;
constexpr int CW_BAR = 4096, CW_FOXQ = 8192;
constexpr size_t WS_WIN = CTL_ZERO_BYTES;
constexpr size_t WS_WBRDN = WS_WIN + al256((size_t)DEPTH * NBIG * D * 2);
constexpr size_t WS_WBRFOX = WS_WBRDN + al256((size_t)DEPTH * D * 4096 * 2);
constexpr size_t WS_WOUT = WS_WBRFOX + al256((size_t)DEPTH * D * D * 2);
constexpr size_t WS_WGU = WS_WOUT + al256((size_t)DEPTH * D * D * 2);
constexpr size_t WS_WDOWN = WS_WGU + al256((size_t)DEPTH * 2 * FF * D * 2);
constexpr size_t WS_WSM = WS_WDOWN + al256((size_t)DEPTH * D * FF * 2);
constexpr size_t WS_MOD = WS_WSM + al256((size_t)DEPTH * 96 * D * 2);
constexpr size_t WS_H = WS_MOD + al256((size_t)DEPTH * 2 * 6 * D * 4);
constexpr size_t WS_DNRAW = WS_H + al256((size_t)M * D * 2);
constexpr size_t WS_DNC = WS_DNRAW + al256((size_t)M * 8192 * 2);
constexpr size_t WS_ZS = WS_DNC + al256((size_t)M * 8192 * 2);
constexpr size_t WS_FQKV = WS_ZS + al256((size_t)M * 4096 * 2);
constexpr size_t WS_MG = WS_FQKV + al256((size_t)M * 6144 * 2);
constexpr size_t WS_BAF = WS_MG + al256((size_t)M * 4096 * 2);
constexpr size_t WS_BETA = WS_BAF + al256((size_t)M * NSM * 4);
constexpr size_t WS_GG = WS_BETA + al256((size_t)M * 32 * 4);
constexpr size_t WS_LOGF = WS_GG + al256((size_t)M * 32 * 4);
constexpr size_t WS_FC = WS_LOGF + al256((size_t)M * 16 * 4);
constexpr size_t WS_ODNRAW = WS_FC + al256((size_t)M * 16 * 4);
constexpr size_t WS_ODN = WS_ODNRAW + al256((size_t)M * 4096 * 4);
constexpr size_t WS_OFOX = WS_ODN + al256((size_t)M * 4096 * 2);
constexpr size_t WS_YDN = WS_OFOX + al256((size_t)M * 2048 * 2);
constexpr size_t WS_MM = WS_YDN + al256((size_t)M * D * 4);
constexpr size_t WS_Y = WS_MM + al256((size_t)M * D * 2);
constexpr size_t WS_HID = WS_Y + al256((size_t)M * D * 4);
constexpr size_t WS_DNP = WS_HID + al256((size_t)M * FF * 2);
constexpr size_t WS_EGL = WS_DNP + al256((size_t)NB * DN_VH * 64 * dn::UNIT_BYTES);
constexpr size_t WS_END = WS_EGL + al256((size_t)NB * DN_VH * 64 * 4);
constexpr size_t WS_DU = WS_ODNRAW;

struct Params { const float* in[17]; float* out; unsigned char* ws; };

__global__ void __launch_bounds__(512, 2) mega_fwd(Params p) {
    extern __shared__ __attribute__((aligned(16))) unsigned char lds_raw[];
    Ctx c; c.lds = (LAS unsigned char*)lds_raw; c.wave = __builtin_amdgcn_readfirstlane((int)threadIdx.x >> 6);
    c.G = gridDim.x; c.gw = blockIdx.x * 8 + c.wave; c.NW = c.G * 8;
    for (int u = threadIdx.x; u < (LDS_BYTES - LDSCTL_OFF) / 4; u += 512) ((LAS unsigned*)(c.lds + LDSCTL_OFF))[u] = 0u;
    __syncthreads();
    typedef __attribute__((address_space(4))) const Params* KParams;
    const KParams kp0 = (KParams)__builtin_amdgcn_kernarg_segment_ptr();
    unsigned char* ws = p.ws;
    XcdBarrier bar = xcd_barrier_post((unsigned*)(ws + WS_CTL) + CW_BAR, (volatile LAS unsigned*)(c.lds + MISC_OFF) + 8);
#define GRID_BAR() do { XcdBarrier b2_ = bar; asm volatile("" : "+s"(b2_.x), "+s"(b2_.bar)); xcd_barrier(b2_); } while (0)
#define PH_BEGIN KParams kp = kp0; asm volatile("" : "+s"(kp)); unsigned char* wsl = kp->ws;
#define WSP(type, off) ((type*)(wsl + (off)))

    for (int l = 0; l < DEPTH; ++l) { PH_BEGIN
        ph_transpose(c, kp->in[5] + (size_t)l * D * NIN, D, NIN, NBIG, WSP(bf16, WS_WIN) + (size_t)l * NBIG * D, 1);
        ph_transpose(c, kp->in[11] + (size_t)l * 4096 * D, 4096, D, D, WSP(bf16, WS_WBRDN) + (size_t)l * D * 4096, 0);
        ph_transpose(c, kp->in[12] + (size_t)l * D * D, D, D, D, WSP(bf16, WS_WBRFOX) + (size_t)l * D * D, 0);
        ph_transpose(c, kp->in[13] + (size_t)l * D * D, D, D, D, WSP(bf16, WS_WOUT) + (size_t)l * D * D, 0);
        ph_transpose(c, kp->in[14] + (size_t)l * D * FF, D, FF, FF, WSP(bf16, WS_WGU) + (size_t)l * 2 * FF * D, 2);
        ph_transpose(c, kp->in[15] + (size_t)l * D * FF, D, FF, FF, WSP(bf16, WS_WGU) + (size_t)l * 2 * FF * D, 3);
        ph_transpose(c, kp->in[16] + (size_t)l * FF * D, FF, D, D, WSP(bf16, WS_WDOWN) + (size_t)l * D * FF, 0);
    }
    { PH_BEGIN ph_wsmall(c, kp->in[5], WSP(bf16, WS_WSM)); }
    __syncthreads();
    { PH_BEGIN ph_adaln(c, kp->in[1], kp->in[2], kp->in[3], WSP(float, WS_MOD)); }
    GRID_BAR();
    { PH_BEGIN RowArgs a{}; a.xin = kp->in[0]; a.x = kp->out; a.gn = kp->in[4]; a.scale = WSP(float, WS_MOD) + 1 * D; a.shift = WSP(float, WS_MOD); a.H = WSP(bf16, WS_H);
      a.has_y = 0; a.has_h = 1; ph_rowpass(c, a); }
    GRID_BAR();

    for (int l = 0; l < DEPTH; ++l) {
        { PH_BEGIN ph_smallproj(c, WSP(bf16, WS_H), WSP(bf16, WS_WSM) + (size_t)l * 96 * D, WSP(float, WS_BAF)); }
        __syncthreads();
        { PH_BEGIN pg8::Gemm g{WSP(bf16, WS_H), WSP(bf16, WS_WIN) + (size_t)l * NBIG * D, M, NBIG, D, 0}; pg8::StaticOrder S; S.init(M, NBIG, c.G, (int)blockIdx.x);
          pg8::EpiInProj E{WSP(bf16, WS_DNRAW), WSP(bf16, WS_ZS), WSP(bf16, WS_FQKV), WSP(bf16, WS_MG)};
          pg8::gemm_phase<pg8::EpiInProj, pg8::StaticOrder, true, true>(c.lds, g, S, E); }
        GRID_BAR();
        { PH_BEGIN ph_conv(c, WSP(bf16, WS_DNRAW), kp->in[6] + (size_t)l * 8192 * 4, WSP(bf16, WS_DNC)); }
        { PH_BEGIN ph_gates(c, WSP(float, WS_BAF), kp->in[7] + l * 32, kp->in[8] + l * 32, kp->in[10] + l * 16, WSP(float, WS_BETA), WSP(float, WS_GG), WSP(float, WS_LOGF)); }
        GRID_BAR();
        { PH_BEGIN ph_fcum(c, WSP(float, WS_LOGF), WSP(float, WS_FC)); }
        { PH_BEGIN dn::prep_phase(c, WSP(bf16, WS_DNC), WSP(float, WS_GG), WSP(float, WS_BETA), WSP(unsigned char, WS_DNP), WSP(float, WS_DU), WSP(float, WS_EGL)); }
        GRID_BAR();
        { PH_BEGIN for (int bh = blockIdx.x; bh < NB * DN_VH; bh += c.G) { __syncthreads();
            dn::scan_head(bh, c.lds, WSP(unsigned char, WS_DNP), WSP(float, WS_DU), WSP(float, WS_EGL), kp->in[9] + l * 128, WSP(bf16, WS_ZS), WSP(bf16, WS_ODN)); } }
        { PH_BEGIN fox::fox_phase((char*)lds_raw, (unsigned*)(wsl + WS_CTL) + CW_FOXQ + l * 512, (int)(xb_xcc_id() & 7u), WSP(bf16, WS_FQKV), WSP(bf16, WS_OFOX), WSP(float, WS_FC)); }
        GRID_BAR();
        { PH_BEGIN pg8::Gemm g{WSP(bf16, WS_ODN), WSP(bf16, WS_WBRDN) + (size_t)l * D * 4096, M, D, 4096, 0}; pg8::StaticOrder S; S.init(M, D, c.G, (int)blockIdx.x); pg8::EpiF32 E{WSP(float, WS_YDN), D, 0};
          pg8::gemm_phase<pg8::EpiF32, pg8::StaticOrder, true, true>(c.lds, g, S, E); }
        __syncthreads();
        { PH_BEGIN pg8::Gemm g{WSP(bf16, WS_OFOX), WSP(bf16, WS_WBRFOX) + (size_t)l * D * D, M, D, D, 0}; pg8::StaticOrder S; S.init(M, D, c.G, (int)blockIdx.x); pg8::EpiMerge E{WSP(float, WS_YDN), WSP(bf16, WS_MG), WSP(bf16, WS_MM)};
          pg8::gemm_phase<pg8::EpiMerge, pg8::StaticOrder, true, true>(c.lds, g, S, E); }
        GRID_BAR();
        { PH_BEGIN pg8::Gemm g{WSP(bf16, WS_MM), WSP(bf16, WS_WOUT) + (size_t)l * D * D, M, D, D, 0}; pg8::StaticOrder S; S.init(M, D, c.G, (int)blockIdx.x); pg8::EpiF32 E{WSP(float, WS_Y), D, 0};
          pg8::gemm_phase<pg8::EpiF32, pg8::StaticOrder, true, true>(c.lds, g, S, E); }
        GRID_BAR();
        { PH_BEGIN const float* mod = WSP(float, WS_MOD) + (size_t)l * 2 * 6 * D; const float* gl = kp->in[4] + (size_t)l * 4 * D;
          RowArgs a{}; a.xin = kp->out; a.x = kp->out; a.Y = WSP(float, WS_Y); a.gy = gl + 1 * D; a.gate = mod + 2 * D; a.gn = gl + 2 * D; a.scale = mod + 4 * D; a.shift = mod + 3 * D; a.H = WSP(bf16, WS_H); a.has_y = 1; a.has_h = 1;
          ph_rowpass(c, a); }
        GRID_BAR();
        { PH_BEGIN pg8::Gemm g{WSP(bf16, WS_H), WSP(bf16, WS_WGU) + (size_t)l * 2 * FF * D, M, 2 * FF, D, 0}; pg8::StaticOrder S; S.init(M, 2 * FF, c.G, (int)blockIdx.x); pg8::EpiSwiGLU E{WSP(bf16, WS_HID), FF, 0};
          pg8::gemm_phase<pg8::EpiSwiGLU, pg8::StaticOrder, true, true>(c.lds, g, S, E); }
        GRID_BAR();
        { PH_BEGIN pg8::Gemm g{WSP(bf16, WS_HID), WSP(bf16, WS_WDOWN) + (size_t)l * D * FF, M, D, FF, 0}; pg8::StaticOrder S; S.init(M, D, c.G, (int)blockIdx.x); pg8::EpiF32 E{WSP(float, WS_Y), D, 0};
          pg8::gemm_phase<pg8::EpiF32, pg8::StaticOrder, true, true>(c.lds, g, S, E); }
        GRID_BAR();
        { PH_BEGIN const float* mod = WSP(float, WS_MOD) + (size_t)l * 2 * 6 * D; const float* gl = kp->in[4] + (size_t)l * 4 * D;
          RowArgs a{}; a.xin = kp->out; a.x = kp->out; a.Y = WSP(float, WS_Y); a.gy = gl + 3 * D; a.gate = mod + 5 * D; a.has_y = 1;
          if (l + 1 < DEPTH) { const float* mod2 = mod + 2 * 6 * D; const float* gl2 = gl + 4 * D;
              a.gn = gl2; a.scale = mod2 + 1 * D; a.shift = mod2; a.H = WSP(bf16, WS_H); a.has_h = 1; }
          ph_rowpass(c, a); }
        if (l + 1 < DEPTH) GRID_BAR();
    }
#undef PH_BEGIN
#undef WSP
#undef GRID_BAR
}

extern "C" void kernel_launch(void* const* d_in, const int* in_sizes, int n_in, void* d_out, int out_size, void* d_ws, size_t ws_size, hipStream_t stream) {
    static int grid = 0;
    if (grid == 0) {
        if (n_in != 17 || out_size != M * D || ws_size < WS_END) { fprintf(stderr, "kernel_launch: bad shapes / workspace (need %zu, have %zu)\n", (size_t)WS_END, ws_size); grid = -1; return; }
        int dev = 0, cus = 0, per_cu = 0;
        if (hipGetDevice(&dev) != hipSuccess || hipDeviceGetAttribute(&cus, hipDeviceAttributeMultiprocessorCount, dev) != hipSuccess) { grid = -1; return; }
        if (hipFuncSetAttribute((const void*)mega_fwd, hipFuncAttributeMaxDynamicSharedMemorySize, LDS_BYTES) != hipSuccess) { fprintf(stderr, "kernel_launch: hipFuncSetAttribute failed\n"); grid = -1; return; }
        if (hipOccupancyMaxActiveBlocksPerMultiprocessor(&per_cu, (const void*)mega_fwd, 512, LDS_BYTES) != hipSuccess || per_cu < 1) { fprintf(stderr, "kernel_launch: occupancy query reports %d workgroups per CU\n", per_cu); }
        (void)hipGetLastError();
        grid = cus;
    }
    if (grid < 0) return;
    if (hipMemsetAsync((char*)d_ws + WS_CTL, 0, CTL_ZERO_BYTES, stream) != hipSuccess) return;
    Params p{};
    for (int i = 0; i < 17; ++i) p.in[i] = (const float*)d_in[i];
    p.out = (float*)d_out; p.ws = (unsigned char*)d_ws;
    hipLaunchKernelGGL(mega_fwd, dim3(grid), dim3(512), LDS_BYTES, stream, p);
}
```

```cpp
#include <hip/hip_runtime.h>
#include <cstdio>
#include <cstdint>

constexpr int D = 2048, NB = 2, T = 4096, M = NB * T, DEPTH = 4;
constexpr int HD = 128, DN_VH = 32, DN_CONV = 8192;
constexpr int FOXH = 16;
constexpr int FF = 5632;
constexpr int NIN = 22608;
constexpr int SRC_B = 12288, SRC_A = 12320, SRC_FQKV = 12352, SRC_F = 18496, SRC_MERGE = 18512;
constexpr int NBIG = 22528;
constexpr int NSM = 80;
constexpr float EPS = 1e-6f;

typedef unsigned short bf16;
typedef float f32x4 __attribute__((ext_vector_type(4)));
typedef unsigned u32x4 __attribute__((ext_vector_type(4)));
typedef unsigned u32x2 __attribute__((ext_vector_type(2)));
#define LAS __attribute__((address_space(3)))

__device__ __forceinline__ float bf_lo(unsigned w) { return __uint_as_float(w << 16); }
__device__ __forceinline__ float bf_hi(unsigned w) { return __uint_as_float(w & 0xffff0000u); }
__device__ __forceinline__ float bf2f(bf16 h) { return __uint_as_float(((unsigned)h) << 16); }
__device__ __forceinline__ unsigned f2bf(float f) { unsigned u = __float_as_uint(f); return (u + 0x7fffu + ((u >> 16) & 1u)) >> 16; }
__device__ __forceinline__ unsigned pk2(float lo, float hi) { return f2bf(lo) | (f2bf(hi) << 16); }
__device__ __forceinline__ float fsigmoid(float x) { return __builtin_amdgcn_rcpf(1.0f + __expf(-x)); }
__device__ __forceinline__ float fsilu(float x) { return x * fsigmoid(x); }
__device__ __forceinline__ float wave_sum(float v) {
#pragma unroll
    for (int o = 1; o < 64; o <<= 1) v += __shfl_xor(v, o);
    return v;
}
namespace pg8 {
#define PG8_LAS __attribute__((address_space(3)))
typedef unsigned short bf16_t;
typedef short bf16x8 __attribute__((ext_vector_type(8)));
typedef float f32x4 __attribute__((ext_vector_type(4)));
typedef unsigned u32x4 __attribute__((ext_vector_type(4)));
constexpr int BM = 256, BK = 64, HALF = 128, HTB = HALF * BK * 2  , STAGE_BYTES = 8 * HTB, NXCD = 8, WGM = 8;

__host__ __device__ __forceinline__ int lds_byte(int r, int c) { const int st = (r >> 4) * 2 + (c >> 5), rr = r & 15, cc = c & 31, ob = rr * 64 + cc * 2; return st * 1024 + (ob ^ (((ob >> 9) & 1) << 5)); }
__host__ __device__ __forceinline__ void stage_rc(int b, int& R, int& C) { const int st = b / 1024, sb = b % 1024, swz = sb ^ (((sb >> 9) & 1) << 5); R = (st >> 1) * 16 + swz / 64; C = (st & 1) * 32 + (swz % 64) / 2; }
__host__ __device__ __forceinline__ int perm32(int rho) { const int n = rho >> 4, i = rho & 15; return 8 * (i >> 2) + 4 * n + (i & 3); }

struct Unit { int pm, pn; };
struct Gemm { const bf16_t* A; const bf16_t* Bt; int M, N, K, pad; };

struct StaticOrder {
    int nM, nN, nwg, G, c;
    __host__ __device__ void init(int M, int N, int G_, int c_) { nM = M / BM; nN = N / BM; nwg = nM * nN; G = G_; c = c_; }
    __host__ __device__ bool next(int i, Unit& u) const {
        const long L = (long)i * G + c; if (L >= nwg) return false;
        int wgid = (int)L; { const int q = nwg / NXCD, r = nwg % NXCD, xcd = wgid % NXCD, off = wgid / NXCD; wgid = (xcd < r ? xcd * (q + 1) : r * (q + 1) + (xcd - r) * q) + off; }
        const int nig = WGM * nN, gid = wgid / nig, fm = gid * WGM, gsz = (nM - fm) < WGM ? (nM - fm) : WGM;
        u.pm = fm + ((wgid % nig) % gsz); u.pn = (wgid % nig) / gsz; return true;
    }
    __device__ __forceinline__ void a_ready(const Unit&) const {}
    __device__ __forceinline__ void done(const Unit&) const {}
};

__device__ __forceinline__ unsigned cvt_pk_bf16(float lo, float hi) { unsigned r; asm volatile("v_cvt_pk_bf16_f32 %0, %1, %2" : "=v"(r) : "v"(lo), "v"(hi)); return r; }
__device__ __forceinline__ float e_sigmoid(float x) { return __builtin_amdgcn_rcpf(1.0f + __expf(-x)); }

struct EpiF32 {
    static constexpr bool PERM = false, AFTER_DRAIN = false;
    float* C; int ldc, pad;
    __device__ __forceinline__ void operator()(const f32x4 (&acc)[2][2][4][2], const Unit& u, int wr, int wc, int fr, int fq) const {
        const int row0 = u.pm * BM + wr * 64 + fr, col0 = u.pn * BM + wc * 32 + 4 * fq;
#pragma unroll
        for (int ai = 0; ai < 2; ++ai)
#pragma unroll
            for (int m = 0; m < 4; ++m) { float* rowp = C + (size_t)(row0 + ai * HALF + m * 16) * ldc + col0;
#pragma unroll
                for (int bj = 0; bj < 2; ++bj)
#pragma unroll
                    for (int n = 0; n < 2; ++n) *(f32x4*)(rowp + bj * HALF + n * 16) = acc[ai][bj][m][n]; }
    }
};
struct EpiBf16P {
    static constexpr bool PERM = true, AFTER_DRAIN = false;
    bf16_t* O; int ldc, pad;
    __device__ __forceinline__ void operator()(const f32x4 (&acc)[2][2][4][2], const Unit& u, int wr, int wc, int fr, int fq) const {
        const int row0 = u.pm * BM + wr * 64 + fr, col0 = u.pn * BM + wc * 32 + 8 * fq;
#pragma unroll
        for (int ai = 0; ai < 2; ++ai)
#pragma unroll
            for (int m = 0; m < 4; ++m) { bf16_t* rowp = O + (size_t)(row0 + ai * HALF + m * 16) * ldc + col0;
#pragma unroll
                for (int bj = 0; bj < 2; ++bj) { const f32x4 v0 = acc[ai][bj][m][0], v1 = acc[ai][bj][m][1];
                    u32x4 w; w.x = cvt_pk_bf16(v0[0], v0[1]); w.y = cvt_pk_bf16(v0[2], v0[3]); w.z = cvt_pk_bf16(v1[0], v1[1]); w.w = cvt_pk_bf16(v1[2], v1[3]);
                    *(u32x4*)(rowp + bj * HALF) = w; } }
    }
};
struct EpiInProj {
    static constexpr bool PERM = true, AFTER_DRAIN = false;
    bf16_t *dnraw, *z, *fqkv, *mg;
    __device__ __forceinline__ void operator()(const f32x4 (&acc)[2][2][4][2], const Unit& u, int wr, int wc, int fr, int fq) const {
        const int pn = u.pn; bf16_t* base; int ldc, colt, act;
        if (pn < 32) { base = dnraw; ldc = 8192; colt = pn * BM; act = 0; }
        else if (pn < 48) { base = z; ldc = 4096; colt = (pn - 32) * BM; act = 1; }
        else if (pn < 72) { base = fqkv; ldc = 6144; colt = (pn - 48) * BM; act = 0; }
        else { base = mg; ldc = 4096; colt = (pn - 72) * BM; act = 2; }
        const int row0 = u.pm * BM + wr * 64 + fr, col0 = colt + wc * 32 + 8 * fq;
#pragma unroll
        for (int ai = 0; ai < 2; ++ai)
#pragma unroll
            for (int m = 0; m < 4; ++m) { bf16_t* rowp = base + (size_t)(row0 + ai * HALF + m * 16) * ldc + col0;
#pragma unroll
                for (int bj = 0; bj < 2; ++bj) { f32x4 v0 = acc[ai][bj][m][0], v1 = acc[ai][bj][m][1];
                    if (act == 1) {
#pragma unroll
                        for (int j = 0; j < 4; ++j) { v0[j] = v0[j] * e_sigmoid(v0[j]); v1[j] = v1[j] * e_sigmoid(v1[j]); } }
                    if (act == 2) {
#pragma unroll
                        for (int j = 0; j < 4; ++j) { v0[j] = e_sigmoid(v0[j]); v1[j] = e_sigmoid(v1[j]); } }
                    u32x4 w; w.x = cvt_pk_bf16(v0[0], v0[1]); w.y = cvt_pk_bf16(v0[2], v0[3]); w.z = cvt_pk_bf16(v1[0], v1[1]); w.w = cvt_pk_bf16(v1[2], v1[3]);
                    *(u32x4*)(rowp + bj * HALF) = w; } }
    }
};
struct EpiMerge {
    static constexpr bool PERM = true, AFTER_DRAIN = false;
    const bf16_t* ydn; const bf16_t* mg; bf16_t* mm;
    __device__ __forceinline__ void operator()(const f32x4 (&acc)[2][2][4][2], const Unit& u, int wr, int wc, int fr, int fq) const {
        const int row0 = u.pm * BM + wr * 64 + fr, col0 = u.pn * BM + wc * 32 + 8 * fq;
#pragma unroll
        for (int ai = 0; ai < 2; ++ai)
#pragma unroll
            for (int m = 0; m < 4; ++m) { const size_t row = (size_t)(row0 + ai * HALF + m * 16);
#pragma unroll
                for (int bj = 0; bj < 2; ++bj) { const int col = col0 + bj * HALF;
                    const u32x4 yb = *(const u32x4*)(ydn + row * 2048 + col);
                    const f32x4 y0 = {__uint_as_float(yb.x << 16), __uint_as_float(yb.x & 0xffff0000u), __uint_as_float(yb.y << 16), __uint_as_float(yb.y & 0xffff0000u)}, y1 = {__uint_as_float(yb.z << 16), __uint_as_float(yb.z & 0xffff0000u), __uint_as_float(yb.w << 16), __uint_as_float(yb.w & 0xffff0000u)};
                    const u32x4 gd = *(const u32x4*)(mg + row * 4096 + col), gf = *(const u32x4*)(mg + row * 4096 + 2048 + col);
                    const f32x4 a0 = acc[ai][bj][m][0], a1 = acc[ai][bj][m][1];
                    float o[8];
                    o[0] = __uint_as_float(gd.x << 16) * y0[0] + __uint_as_float(gf.x << 16) * a0[0];
                    o[1] = __uint_as_float(gd.x & 0xffff0000u) * y0[1] + __uint_as_float(gf.x & 0xffff0000u) * a0[1];
                    o[2] = __uint_as_float(gd.y << 16) * y0[2] + __uint_as_float(gf.y << 16) * a0[2];
                    o[3] = __uint_as_float(gd.y & 0xffff0000u) * y0[3] + __uint_as_float(gf.y & 0xffff0000u) * a0[3];
                    o[4] = __uint_as_float(gd.z << 16) * y1[0] + __uint_as_float(gf.z << 16) * a1[0];
                    o[5] = __uint_as_float(gd.z & 0xffff0000u) * y1[1] + __uint_as_float(gf.z & 0xffff0000u) * a1[1];
                    o[6] = __uint_as_float(gd.w << 16) * y1[2] + __uint_as_float(gf.w << 16) * a1[2];
                    o[7] = __uint_as_float(gd.w & 0xffff0000u) * y1[3] + __uint_as_float(gf.w & 0xffff0000u) * a1[3];
                    u32x4 w; w.x = cvt_pk_bf16(o[0], o[1]); w.y = cvt_pk_bf16(o[2], o[3]); w.z = cvt_pk_bf16(o[4], o[5]); w.w = cvt_pk_bf16(o[6], o[7]);
                    *(u32x4*)(mm + row * 2048 + col) = w; } }
    }
};
struct EpiSwiGLU {
    static constexpr bool PERM = true, AFTER_DRAIN = false;
    bf16_t* hid; int ldc, pad;
    __device__ __forceinline__ void operator()(const f32x4 (&acc)[2][2][4][2], const Unit& u, int wr, int wc, int fr, int fq) const {
        const int row0 = u.pm * BM + wr * 64 + fr, col0 = u.pn * HALF + wc * 32 + 8 * fq;
#pragma unroll
        for (int ai = 0; ai < 2; ++ai)
#pragma unroll
            for (int m = 0; m < 4; ++m) { bf16_t* rowp = hid + (size_t)(row0 + ai * HALF + m * 16) * ldc + col0;
                const f32x4 g0 = acc[ai][0][m][0], g1 = acc[ai][0][m][1], u0 = acc[ai][1][m][0], u1 = acc[ai][1][m][1];
                float o[8];
#pragma unroll
                for (int j = 0; j < 4; ++j) { o[j] = g0[j] * e_sigmoid(g0[j]) * u0[j]; o[4 + j] = g1[j] * e_sigmoid(g1[j]) * u1[j]; }
                u32x4 w; w.x = cvt_pk_bf16(o[0], o[1]); w.y = cvt_pk_bf16(o[2], o[3]); w.z = cvt_pk_bf16(o[4], o[5]); w.w = cvt_pk_bf16(o[6], o[7]);
                *(u32x4*)rowp = w; }
    }
};

template <class Epi, class Sched, bool ALIGN_EPI = false, bool SP2 = false>
__device__ __forceinline__ void gemm_phase(PG8_LAS unsigned char* lds, const Gemm g, const Sched& S, const Epi& E) {
    int tid_ = threadIdx.x; asm volatile("" : "+v"(tid_)); const int tid = tid_, wid = __builtin_amdgcn_readfirstlane(tid >> 6), lane = tid & 63, wr = wid >> 2, wc = wid & 3, fr = lane & 15, fq = lane >> 4;
    const int K = g.K, nt = K / BK;
    unsigned voffA[2], voffB[2];
#pragma unroll
    for (int i = 0; i < 2; ++i) { int R, C; stage_rc(tid * 16 + i * 8192, R, C); const int Rb = Epi::PERM ? ((R & ~31) + perm32(R & 31)) : R;
        voffA[i] = (unsigned)(R * K + C) * 2u; voffB[i] = (unsigned)(Rb * K + C) * 2u; }
    const size_t kstep = (size_t)(BK * 2);
    const size_t hstep = (size_t)HALF * K * 2;
    const size_t tstep = 2 * hstep;
    const unsigned ldsw = (unsigned)wid * 1024u;
    const int aoff = lds_byte(wr * 64 + fr, fq * 8), boff = lds_byte(wc * 32 + fr, fq * 8);
#define PG8_SA(b, h) (((b) * 2 + (h)) * HTB)
#define PG8_SB(b, h) ((4 + (b) * 2 + (h)) * HTB)
#define PG8_STAGE(bufoff, gbase, voff) do { _Pragma("unroll") for (int _i = 0; _i < 2; ++_i) \
        __builtin_amdgcn_global_load_lds((const unsigned*)((const char*)(gbase) + (voff)[_i]), (PG8_LAS unsigned*)(lds + (bufoff) + ldsw + _i * 8192), 16, 0, 0); } while (0)
#define PG8_LDA(dst, b, h) do { _Pragma("unroll") for (int m = 0; m < 4; ++m) _Pragma("unroll") for (int k = 0; k < 2; ++k) dst[m][k] = *(const PG8_LAS bf16x8*)(lds + PG8_SA(b, h) + aoff + m * 2048 + k * 1024); } while (0)
#define PG8_LDB(dst, b, h) do { _Pragma("unroll") for (int n = 0; n < 2; ++n) _Pragma("unroll") for (int k = 0; k < 2; ++k) dst[n][k] = *(const PG8_LAS bf16x8*)(lds + PG8_SB(b, h) + boff + n * 2048 + k * 1024); } while (0)
#define PG8_MMA(ai, bj, At, Bt) do { __builtin_amdgcn_s_setprio(1); _Pragma("unroll") for (int m = 0; m < 4; ++m) _Pragma("unroll") for (int n = 0; n < 2; ++n) _Pragma("unroll") for (int k = 0; k < 2; ++k) \
        acc[ai][bj][m][n] = __builtin_amdgcn_mfma_f32_16x16x32_bf16(Bt[n][k], At[m][k], acc[ai][bj][m][n], 0, 0, 0); __builtin_amdgcn_s_setprio(0); } while (0)
#define PG8_WAIT_V(n) asm volatile("s_waitcnt vmcnt(" #n ")" ::: "memory")
#define PG8_WAIT_L(n) asm volatile("s_waitcnt lgkmcnt(" #n ")" ::: "memory")
#define PG8_BAR __builtin_amdgcn_s_barrier()
#define PG8_SCHED __builtin_amdgcn_sched_barrier(0)
    Unit cur, nxt; int ui = 0;
    if (!S.next(0, cur)) return;
    f32x4 acc[2][2][4][2];
#pragma unroll
    for (int a = 0; a < 2; ++a)
#pragma unroll
        for (int b = 0; b < 2; ++b)
#pragma unroll
            for (int m = 0; m < 4; ++m)
#pragma unroll
                for (int n = 0; n < 2; ++n) acc[a][b][m][n] = (f32x4){0.f, 0.f, 0.f, 0.f};
    bf16x8 At[4][2], B0[2][2], B1[2][2];
    const char* cA = (const char*)g.A + (size_t)cur.pm * tstep; const char* cB = (const char*)g.Bt + (size_t)cur.pn * tstep;
    S.a_ready(cur);
    if constexpr (SP2) {
        PG8_STAGE(PG8_SB(0, 0), cB, voffB); PG8_STAGE(PG8_SB(0, 1), cB + hstep, voffB); PG8_STAGE(PG8_SA(0, 0), cA, voffA); PG8_STAGE(PG8_SA(0, 1), cA + hstep, voffA);
        if (wr == 1) PG8_BAR;
        PG8_WAIT_V(2); PG8_BAR;
        PG8_STAGE(PG8_SB(1, 0), cB + kstep, voffB); PG8_STAGE(PG8_SA(1, 0), cA + kstep, voffA); PG8_STAGE(PG8_SB(1, 1), cB + hstep + kstep, voffB);
        PG8_WAIT_V(6); PG8_BAR;
    } else {
        PG8_STAGE(PG8_SB(0, 0), cB, voffB); PG8_STAGE(PG8_SA(0, 0), cA, voffA); PG8_STAGE(PG8_SB(0, 1), cB + hstep, voffB); PG8_STAGE(PG8_SA(0, 1), cA + hstep, voffA);
        if (wr == 1) PG8_BAR;
        PG8_WAIT_V(4); PG8_BAR;
        PG8_STAGE(PG8_SB(1, 0), cB + kstep, voffB); PG8_STAGE(PG8_SA(1, 0), cA + kstep, voffA); PG8_STAGE(PG8_SB(1, 1), cB + hstep + kstep, voffB);
        PG8_WAIT_V(6); PG8_BAR;
    }
    for (;;) {
        const bool has_next = S.next(ui + 1, nxt);
        const char* nA = has_next ? (const char*)g.A + (size_t)nxt.pm * tstep : cA; const char* nB = has_next ? (const char*)g.Bt + (size_t)nxt.pn * tstep : cB;
        for (int t = 0; t < nt; t += 2) {
            const bool last = (t == nt - 2);
            const char* a1 = cA + (size_t)(t + 1) * kstep;
            const char* a2 = last ? nA : cA + (size_t)(t + 2) * kstep; const char* b2 = last ? nB : cB + (size_t)(t + 2) * kstep;
            const char* a3 = a2 + kstep; const char* b3 = b2 + kstep;
            if (last && has_next) S.a_ready(nxt);
            if constexpr (SP2) {
            PG8_LDB(B0, 0, 0); PG8_LDB(B1, 0, 1); PG8_SCHED; PG8_LDA(At, 0, 0); PG8_STAGE(PG8_SA(1, 1), a1 + hstep, voffA);
            PG8_WAIT_V(8); PG8_WAIT_L(0); PG8_BAR; PG8_MMA(0, 0, At, B0); PG8_MMA(0, 1, At, B1); PG8_BAR; PG8_SCHED;
            PG8_LDA(At, 0, 1); PG8_STAGE(PG8_SB(0, 0), b2, voffB); PG8_STAGE(PG8_SB(0, 1), b2 + hstep, voffB); PG8_STAGE(PG8_SA(0, 0), a2, voffA);
            PG8_WAIT_V(8); PG8_WAIT_L(0); PG8_BAR; PG8_MMA(1, 0, At, B0); PG8_MMA(1, 1, At, B1); PG8_BAR; PG8_SCHED;
            PG8_LDB(B0, 1, 0); PG8_LDB(B1, 1, 1); PG8_SCHED; PG8_LDA(At, 1, 0); PG8_STAGE(PG8_SA(0, 1), a2 + hstep, voffA);
            PG8_WAIT_V(8); PG8_WAIT_L(0); PG8_BAR; PG8_MMA(0, 0, At, B0); PG8_MMA(0, 1, At, B1); PG8_BAR; PG8_SCHED;
            PG8_LDA(At, 1, 1); PG8_STAGE(PG8_SB(1, 0), b3, voffB); PG8_STAGE(PG8_SB(1, 1), b3 + hstep, voffB); PG8_STAGE(PG8_SA(1, 0), a3, voffA);
            PG8_WAIT_V(8); PG8_WAIT_L(0); PG8_BAR; PG8_MMA(1, 0, At, B0); PG8_MMA(1, 1, At, B1); PG8_BAR; PG8_SCHED;
            } else {
            PG8_LDB(B0, 0, 0); PG8_SCHED; PG8_LDA(At, 0, 0); PG8_STAGE(PG8_SA(1, 1), a1 + hstep, voffA);
            PG8_WAIT_L(8); PG8_BAR; PG8_WAIT_L(0); PG8_MMA(0, 0, At, B0); PG8_BAR; PG8_SCHED;
            PG8_LDB(B1, 0, 1); PG8_STAGE(PG8_SB(0, 0), b2, voffB);
            PG8_BAR; PG8_WAIT_L(0); PG8_MMA(0, 1, At, B1); PG8_BAR;
            PG8_LDA(At, 0, 1); PG8_STAGE(PG8_SA(0, 0), a2, voffA);
            PG8_BAR; PG8_WAIT_L(0); PG8_MMA(1, 0, At, B0); PG8_BAR; PG8_SCHED;
            PG8_STAGE(PG8_SB(0, 1), b2 + hstep, voffB);
            PG8_WAIT_V(6); PG8_BAR; PG8_MMA(1, 1, At, B1); PG8_BAR;
            PG8_LDB(B0, 1, 0); PG8_SCHED; PG8_LDA(At, 1, 0); PG8_STAGE(PG8_SA(0, 1), a2 + hstep, voffA);
            PG8_WAIT_L(8); PG8_BAR; PG8_WAIT_L(0); PG8_MMA(0, 0, At, B0); PG8_BAR; PG8_SCHED;
            PG8_LDB(B1, 1, 1); PG8_STAGE(PG8_SB(1, 0), b3, voffB);
            PG8_BAR; PG8_WAIT_L(0); PG8_MMA(0, 1, At, B1); PG8_BAR;
            PG8_LDA(At, 1, 1); PG8_STAGE(PG8_SA(1, 0), a3, voffA);
            PG8_BAR; PG8_WAIT_L(0); PG8_MMA(1, 0, At, B0); PG8_BAR; PG8_SCHED;
            PG8_STAGE(PG8_SB(1, 1), b3 + hstep, voffB);
            PG8_WAIT_V(6); PG8_BAR; PG8_MMA(1, 1, At, B1); PG8_BAR;
            }
        }
        if constexpr (ALIGN_EPI) { if (wr == 0) PG8_BAR; }
        if constexpr (!Epi::AFTER_DRAIN) { E(acc, cur, wr, wc, fr, fq); S.done(cur); }
        if (!has_next) break;
#pragma unroll
        for (int a = 0; a < 2; ++a)
#pragma unroll
            for (int b = 0; b < 2; ++b)
#pragma unroll
                for (int m = 0; m < 4; ++m)
#pragma unroll
                    for (int n = 0; n < 2; ++n) acc[a][b][m][n] = (f32x4){0.f, 0.f, 0.f, 0.f};
        cur = nxt; cA = nA; cB = nB; ++ui;
        if constexpr (ALIGN_EPI) { if (wr == 1) PG8_BAR; }
    }
    PG8_WAIT_V(0);
    if constexpr (!ALIGN_EPI) { if (wr == 0) PG8_BAR; }
    PG8_BAR;
    if constexpr (Epi::AFTER_DRAIN) { E.fused(acc, cur, wr, wc, fr, fq, lds, wid, lane); S.done(cur); }
#undef PG8_SA
#undef PG8_SB
#undef PG8_STAGE
#undef PG8_LDA
#undef PG8_LDB
#undef PG8_MMA
#undef PG8_WAIT_V
#undef PG8_WAIT_L
#undef PG8_BAR
#undef PG8_SCHED
}
}
#define XB_TMO      128
#define XB_XCNT(j)  (256  + 64 * (j))
#define XB_XSUB(j)  (1280 + 64 * (j))
#define XB_XGEN(j)  (2304 + 64 * (j))
#define XB_TOP      3328
#define XB_TOPGEN   3392
#define XCD_BAR_WORDS 3456
#define XB_SPIN_CAP (1u << 21)


__device__ __forceinline__ unsigned xb_ld(unsigned* p)              { return __hip_atomic_load(p, __ATOMIC_RELAXED, __HIP_MEMORY_SCOPE_AGENT); }
__device__ __forceinline__ unsigned xb_add(unsigned* p, unsigned v) { return __hip_atomic_fetch_add(p, v, __ATOMIC_RELAXED, __HIP_MEMORY_SCOPE_AGENT); }
__device__ __forceinline__ unsigned xb_xcc_id() { return (unsigned)__builtin_amdgcn_s_getreg((3 << 11) | 20) & 0xFu; }
#define XB_SPIN(cond, bar) do { unsigned _sp = 0; while (cond) { __builtin_amdgcn_s_sleep(1); \
    if ((++_sp & 255u) == 0u) { if (xb_ld(&(bar)[XB_TMO])) break; if (_sp > XB_SPIN_CAP) { atomicAdd(&(bar)[XB_TMO], 1u); break; } } } } while (0)

struct XcdBarrier {
    unsigned* bar; unsigned x;
    volatile LAS unsigned* st;
};

__device__ __forceinline__ XcdBarrier xcd_barrier_post(unsigned* bar, volatile LAS unsigned* st) {
    XcdBarrier b; b.bar = bar; b.x = xb_xcc_id(); b.st = st;
    if (threadIdx.x == 0) (void)xb_add(&bar[XB_XCNT(b.x)], 1u);
    return b;
}
__device__ __forceinline__ void xcd_barrier_complete(unsigned* bar, unsigned x, unsigned& nloc, unsigned& nx) {
    const unsigned G = gridDim.x * gridDim.y * gridDim.z;
    unsigned sum, cnt, mine, sp = 0u;
    for (;;) {
        sum = 0u; cnt = 0u; mine = 0u;
#pragma unroll
        for (unsigned j = 0; j < 16; ++j) { const unsigned c = xb_ld(&bar[XB_XCNT(j)]); sum += c; cnt += (c > 0u) ? 1u : 0u; mine = (j == x) ? c : mine; }
        if (sum == G) break;
        __builtin_amdgcn_s_sleep(1);
        if ((++sp & 255u) == 0u) { if (xb_ld(&bar[XB_TMO])) break; if (sp > XB_SPIN_CAP) { atomicAdd(&bar[XB_TMO], 1u); break; } }
    }
    nloc = mine > 0u ? mine : 1u; nx = cnt > 0u ? cnt : 1u;
}

__device__ __forceinline__ void xcd_barrier(const XcdBarrier& b) {
    asm volatile("s_waitcnt vmcnt(0)" ::: "memory");
    __syncthreads();
    if (threadIdx.x == 0) {
        unsigned* bar = b.bar;
        __builtin_amdgcn_s_waitcnt(0);
        unsigned nloc = b.st[0], nx = b.st[1];
        if (nloc == 0u) { xcd_barrier_complete(bar, b.x, nloc, nx); b.st[0] = nloc; b.st[1] = nx; }
        const unsigned old = xb_add(&bar[XB_XSUB(b.x)], 1u);
        const unsigned gen = old / nloc;
        if (old + 1u == (gen + 1u) * nloc) {
            __builtin_amdgcn_fence(__ATOMIC_RELEASE, "agent");
            asm volatile("s_waitcnt vmcnt(0)" ::: "memory");
            const unsigned og = xb_add(&bar[XB_TOP], 1u);
            const unsigned tg = og / nx;
            if (og + 1u == (tg + 1u) * nx) xb_add(&bar[XB_TOPGEN], 1u);
            else XB_SPIN(xb_ld(&bar[XB_TOPGEN]) == tg, bar);
            __builtin_amdgcn_fence(__ATOMIC_ACQUIRE, "agent");
            xb_add(&bar[XB_XGEN(b.x)], 1u);
            asm volatile("s_waitcnt vmcnt(0)" ::: "memory");
        } else {
            XB_SPIN(xb_ld(&bar[XB_XGEN(b.x)]) == gen, bar);
            __builtin_amdgcn_fence(__ATOMIC_ACQUIRE, "agent");
            asm volatile("s_waitcnt vmcnt(0)" ::: "memory");
        }
    }
    __syncthreads();
}

namespace fox {
constexpr int D = 128, QP = 6144, KVP = 6144, OP = 2048;
constexpr float THR = 8.f;
constexpr bool WSKIP = false;
using bf16 = unsigned short;
constexpr float SCALE = 0.08838834764831845f;
constexpr int NW = 8, QBLK = 32, KVBLK = 64, QB = NW * QBLK;
constexpr int SHM_V = KVBLK * D * 2, SHM_K = KVBLK * D * 2;
constexpr int BIAS_OFF = 2 * SHM_V + 2 * SHM_K + NW * 64 * 4;
constexpr int MB_OFF = BIAS_OFF + 2 * 4096 * 4;
constexpr int LDS_BYTES = MB_OFF + 64;

typedef short bf16x8 __attribute__((ext_vector_type(8)));
typedef short s16x4 __attribute__((ext_vector_type(4)));
typedef float f32x16 __attribute__((ext_vector_type(16)));
typedef float f32x4 __attribute__((ext_vector_type(4)));
typedef unsigned u32x4 __attribute__((ext_vector_type(4)));
template <class A, class Bt> struct same_t { static constexpr bool v = false; };
template <class A> struct same_t<A, A> { static constexpr bool v = true; };

#define KSWZ(row, colB) ((row) * 256 + ((colB) ^ (((row) & 7) << 4)))
#define SBAR() __builtin_amdgcn_sched_barrier(0)
__device__ __forceinline__ int v_st(int k, int c) { const int kk = (k & ~0xC) | ((k & 4) << 1) | ((k & 8) >> 1); return ((kk >> 3) * 4 + (c >> 5)) * 512 + ((kk & 7) * 32 + (c & 31)) * 2; }
__device__ __forceinline__ int v_rd_base(int lane) { return ((lane & 3) << 3) | (((lane >> 2) & 3) << 6) | (((lane >> 4) & 1) << 5) | (((lane >> 5) & 1) << 8); }
constexpr int v_rd_off(int d0, int ks, int half) { return d0 * 512 + ks * 4096 + half * 2048; }
__device__ __forceinline__ int crow(int r, int hi) { return (r & 3) + 8 * (r >> 2) + 4 * hi; }
__device__ __forceinline__ unsigned cvtpk(float lo, float hi) {
    unsigned r; asm volatile("v_cvt_pk_bf16_f32 %0, %1, %2" : "=v"(r) : "v"(lo), "v"(hi)); return r;
}
__device__ __forceinline__ bf16x8 pack8(f32x4 a, f32x4 b) {
    u32x4 w = {cvtpk(a[0], a[1]), cvtpk(a[2], a[3]), cvtpk(b[0], b[1]), cvtpk(b[2], b[3])};
    return *reinterpret_cast<bf16x8*>(&w);
}
template <class T> __device__ __forceinline__ bf16x8 load8(const T* p) {
    if constexpr (same_t<T, float>::v) { return pack8(*(const f32x4*)p, *(const f32x4*)(p + 4)); }
    else { return *reinterpret_cast<const bf16x8*>(p); }
}
__device__ __forceinline__ void mask_tile(f32x16& p0, f32x16& p1, int dq, unsigned W) {
    const float NEG = -__builtin_inff();
#pragma unroll
    for (int r = 0; r < 16; ++r) {
        const int c = (r & 3) + 8 * (r >> 2);
        if ((unsigned)(dq - c) >= W) p0[r] = NEG;
        if ((unsigned)(dq - c - 32) >= W) p1[r] = NEG;
    }
}
__device__ __forceinline__ void partialSM(f32x16& p0, f32x16& p1, float& m_reg, float& mn, float& alpha) {
    float pmax = p0[0]; for (int r = 1; r < 16; ++r) pmax = fmaxf(pmax, p0[r]); for (int r = 0; r < 16; ++r) pmax = fmaxf(pmax, p1[r]);
    { auto rr = __builtin_amdgcn_permlane32_swap(__float_as_uint(pmax), __float_as_uint(pmax), false, false);
      pmax = fmaxf(__uint_as_float(rr[0]), __uint_as_float(rr[1])); }
    constexpr float C2 = 1.4426950408889634f * SCALE;
    if (__builtin_expect(__all((pmax - m_reg) * SCALE <= THR), 1)) { mn = m_reg; alpha = 1.f; }
    else { mn = fmaxf(m_reg, pmax); alpha = __builtin_amdgcn_exp2f((m_reg - mn) * C2); m_reg = mn; }
    const float mnL = -mn * C2;
    for (int r = 0; r < 16; ++r) p0[r] = fmaf(p0[r], C2, mnL); for (int r = 0; r < 16; ++r) p1[r] = fmaf(p1[r], C2, mnL);
    for (int r = 0; r < 16; ++r) p0[r] = __builtin_amdgcn_exp2f(p0[r]);
}
__device__ __forceinline__ void finishSM(f32x16& p0, f32x16& p1, float alpha, float& l_reg, bf16x8& pa0, bf16x8& pa1, bf16x8& pa2, bf16x8& pa3) {
    for (int r = 0; r < 16; ++r) p1[r] = __builtin_amdgcn_exp2f(p1[r]);
    float ps = 0; for (int r = 0; r < 16; ++r) ps += p0[r]; for (int r = 0; r < 16; ++r) ps += p1[r];
    { auto rr = __builtin_amdgcn_permlane32_swap(__float_as_uint(ps), __float_as_uint(ps), false, false);
      ps = __uint_as_float(rr[0]) + __uint_as_float(rr[1]); }
    l_reg = l_reg * alpha + ps;
#define PK4(P, B_, OUT) do { unsigned a0 = cvtpk(P[B_+0], P[B_+1]), a1 = cvtpk(P[B_+2], P[B_+3]);                          \
        unsigned b0 = cvtpk(P[B_+4], P[B_+5]), b1 = cvtpk(P[B_+6], P[B_+7]);                                             \
        auto r0 = __builtin_amdgcn_permlane32_swap(a0, b0, false, false); auto r1 = __builtin_amdgcn_permlane32_swap(a1, b1, false, false); \
        u32x4 w = {r0[0], r1[0], r0[1], r1[1]}; OUT = *reinterpret_cast<bf16x8*>(&w); } while (0)
    PK4(p0, 0, pa0); PK4(p0, 8, pa1); PK4(p1, 0, pa2); PK4(p1, 8, pa3);
#undef PK4
}
template <int KB, bool SK>
__device__ __forceinline__ void qkt(f32x16& p0, f32x16& p1, const char* K_lds, int r32, int hi, const bf16x8* qr, bool act, const float* bl  ) {
    if (SK && !act) { const float NEG = -__builtin_inff();
#pragma unroll
        for (int r = 0; r < 16; ++r) { p0[r] = NEG; p1[r] = NEG; } return; }
    { const f32x4 a0 = *(const f32x4*)(bl), a1 = *(const f32x4*)(bl + 8), a2 = *(const f32x4*)(bl + 16), a3 = *(const f32x4*)(bl + 24);
      const f32x4 c0 = *(const f32x4*)(bl + 32), c1 = *(const f32x4*)(bl + 40), c2 = *(const f32x4*)(bl + 48), c3 = *(const f32x4*)(bl + 56);
      p0 = (f32x16){a0[0], a0[1], a0[2], a0[3], a1[0], a1[1], a1[2], a1[3], a2[0], a2[1], a2[2], a2[3], a3[0], a3[1], a3[2], a3[3]};
      p1 = (f32x16){c0[0], c0[1], c0[2], c0[3], c1[0], c1[1], c1[2], c1[3], c2[0], c2[1], c2[2], c2[3], c3[0], c3[1], c3[2], c3[3]}; }
    const char* kb[4];
#pragma unroll
    for (int dd = 0; dd < 4; ++dd) kb[dd] = K_lds + KB * SHM_K + KSWZ(r32, (dd * 16 + hi * 8) * 2);
#pragma unroll
    for (int d0 = 0; d0 < 8; ++d0) { const char* a = kb[d0 & 3] + (d0 >> 2) * 128;
        bf16x8 b0 = *reinterpret_cast<const bf16x8*>(a);
        bf16x8 b1 = *reinterpret_cast<const bf16x8*>(a + 32 * 256);
        p0 = __builtin_amdgcn_mfma_f32_32x32x16_bf16(b0, qr[d0], p0, 0, 0, 0);
        p1 = __builtin_amdgcn_mfma_f32_32x32x16_bf16(b1, qr[d0], p1, 0, 0, 0); }
}
template <int VB, bool SK>
__device__ __forceinline__ void pv_tile(f32x16* o, int vb0, bf16x8 pa0, bf16x8 pa1, bf16x8 pa2, bf16x8 pa3, bool act) {
    if (SK && !act) return;
#define TRRD(dst, off) asm volatile("ds_read_b64_tr_b16 %0, %1 offset:%2" : "=&v"(dst) : "v"(vb0), "i"(off) : "memory")
#define PV_D0(d0) do { s16x4 l0, l1, l2, l3, h0, h1, h2, h3; constexpr int b_ = VB * SHM_V + v_rd_off(d0, 0, 0);     \
        TRRD(l0, b_); TRRD(h0, b_ + 2048); TRRD(l1, b_ + 4096); TRRD(h1, b_ + 6144); TRRD(l2, b_ + 8192); TRRD(h2, b_ + 10240); TRRD(l3, b_ + 12288); TRRD(h3, b_ + 14336); \
        asm volatile("s_waitcnt lgkmcnt(0)" ::: "memory"); SBAR();                 \
        o[d0] = __builtin_amdgcn_mfma_f32_32x32x16_bf16(pa0, (bf16x8){l0[0], l0[1], l0[2], l0[3], h0[0], h0[1], h0[2], h0[3]}, o[d0], 0, 0, 0);   \
        o[d0] = __builtin_amdgcn_mfma_f32_32x32x16_bf16(pa1, (bf16x8){l1[0], l1[1], l1[2], l1[3], h1[0], h1[1], h1[2], h1[3]}, o[d0], 0, 0, 0);   \
        o[d0] = __builtin_amdgcn_mfma_f32_32x32x16_bf16(pa2, (bf16x8){l2[0], l2[1], l2[2], l2[3], h2[0], h2[1], h2[2], h2[3]}, o[d0], 0, 0, 0);   \
        o[d0] = __builtin_amdgcn_mfma_f32_32x32x16_bf16(pa3, (bf16x8){l3[0], l3[1], l3[2], l3[3], h3[0], h3[1], h3[2], h3[3]}, o[d0], 0, 0, 0); } while (0)
    PV_D0(0); PV_D0(1); PV_D0(2); PV_D0(3);
#undef PV_D0
#undef TRRD
}

template <class TIn, class TOut> struct BlockRef { const TIn* Q; const TIn* K; const TIn* V; TOut* O; const float* bt; int P0; };
template <class TIn> struct Seam {
    bf16x8 qr[8];
    bf16x8 st_k0, st_k1;
};
__device__ __forceinline__ int swa_jlo(int P0, int W) { const int lowk = P0 - W + 1; return lowk > 0 ? lowk / KVBLK : 0; }
#define ROW(p, k0, rr) ((p) + (unsigned)(((k0) + (rr)) * KVP + sc))
#define VMW() asm volatile("s_waitcnt vmcnt(0)" ::: "memory")
#define VMWN(n) asm volatile("s_waitcnt vmcnt(%0)" :: "i"(n) : "memory")
#define SLOAD_F(p, k0) do { S.st_k0 = load8<TIn>(ROW(p, k0, sr)); S.st_k1 = load8<TIn>(ROW(p, k0, 32 + sr)); } while (0)
#define SWRITE_KF(bf) do { *(bf16x8*)(K_lds + (bf) * SHM_K + kws) = S.st_k0; *(bf16x8*)(K_lds + (bf) * SHM_K + kws + 32 * 256) = S.st_k1; } while (0)
#define SWRITE_VF(bf) do { *(bf16x8*)(V_lds + (bf) * SHM_V + vst0) = S.st_k0; *(bf16x8*)(V_lds + (bf) * SHM_V + vst1) = S.st_k1; } while (0)
template <class TIn, class TOut>
__device__ __forceinline__ void causal_swa_prime(const BlockRef<TIn, TOut>& cur, int W, char* lds, Seam<TIn>& S) {
    int tid_ = threadIdx.x; asm volatile("" : "+v"(tid_));
    const int tid = tid_, wid = __builtin_amdgcn_readfirstlane(tid >> 6), lane = tid & 63, r32 = lane & 31, hi = lane >> 5;
    const int sr = tid >> 4, sc = (tid & 15) * 8, kws = KSWZ(sr, sc * 2); char* K_lds = lds + 2 * SHM_V;
    const int kb0 = swa_jlo(cur.P0, W) * KVBLK;
    for (int d0 = 0; d0 < 8; ++d0) S.qr[d0] = load8<TIn>(cur.Q + (unsigned)((wid * QBLK + r32) * QP + hi * 8) + d0 * 16);
    SLOAD_F(cur.K, kb0); VMW(); SWRITE_KF(0); SBAR(); SLOAD_F(cur.V, kb0);
    __syncthreads();
}
template <class TIn, class TOut>
__device__ __forceinline__ void causal_swa_block(const BlockRef<TIn, TOut>& cur, const BlockRef<TIn, TOut>& nxt, int skv, int W, char* lds, Seam<TIn>& S) {
    int tid_ = threadIdx.x; asm volatile("" : "+v"(tid_));
    const int tid = tid_, wid = __builtin_amdgcn_readfirstlane(tid >> 6), lane = tid & 63, r32 = lane & 31, hi = lane >> 5;
    const int j_lo = swa_jlo(cur.P0, W);
    int j_hi = (cur.P0 + QB - 1) / KVBLK + 1; if (j_hi > skv / KVBLK) j_hi = skv / KVBLK;
    const int NT = j_hi - j_lo;
    const int kbn = swa_jlo(nxt.P0, W) * KVBLK;
    const int qlo = cur.P0 + wid * QBLK, qm = qlo + r32 - 4 * hi;
    char* V_lds = lds; char* K_lds = lds + 2 * SHM_V;
    float* ws = (float*)(lds + 2 * SHM_V + 2 * SHM_K) + wid * 64; float* li_l = ws, * al_l = ws + 32;
    float m_reg = -1e30f, l_reg = 0; f32x16 o[4] = {};
    const int sr = tid >> 4, sc = (tid & 15) * 8, vst0 = v_st(sr, sc), vst1 = v_st(32 + sr, sc), kws = KSWZ(sr, sc * 2);
    const int vb0 = (int)(uintptr_t)V_lds + v_rd_base(lane);
    const TIn* Kh = cur.K; const TIn* Vh = cur.V;
    const float* btab = cur.bt + 4 * hi;
#define RESC(a) do { if (__any((a) < 1.f)) { if (hi == 0) al_l[r32] = (a); asm volatile("s_waitcnt lgkmcnt(0)" ::: "memory");              \
                     for (int d_ = 0; d_ < 4; ++d_) for (int r = 0; r < 16; ++r) o[d_][r] *= al_l[crow(r, hi)]; } } while (0)
#define KBASE(t) ((j_lo + (t)) * KVBLK)
#define ACT(t) (KBASE(t) <= qlo + QBLK - 1 && KBASE(t) + KVBLK - 1 >= qlo - W + 1)
#define MASKT(P0_, P1_, t) do { const int kb_ = KBASE(t); if ((!SK || ACT(t)) && (kb_ + KVBLK - 1 > qlo || kb_ <= qlo + QBLK - 1 - W)) mask_tile(P0_, P1_, qm - kb_, (unsigned)W); } while (0)
    constexpr int NQL = 8;
    constexpr bool SK = WSKIP;
#define SEAM_K0() do { VMWN(NQL); SWRITE_KF(0); SBAR(); SLOAD_F(nxt.V, kbn); SBAR(); } while (0)
    f32x16 pA0, pA1, pB0, pB1; float mnA, mnB, alA, alB; bf16x8 pa0, pa1, pa2, pa3;
    VMW(); SWRITE_VF(0); SBAR();
    if (NT > 1) { SLOAD_F(Kh, KBASE(1)); }
    SBAR(); qkt<0, SK>(pA0, pA1, K_lds, r32, hi, S.qr, ACT(0), btab + KBASE(0));
    if (NT > 1) { VMW(); SWRITE_KF(1); SBAR(); SLOAD_F(Vh, KBASE(1)); }
    MASKT(pA0, pA1, 0); partialSM(pA0, pA1, m_reg, mnA, alA);
    if (NT > 1) { VMW(); SWRITE_VF(1); SBAR(); if (NT > 2) SLOAD_F(Kh, KBASE(2)); }
    __syncthreads();
#define HALF_STEP(PX0, PX1, mnX, alX, PY0, PY1, alY, t, KB, VB, SB) do {                                                      \
        SBAR(); qkt<KB, SK>(PX0, PX1, K_lds, r32, hi, S.qr, ACT(t), btab + KBASE(t));                                             \
        finishSM(PY0, PY1, alY, l_reg, pa0, pa1, pa2, pa3); SBAR();                                                           \
        if ((t) + 1 < NT) { VMW(); SWRITE_KF(SB); SBAR(); SLOAD_F(Vh, KBASE((t) + 1)); SBAR(); }                              \
        pv_tile<VB, SK>(o, vb0, pa0, pa1, pa2, pa3, ACT((t) - 1)); MASKT(PX0, PX1, (t)); partialSM(PX0, PX1, m_reg, mnX, alX);                                        \
        __syncthreads();                                                                                                      \
        if ((t) + 1 < NT) { VMW(); SWRITE_VF(SB); SBAR(); if ((t) + 2 < NT) SLOAD_F(Kh, KBASE((t) + 2)); }                    \
        RESC(alX); __syncthreads(); } while (0)
    for (int t = 1; t + 1 < NT; t += 2) {
        HALF_STEP(pB0, pB1, mnB, alB, pA0, pA1, alA, t, 1, 0, 0);
        HALF_STEP(pA0, pA1, mnA, alA, pB0, pB1, alB, t + 1, 0, 1, 1);
    }
    const bool even = (NT & 1) == 0;
    if (even) { SBAR(); qkt<1, SK>(pB0, pB1, K_lds, r32, hi, S.qr, ACT(NT - 1), btab + KBASE(NT - 1)); SBAR(); }
    SLOAD_F(nxt.K, kbn); SBAR();
#pragma unroll
    for (int d0 = 0; d0 < 8; ++d0) S.qr[d0] = load8<TIn>(nxt.Q + (unsigned)((wid * QBLK + r32) * QP + hi * 8) + d0 * 16);
    SBAR();
    finishSM(pA0, pA1, alA, l_reg, pa0, pa1, pa2, pa3); SBAR();
    pv_tile<0, SK>(o, vb0, pa0, pa1, pa2, pa3, ACT(even ? NT - 2 : NT - 1));
    if (even) { MASKT(pB0, pB1, NT - 1); partialSM(pB0, pB1, m_reg, mnB, alB); __syncthreads(); RESC(alB);
        finishSM(pB0, pB1, alB, l_reg, pa0, pa1, pa2, pa3); SBAR(); pv_tile<1, SK>(o, vb0, pa0, pa1, pa2, pa3, ACT(NT - 1)); }
    SBAR(); SEAM_K0();
    if (hi == 0) li_l[r32] = l_reg; asm volatile("s_waitcnt lgkmcnt(0)" ::: "memory");
    float rli[16];
#pragma unroll
    for (int r = 0; r < 16; ++r) rli[r] = __builtin_amdgcn_rcpf(li_l[crow(r, hi)]);
    TOut* Ow = cur.O + (unsigned)(wid * QBLK * OP);
#pragma unroll
    for (int r = 0; r < 16; ++r) { const int orow = crow(r, hi);
#pragma unroll
        for (int d0 = 0; d0 < 4; ++d0) { const float v = o[d0][r] * rli[r];
            if constexpr (same_t<TOut, float>::v) { Ow[(unsigned)(orow * OP + d0 * 32 + r32)] = v; }
            else { const float vn = __shfl_xor(v, 1);
                   if ((r32 & 1) == 0) *(unsigned*)(Ow + (unsigned)(orow * OP + d0 * 32 + r32)) = cvtpk(v, vn); } } }
    __syncthreads();
#undef RESC
#undef KBASE
#undef ACT
#undef MASKT
#undef SEAM_K0
#undef HALF_STEP
}
#undef ROW
#undef VMW
#undef VMWN
#undef SLOAD_F
#undef SWRITE_KF
#undef SWRITE_VF
constexpr int NONE = 1 << 20;
__device__ __forceinline__ BlockRef<bf16, bf16> fox_ref(int id, const bf16* FQKV, bf16* OFOX, const float* bt) {
    const int q = id >> 6, i = id & 63, qb = 15 - (i >> 2), bh = 4 * q + (i & 3), b = bh >> 4, h = bh & 15;
    BlockRef<bf16, bf16> r; const size_t row0 = (size_t)b * 4096;
    r.Q = FQKV + (row0 + (size_t)qb * QB) * QP + h * 128; r.K = FQKV + row0 * KVP + 2048 + h * 128; r.V = FQKV + row0 * KVP + 4096 + h * 128;
    r.O = OFOX + (row0 + (size_t)qb * QB) * OP + h * 128; r.bt = bt; r.P0 = qb * QB; return r;
}
__device__ __forceinline__ int fox_grab(unsigned* qctr, int x, int& qoff) {
    while (qoff < 8) { const int q = (x + qoff) & 7; const unsigned i = __hip_atomic_fetch_add(qctr + 64 * q, 1u, __ATOMIC_RELAXED, __HIP_MEMORY_SCOPE_AGENT);
        if (i < 64u) return q * 64 + (int)i; ++qoff; }
    return NONE;
}
__device__ __forceinline__ void fox_table(char* lds, int slot, int id, const float* FB) {
    int tid = threadIdx.x; asm volatile("" : "+v"(tid));
    const int q = id >> 6, i = id & 63, qb = 15 - (i >> 2), bh = 4 * q + (i & 3);
    if (8 * tid < 256 * (qb + 1)) { const float* fb = FB + (size_t)bh * 4096 + tid * 8; float* tb = (float*)(lds + BIAS_OFF) + slot * 4096 + tid * 8;
        const f32x4 v0 = *(const f32x4*)fb, v1 = *(const f32x4*)(fb + 4); *(f32x4*)tb = v0; *(f32x4*)(tb + 4) = v1; }
}
__device__ __forceinline__ void fox_phase(char* lds, unsigned* qctr, int x, const bf16* FQKV, bf16* OFOX, const float* FB) {
    constexpr int SKV_ = 4096, W = 4096;
    volatile int* mb = (volatile int*)(lds + MB_OFF);
    int qoff = 0;
    int tid0 = threadIdx.x; asm volatile("" : "+v"(tid0));
    __syncthreads();
    if (tid0 == 0) { mb[0] = fox_grab(qctr, x, qoff); mb[1] = fox_grab(qctr, x, qoff); }
    __syncthreads();
    int cur = mb[0], nxt = mb[1], slot = 0, k = 0;
    if (cur == NONE) return;
    fox_table(lds, 0, cur, FB);
    Seam<bf16> S;
    { const BlockRef<bf16, bf16> r0 = fox_ref(cur, FQKV, OFOX, (const float*)(lds + BIAS_OFF));
      causal_swa_prime<bf16, bf16>(r0, W, lds, S); }
    for (;;) {
        if (tid0 == 0) mb[k & 1] = fox_grab(qctr, x, qoff);
        if (nxt != NONE) fox_table(lds, slot ^ 1, nxt, FB);
        const BlockRef<bf16, bf16> rc = fox_ref(cur, FQKV, OFOX, (const float*)(lds + BIAS_OFF) + slot * 4096);
        const BlockRef<bf16, bf16> rn = (nxt != NONE) ? fox_ref(nxt, FQKV, OFOX, (const float*)(lds + BIAS_OFF) + (slot ^ 1) * 4096) : rc;
        causal_swa_block<bf16, bf16>(rc, rn, SKV_, W, lds, S);
        const int g = mb[k & 1];
        cur = nxt; nxt = g; slot ^= 1; ++k;
        if (cur == NONE) break;
    }
}
}

struct Ctx { LAS unsigned char* lds; int wave, gw, NW, G; };

__device__ __forceinline__ void transpose_item(const float* W, int ldw, int k0, int c0, bf16* WT, int K, int r0, LAS float* scr, int lane) {
#pragma unroll
    for (int i = 0; i < 32; ++i) { const int kk = 2 * i + (lane >> 5); scr[kk * 33 + (lane & 31)] = W[(size_t)(k0 + kk) * ldw + c0 + (lane & 31)]; }
    asm volatile("s_waitcnt lgkmcnt(0)" ::: "memory");
    const int c = lane & 7;
#pragma unroll
    for (int j = 0; j < 4; ++j) { const int n = (lane >> 3) + 8 * j; const LAS float* s = scr + (8 * c) * 33 + n;
        u32x4 o; o.x = pk2(s[0 * 33], s[1 * 33]); o.y = pk2(s[2 * 33], s[3 * 33]); o.z = pk2(s[4 * 33], s[5 * 33]); o.w = pk2(s[6 * 33], s[7 * 33]);
        *(u32x4*)(WT + (size_t)(r0 + n) * K + k0 + 8 * c) = o; }
    asm volatile("s_waitcnt lgkmcnt(0)" ::: "memory");
}
__device__ __forceinline__ void map_rows(int mode, int nb, int& c0, int& r0) {
    const int n0 = nb * 32;
    if (mode == 0) { c0 = n0; r0 = n0; }
    else if (mode == 1) { r0 = n0; c0 = n0 < 12288 ? n0 : (n0 < 18432 ? SRC_FQKV + (n0 - 12288) : SRC_MERGE + (n0 - 18432)); }
    else { c0 = n0; r0 = (n0 >> 7) * 256 + (n0 & 127) + (mode == 3 ? 128 : 0); }
}
__device__ __forceinline__ void ph_transpose(const Ctx& c, const float* W, int K, int ldw, int ncols, bf16* WT, int mode) {
    LAS float* scr = (LAS float*)(c.lds + c.wave * 16384); int lane = threadIdx.x & 63; asm volatile("" : "+v"(lane));
    const int nblk = ncols / 32, nitems = (K / 64) * nblk;
    for (int it = c.gw; it < nitems; it += c.NW) { const int kb = it / nblk, nb = it % nblk; int c0, r0; map_rows(mode, nb, c0, r0);
        transpose_item(W, ldw, kb * 64, c0, WT, K, r0, scr, lane); }
}
__device__ __forceinline__ void ph_wsmall(const Ctx& c, const float* w_in, bf16* wsm) {
    int lane = threadIdx.x & 63; asm volatile("" : "+v"(lane));
    for (int idx = c.gw * 64 + lane; idx < DEPTH * D * 96; idx += c.NW * 64) {
        const int j = idx % 96, k = (idx / 96) % D, l = idx / (96 * D);
        const int sc = j < 32 ? SRC_B + j : (j < 64 ? SRC_A + (j - 32) : SRC_F + (j - 64));
        wsm[((size_t)l * 96 + j) * D + k] = j < NSM ? (bf16)f2bf(w_in[((size_t)l * D + k) * NIN + sc]) : (bf16)0; }
}
__device__ __forceinline__ void ph_smallproj(const Ctx& c, const bf16* H, const bf16* wsm, float* baf) {
    typedef short bf16x8s __attribute__((ext_vector_type(8))); typedef float f32x16s __attribute__((ext_vector_type(16)));
    int tid = threadIdx.x; asm volatile("" : "+v"(tid)); const int lane = tid & 63, r = lane & 31, kq = lane >> 5;
    LAS float* part = (LAS float*)c.lds;
    for (int task = blockIdx.x; task < M / 32; task += c.G) {
        const bf16* ap = H + (size_t)(32 * task + r) * D + 256 * c.wave + 8 * kq; const bf16* bp = wsm + (size_t)r * D + 256 * c.wave + 8 * kq;
        f32x16s acc[3] = {};
#pragma unroll
        for (int s8 = 0; s8 < 16; ++s8) { const bf16x8s a = *(const bf16x8s*)(ap + 16 * s8);
#pragma unroll
            for (int j = 0; j < 3; ++j) acc[j] = __builtin_amdgcn_mfma_f32_32x32x16_bf16(a, *(const bf16x8s*)(bp + (size_t)(32 * j) * D + 16 * s8), acc[j], 0, 0, 0); }
        __syncthreads();
#pragma unroll
        for (int j = 0; j < 3; ++j)
#pragma unroll
            for (int rr = 0; rr < 16; ++rr) part[((c.wave * 3 + j) * 16 + rr) * 64 + lane] = acc[j][rr];
        __syncthreads();
#pragma unroll
        for (int i = 0; i < 6; ++i) { const int idx = tid + 512 * i, j = idx >> 10, rr = (idx >> 6) & 15, ln = idx & 63; float sum = 0.f;
#pragma unroll
            for (int w = 0; w < 8; ++w) sum += part[w * 3072 + idx];
            const int col = 32 * j + (ln & 31), row = (rr & 3) + 8 * (rr >> 2) + 4 * (ln >> 5);
            if (col < NSM) baf[(size_t)(32 * task + row) * NSM + col] = sum; }
    }
}
__device__ __forceinline__ void ph_adaln(const Ctx& c, const float* cin, const float* w_ada, const float* b_ada, float* mod) {
    LAS float* cond = (LAS float*)c.lds;
    LAS float* red = (LAS float*)(c.lds + 16384);
    int tid = threadIdx.x; asm volatile("" : "+v"(tid)); const int lane = tid & 63;
    for (int i = tid; i < 2 * D; i += 512) cond[i] = fsilu(cin[i]);
    __syncthreads();
    const int ntask = DEPTH * (6 * D / 64);
    for (int task = blockIdx.x; task < ntask; task += c.G) {
        const int l = task / (6 * D / 64), n = (task % (6 * D / 64)) * 64 + lane;
        const float* w = w_ada + (size_t)l * D * (6 * D) + n; float a0 = 0.f, a1 = 0.f;
#pragma unroll 8
        for (int k = c.wave * 256; k < c.wave * 256 + 256; ++k) { const float wv = w[(size_t)k * (6 * D)]; a0 += cond[k] * wv; a1 += cond[D + k] * wv; }
        red[(c.wave * 2 + 0) * 64 + lane] = a0; red[(c.wave * 2 + 1) * 64 + lane] = a1;
        __syncthreads();
        if (tid < 128) { const int b = tid >> 6; float s = b_ada[(size_t)l * 6 * D + n];
#pragma unroll
            for (int w8 = 0; w8 < 8; ++w8) s += red[(w8 * 2 + b) * 64 + lane];
            mod[((size_t)l * 2 + b) * (6 * D) + n] = s; }
        __syncthreads();
    }
}

struct RowArgs { const float* xin; float* x; const bf16* Y; const float* gy; const float* gate; const float* gn; const float* scale; const float* shift; bf16* H; int has_y, has_h; };
__device__ __forceinline__ void ph_rowpass(const Ctx& c, const RowArgs& a) {
    int lane = threadIdx.x & 63; asm volatile("" : "+v"(lane));
    for (int m = c.gw; m < M; m += c.NW) {
        const int b = m / T; const size_t ro = (size_t)m * D; const int mo = b * 6 * D;
        f32x4 v[8];
#pragma unroll
        for (int i = 0; i < 8; ++i) v[i] = *(const f32x4*)(a.xin + ro + 4 * lane + 256 * i);
        if (a.has_y) {
            f32x4 y[8]; float ss = 0.f;
#pragma unroll
            for (int i = 0; i < 8; ++i) { const u32x2 yb = *(const u32x2*)(a.Y + ro + 4 * lane + 256 * i); y[i] = (f32x4){bf_lo(yb.x), bf_hi(yb.x), bf_lo(yb.y), bf_hi(yb.y)}; ss += (y[i][0] * y[i][0] + y[i][1] * y[i][1]) + (y[i][2] * y[i][2] + y[i][3] * y[i][3]); }
            const float r = rsqrtf(wave_sum(ss) * (1.0f / D) + EPS);
#pragma unroll
            for (int i = 0; i < 8; ++i) { const int cc = 4 * lane + 256 * i; const f32x4 g = *(const f32x4*)(a.gy + cc), gt = *(const f32x4*)(a.gate + mo + cc);
                v[i] = v[i] + gt * (y[i] * r * g); }
        }
#pragma unroll
        for (int i = 0; i < 8; ++i) *(f32x4*)(a.x + ro + 4 * lane + 256 * i) = v[i];
        if (!a.has_h) continue;
        float ss = 0.f;
#pragma unroll
        for (int i = 0; i < 8; ++i) ss += (v[i][0] * v[i][0] + v[i][1] * v[i][1]) + (v[i][2] * v[i][2] + v[i][3] * v[i][3]);
        const float r = rsqrtf(wave_sum(ss) * (1.0f / D) + EPS);
#pragma unroll
        for (int i = 0; i < 8; ++i) { const int cc = 4 * lane + 256 * i; const f32x4 g = *(const f32x4*)(a.gn + cc), sc = *(const f32x4*)(a.scale + mo + cc), sh = *(const f32x4*)(a.shift + mo + cc);
            v[i] = v[i] * r * g * (sc + 1.0f) + sh;
            u32x2 w; w.x = pk2(v[i][0], v[i][1]); w.y = pk2(v[i][2], v[i][3]); *(u32x2*)(a.H + ro + cc) = w; }
    }
}

__device__ __forceinline__ void ph_conv(const Ctx& c, const bf16* raw, const float* convw  , bf16* dnc) {
    int lane = threadIdx.x & 63; asm volatile("" : "+v"(lane));
    constexpr int NTASK = (M / 8) * 64;
    unsigned ua[11], ub[11]; f32x4 wa0, wa1, wb0, wb1;
#define CONV_LOAD(task, U, W0, W1) do { const int hv_ = (task) & 63, m0_ = ((task) >> 6) * 8, t0_ = m0_ % T, ch_ = hv_ * 128 + 2 * lane; \
        W0 = *(const f32x4*)(convw + (size_t)ch_ * 4); W1 = *(const f32x4*)(convw + (size_t)ch_ * 4 + 4); \
        _Pragma("unroll") for (int i = 0; i < 11; ++i) U[i] = ((t0_ + i - 3) >= 0) ? *(const unsigned*)(raw + (size_t)(m0_ + i - 3) * DN_CONV + ch_) : 0u; } while (0)
    int task = c.gw;
    if (task < NTASK) CONV_LOAD(task, ua, wa0, wa1);
    for (; task < NTASK; task += c.NW) {
        const int nxt = task + c.NW;
        if (nxt < NTASK) CONV_LOAD(nxt, ub, wb0, wb1);
        const int hv = task & 63, m0 = (task >> 6) * 8, ch = hv * 128 + 2 * lane;
        float a0[8], a1[8];
#pragma unroll
        for (int i = 0; i < 8; ++i) { a0[i] = fsilu(wa0[0] * bf_lo(ua[i]) + wa0[1] * bf_lo(ua[i + 1]) + wa0[2] * bf_lo(ua[i + 2]) + wa0[3] * bf_lo(ua[i + 3]));
                                      a1[i] = fsilu(wa1[0] * bf_hi(ua[i]) + wa1[1] * bf_hi(ua[i + 1]) + wa1[2] * bf_hi(ua[i + 2]) + wa1[3] * bf_hi(ua[i + 3])); }
        if (hv < 32) { float ss[8];
#pragma unroll
            for (int i = 0; i < 8; ++i) ss[i] = a0[i] * a0[i] + a1[i] * a1[i];
#pragma unroll
            for (int o = 1; o < 64; o <<= 1)
#pragma unroll
                for (int i = 0; i < 8; ++i) ss[i] += __shfl_xor(ss[i], o);
#pragma unroll
            for (int i = 0; i < 8; ++i) { float rr = rsqrtf(ss[i] + EPS); if (hv < 16) rr *= 0.08838834764831845f; a0[i] *= rr; a1[i] *= rr; } }
#pragma unroll
        for (int i = 0; i < 8; ++i) *(unsigned*)(dnc + (size_t)(m0 + i) * DN_CONV + ch) = pk2(a0[i], a1[i]);
#pragma unroll
        for (int i = 0; i < 11; ++i) ua[i] = ub[i];
        wa0 = wb0; wa1 = wb1;
    }
#undef CONV_LOAD
}
__device__ __forceinline__ float softplus_f(float x) { return fmaxf(x, 0.f) + log1pf(__expf(-fabsf(x))); }
__device__ __forceinline__ void ph_gates(const Ctx& c, const float* baf, const float* a_log, const float* dt_bias, const float* f_bias, float* beta, float* g, float* logf) {
    int lane = threadIdx.x & 63; asm volatile("" : "+v"(lane));
    for (int idx = c.gw * 64 + lane; idx < M * NSM; idx += c.NW * 64) {
        const int m = idx / NSM, j = idx % NSM; const float v = baf[idx];
        if (j < 32) beta[(size_t)m * 32 + j] = 1.0f / (1.0f + expf(-v));
        else if (j < 64) { const int h = j - 32; g[(size_t)m * 32 + h] = -expf(a_log[h]) * softplus_f(v + dt_bias[h]); }
        else { const int h = j - 64; logf[(size_t)m * 16 + h] = -softplus_f(-(v + f_bias[h])); } }
}
__device__ __forceinline__ void ph_fcum(const Ctx& c, const float* logf, float* fc) {
    int lane = threadIdx.x & 63; asm volatile("" : "+v"(lane));
    for (int bh = c.gw; bh < NB * FOXH; bh += c.NW) { const int b = bh / FOXH, h = bh % FOXH; float carry = 0.f; float v[64];
#pragma unroll
        for (int i = 0; i < 64; ++i) v[i] = logf[(size_t)(b * T + 64 * i + lane) * 16 + h];
#pragma unroll
        for (int i = 0; i < 64; ++i) { float x = v[i];
#pragma unroll
            for (int o = 1; o < 64; o <<= 1) { const float u = __shfl_up(x, o); if (lane >= o) x += u; }
            x += carry; fc[(size_t)bh * T + 64 * i + lane] = x * (-11.313708498984761f); carry = __shfl(x, 63); } }
}
__device__ __forceinline__ void ph_dn_naive(const Ctx& c, const bf16* dnc, const float* g, const float* beta, float* o) {
    int lane = threadIdx.x & 63; asm volatile("" : "+v"(lane));
    constexpr int TB = 16;
    for (int gw = c.gw; gw < NB * 32 * 128; gw += c.NW) {
        const int j = gw & 127, hv = (gw >> 7) & 31, b = gw >> 12, hq = hv >> 1;
        const bf16* rowq = dnc + (size_t)b * T * DN_CONV + hq * 128 + 2 * lane; const bf16* rowv = dnc + (size_t)b * T * DN_CONV + 4096 + hv * 128 + j;
        const float* gp = g + (size_t)b * T * 32 + hv; const float* bp = beta + (size_t)b * T * 32 + hv;
        unsigned qa[TB], ka[TB]; float va[TB], ga[TB], ba[TB];
#pragma unroll
        for (int i = 0; i < TB; ++i) { qa[i] = *(const unsigned*)(rowq + (size_t)i * DN_CONV); ka[i] = *(const unsigned*)(rowq + (size_t)i * DN_CONV + 2048); va[i] = bf2f(rowv[(size_t)i * DN_CONV]); ga[i] = gp[i * 32]; ba[i] = bp[i * 32]; }
        float s0 = 0.f, s1 = 0.f;
        for (int t0 = 0; t0 < T; t0 += TB) {
            unsigned qn[TB], kn[TB]; float vn[TB], gn[TB], bn[TB];
            const int tn = (t0 + TB < T) ? t0 + TB : t0;
#pragma unroll
            for (int i = 0; i < TB; ++i) { const size_t tt = (size_t)(tn + i); qn[i] = *(const unsigned*)(rowq + tt * DN_CONV); kn[i] = *(const unsigned*)(rowq + tt * DN_CONV + 2048); vn[i] = bf2f(rowv[tt * DN_CONV]); gn[i] = gp[tt * 32]; bn[i] = bp[tt * 32]; }
#pragma unroll
            for (int i = 0; i < TB; ++i) {
                const float q0 = bf_lo(qa[i]), q1 = bf_hi(qa[i]), k0 = bf_lo(ka[i]), k1 = bf_hi(ka[i]), eg = __expf(ga[i]);
                s0 *= eg; s1 *= eg;
                float dk = s0 * k0 + s1 * k1, dq = s0 * q0 + s1 * q1, kq = k0 * q0 + k1 * q1;
#pragma unroll
                for (int of = 1; of < 64; of <<= 1) { dk += __shfl_xor(dk, of); dq += __shfl_xor(dq, of); kq += __shfl_xor(kq, of); }
                const float cc = ba[i] * (va[i] - dk);
                s0 += cc * k0; s1 += cc * k1;
                if (lane == 0) o[((size_t)b * T + t0 + i) * 4096 + hv * 128 + j] = dq + cc * kq; }
#pragma unroll
            for (int i = 0; i < TB; ++i) { qa[i] = qn[i]; ka[i] = kn[i]; va[i] = vn[i]; ga[i] = gn[i]; ba[i] = bn[i]; }
        }
    }
}
__device__ __forceinline__ void ph_dn_norm(const Ctx& c, const float* o, const float* norm_w, const bf16* zs, bf16* odn) {
    int lane = threadIdx.x & 63; asm volatile("" : "+v"(lane));
    for (int gw = c.gw; gw < M * 32; gw += c.NW) { const size_t off = (size_t)gw * 128 + 2 * lane;
        const float a0 = o[off], a1 = o[off + 1]; const float r = rsqrtf(wave_sum(a0 * a0 + a1 * a1) * (1.0f / 128.0f) + EPS);
        const unsigned zu = *(const unsigned*)(zs + off);
        *(unsigned*)(odn + off) = pk2(a0 * r * norm_w[2 * lane] * bf_lo(zu), a1 * r * norm_w[2 * lane + 1] * bf_hi(zu)); }
}
constexpr int RING_BYTES = 131072;
constexpr int LDSCTL_OFF = RING_BYTES, MISC_OFF = LDSCTL_OFF + 320;
constexpr int LDS_BYTES = 147456;


namespace dn {
typedef short bf16x8 __attribute__((ext_vector_type(8)));
typedef short s16x4 __attribute__((ext_vector_type(4)));
typedef float f32x16 __attribute__((ext_vector_type(16)));
typedef float f32x8 __attribute__((ext_vector_type(8)));
typedef __bf16 bf16x8_t __attribute__((ext_vector_type(8)));
#define DN_MFMA(a, b, c) __builtin_amdgcn_mfma_f32_32x32x16_bf16((a), (b), (c), 0, 0, 0)
constexpr int UNIT_FRAGS = 54;
constexpr int F_NW = 0, F_QG = 16, F_KGT = 32, F_AT = 48;
constexpr int UNIT_BYTES = UNIT_FRAGS * 1024;
constexpr int DU_UNIT = 4 * 2 * 64 * 16;

template <int S> __device__ __forceinline__ bf16x8 pack_step(const f32x16& x) {
    const f32x8 v = {x[8 * S + 0], x[8 * S + 1], x[8 * S + 2], x[8 * S + 3], x[8 * S + 4], x[8 * S + 5], x[8 * S + 6], x[8 * S + 7]};
    return __builtin_bit_cast(bf16x8, __builtin_convertvector(v, bf16x8_t));
}
__device__ __forceinline__ bf16x8 pack8(const f32x8& v) { return __builtin_bit_cast(bf16x8, __builtin_convertvector(v, bf16x8_t)); }
__device__ __forceinline__ f32x8 unpack8(const bf16x8& b) { f32x8 v;
#pragma unroll
    for (int j = 0; j < 8; ++j) v[j] = __uint_as_float(((unsigned)(unsigned short)b[j]) << 16);
    return v; }
__device__ __forceinline__ bf16x8 tr_frag(LAS unsigned char* a0  , int col0, int kb, int st) {
    LAS s16x4* p = (LAS s16x4*)(a0 + (32 * kb + 16 * st) * 256 + col0 * 2);
    const s16x4 lo = __builtin_amdgcn_ds_read_tr16_b64_v4i16(p), hi = __builtin_amdgcn_ds_read_tr16_b64_v4i16(p + 256);
    return __builtin_shufflevector(lo, hi, 0, 1, 2, 3, 4, 5, 6, 7);
}
__device__ __forceinline__ LAS unsigned char* tr_base(LAS unsigned char* img, int lane) {
    const int i16 = lane & 15, q = i16 >> 2, p = i16 & 3, cblk = (lane >> 4) & 1, h = lane >> 5;
    return img + (4 * h + q) * 256 + cblk * 32 + 8 * p;
}

__device__ __forceinline__ f32x16 mm2(const bf16x8& a0, const bf16x8& a1, const bf16x8& b0, const bf16x8& b1, f32x16 c) { c = DN_MFMA(a0, b0, c); c = DN_MFMA(a1, b1, c); return c; }
__device__ __forceinline__ void inv_diag(const f32x16& Y, const f32x16& Yt, int r, int h, f32x16& R, f32x16& Rt) {
    f32x16 Yd = Y, Ysub = {}, Ytd = Yt, Ytsub = {};
#pragma unroll
    for (int rr = 8; rr < 16; ++rr) { if (r < 16) { Ysub[rr] = Yd[rr]; Yd[rr] = 0.f; } }
#pragma unroll
    for (int rr = 0; rr < 8; ++rr) { if (r >= 16) { Ytsub[rr] = Ytd[rr]; Ytd[rr] = 0.f; } }
    f32x16 D = Yd, Dt = Ytd;
#pragma unroll
    for (int rr = 0; rr < 16; ++rr) { const float e = ((rr & 3) + 8 * (rr >> 2) + 4 * h == r) ? 1.f : 0.f; D[rr] += e; Dt[rr] += e; }
    bf16x8 Zp0 = pack_step<0>(Yd), Zp1 = pack_step<1>(Yd), Ztp0 = pack_step<0>(Ytd), Ztp1 = pack_step<1>(Ytd);
#pragma unroll 1
    for (int it = 0; it < 3; ++it) {
        const f32x16 zn = mm2(Ztp0, Ztp1, Zp0, Zp1, (f32x16){}), ztn = mm2(Zp0, Zp1, Ztp0, Ztp1, (f32x16){});
        Zp0 = pack_step<0>(zn); Zp1 = pack_step<1>(zn); Ztp0 = pack_step<0>(ztn); Ztp1 = pack_step<1>(ztn);
        const bf16x8 dp0 = pack_step<0>(D), dp1 = pack_step<1>(D), dtp0 = pack_step<0>(Dt), dtp1 = pack_step<1>(Dt);
        Dt = mm2(Zp0, Zp1, dtp0, dtp1, Dt); D = mm2(Ztp0, Ztp1, dp0, dp1, D);
        __builtin_amdgcn_sched_barrier(0);
    }
    const bf16x8 dp0 = pack_step<0>(D), dp1 = pack_step<1>(D), dtp0 = pack_step<0>(Dt), dtp1 = pack_step<1>(Dt);
    const f32x16 M1 = mm2(pack_step<0>(Ytsub), pack_step<1>(Ytsub), dp0, dp1, (f32x16){});
    const f32x16 M1t = mm2(pack_step<0>(Ysub), pack_step<1>(Ysub), dtp0, dtp1, (f32x16){});
    R = mm2(dtp0, dtp1, pack_step<0>(M1), pack_step<1>(M1), D);
    Rt = mm2(dp0, dp1, pack_step<0>(M1t), pack_step<1>(M1t), Dt);
}

__device__ __forceinline__ void prep_unit(int u, const bf16* DNC, const float* GG, const float* BETA, unsigned char* DNP, float* DU, float* EGL,
                                          LAS unsigned char* img, LAS float* tbl, int lane) {
    const int b = u >> 11, hv = (u >> 6) & 31, n = u & 63, hq = hv >> 1, m0 = b * T + n * 64, r = lane & 31, h = lane >> 5;
    const bf16* qbase = DNC + (size_t)m0 * DN_CONV + hq * 128; const bf16* kbase = qbase + 2048; const bf16* vbase = DNC + (size_t)m0 * DN_CONV + 4096 + hv * 128;
    unsigned char* outp = DNP + (size_t)u * UNIT_BYTES + lane * 16;
    float gc = GG[(size_t)(m0 + lane) * 32 + hv]; const float be = BETA[(size_t)(m0 + lane) * 32 + hv];
#pragma unroll
    for (int o = 1; o < 64; o <<= 1) { const float t = __shfl_up(gc, o); if (lane >= o) gc += t; }
    const float glast = __shfl(gc, 63);
    tbl[lane] = gc; tbl[64 + lane] = be;
    if (lane == 0) EGL[u] = __expf(glast);
    asm volatile("s_waitcnt lgkmcnt(0)" ::: "memory");
    const float gcol[2] = {tbl[r], tbl[32 + r]}, bcol[2] = {tbl[64 + r], tbl[96 + r]};
    bf16x8 kf[2][8];
#pragma unroll
    for (int i = 0; i < 2; ++i)
#pragma unroll
        for (int s = 0; s < 8; ++s) kf[i][s] = *(const bf16x8*)(kbase + (unsigned)((32 * i + r) * DN_CONV + 16 * s + 8 * h));
    {
        bf16x8 qf[2][8];
#pragma unroll
        for (int i = 0; i < 2; ++i)
#pragma unroll
            for (int s = 0; s < 8; ++s) qf[i][s] = *(const bf16x8*)(qbase + (unsigned)((32 * i + r) * DN_CONV + 16 * s + 8 * h));
#pragma unroll
        for (int t = 0; t < 3; ++t) { const int I = (t == 2) ? 1 : 0, J = (t == 0) ? 0 : 1;
            f32x16 acc = {};
#pragma unroll
            for (int s = 0; s < 8; ++s) acc = DN_MFMA(kf[I][s], qf[J][s], acc);
#pragma unroll
            for (int g4 = 0; g4 < 4; ++g4) { const f32x4 gs = *(const LAS f32x4*)(tbl + 32 * I + 8 * g4 + 4 * h);
#pragma unroll
                for (int j = 0; j < 4; ++j) { const int rr = 4 * g4 + j; const bool ok = (I != J) || (8 * g4 + 4 * h + j <= r);
                    acc[rr] = ok ? acc[rr] * __expf(gcol[J] - gs[j]) : 0.f; } }
            *(bf16x8*)(outp + (F_AT + t * 2 + 0) * 1024) = pack_step<0>(acc); *(bf16x8*)(outp + (F_AT + t * 2 + 1) * 1024) = pack_step<1>(acc); }
    }
    __builtin_amdgcn_sched_barrier(0);
    f32x16 Z[3], Zt[3], Rt[3];
    {
        f32x16 KK[2][2];
#pragma unroll
        for (int I = 0; I < 2; ++I)
#pragma unroll
            for (int J = 0; J < 2; ++J) { f32x16 acc = {};
#pragma unroll
                for (int s = 0; s < 8; ++s) acc = DN_MFMA(kf[I][s], kf[J][s], acc);
                KK[I][J] = acc; }
#pragma unroll
        for (int t = 0; t < 3; ++t) { const int I = (t == 2) ? 1 : 0, J = (t == 0) ? 0 : 1; f32x16 x;
#pragma unroll
            for (int g4 = 0; g4 < 4; ++g4) { const f32x4 gs = *(const LAS f32x4*)(tbl + 32 * I + 8 * g4 + 4 * h);
#pragma unroll
                for (int j = 0; j < 4; ++j) { const int rr = 4 * g4 + j; const bool ok = (I != J) || (8 * g4 + 4 * h + j < r);
                    x[rr] = ok ? -bcol[J] * KK[I][J][rr] * __expf(gcol[J] - gs[j]) : 0.f; } }
            Zt[t] = x; }
#pragma unroll
        for (int t = 0; t < 3; ++t) { const int I = (t == 0) ? 0 : 1, J = (t == 2) ? 1 : 0; f32x16 x;
#pragma unroll
            for (int g4 = 0; g4 < 4; ++g4) { const f32x4 gcr = *(const LAS f32x4*)(tbl + 32 * I + 8 * g4 + 4 * h), ber = *(const LAS f32x4*)(tbl + 64 + 32 * I + 8 * g4 + 4 * h);
#pragma unroll
                for (int j = 0; j < 4; ++j) { const int rr = 4 * g4 + j; const bool ok = (I != J) || (r < 8 * g4 + 4 * h + j);
                    x[rr] = ok ? -ber[j] * KK[I][J][rr] * __expf(gcr[j] - gcol[J]) : 0.f; } }
            Z[t] = x; }
    }
    __builtin_amdgcn_sched_barrier(0);
    {
        f32x16 R0, Rt0, R1, Rt1;
        inv_diag(Z[0], Zt[0], r, h, R0, Rt0);
        __builtin_amdgcn_sched_barrier(0);
        inv_diag(Z[2], Zt[2], r, h, R1, Rt1);
        __builtin_amdgcn_sched_barrier(0);
        const f32x16 Pm = mm2(pack_step<0>(Z[1]), pack_step<1>(Z[1]), pack_step<0>(Rt1), pack_step<1>(Rt1), (f32x16){});
        Rt[1] = mm2(pack_step<0>(R0), pack_step<1>(R0), pack_step<0>(Pm), pack_step<1>(Pm), (f32x16){});
        Rt[0] = Rt0; Rt[2] = Rt1;
    }
    __builtin_amdgcn_sched_barrier(0);
    bf16x8 Rp[3][2];
#pragma unroll
    for (int t = 0; t < 3; ++t) { Rp[t][0] = pack_step<0>(Rt[t]); Rp[t][1] = pack_step<1>(Rt[t]); }
    LAS unsigned char* a0 = tr_base(img, lane);
    __builtin_amdgcn_sched_barrier(0);
    { bf16x8 raw[16];
#pragma unroll
      for (int itr = 0; itr < 16; ++itr) { const int ci = itr * 64 + lane, row = ci >> 4, cch = ci & 15; raw[itr] = *(const bf16x8*)(kbase + (unsigned)(row * DN_CONV + cch * 8)); }
#pragma unroll
      for (int itr = 0; itr < 16; ++itr) { const int ci = itr * 64 + lane, row = ci >> 4, cch = ci & 15;
        *(LAS bf16x8*)(img + row * 256 + cch * 16) = pack8(unpack8(raw[itr]) * (tbl[64 + row] * __expf(tbl[row]))); } }
    asm volatile("s_waitcnt lgkmcnt(0)" ::: "memory");
#pragma unroll
    for (int kb = 0; kb < 4; ++kb)
#pragma unroll
        for (int cb = 0; cb < 2; ++cb) { f32x16 acc = {};
            if (cb == 0) { acc = DN_MFMA(tr_frag(a0, 32 * kb, 0, 0), Rp[0][0], acc); acc = DN_MFMA(tr_frag(a0, 32 * kb, 0, 1), Rp[0][1], acc); }
            else { acc = DN_MFMA(tr_frag(a0, 32 * kb, 0, 0), Rp[1][0], acc); acc = DN_MFMA(tr_frag(a0, 32 * kb, 0, 1), Rp[1][1], acc);
                   acc = DN_MFMA(tr_frag(a0, 32 * kb, 1, 0), Rp[2][0], acc); acc = DN_MFMA(tr_frag(a0, 32 * kb, 1, 1), Rp[2][1], acc); }
            acc = -acc;
            *(bf16x8*)(outp + (F_NW + (cb * 4 + kb) * 2 + 0) * 1024) = pack_step<0>(acc); *(bf16x8*)(outp + (F_NW + (cb * 4 + kb) * 2 + 1) * 1024) = pack_step<1>(acc); }
    asm volatile("s_waitcnt lgkmcnt(0)" ::: "memory");
    __builtin_amdgcn_sched_barrier(0);
    { bf16x8 raw[16];
#pragma unroll
      for (int itr = 0; itr < 16; ++itr) { const int ci = itr * 64 + lane, row = ci >> 4, cch = ci & 15; raw[itr] = *(const bf16x8*)(kbase + (unsigned)(row * DN_CONV + cch * 8)); }
#pragma unroll
      for (int itr = 0; itr < 16; ++itr) { const int ci = itr * 64 + lane, row = ci >> 4, cch = ci & 15;
        *(LAS bf16x8*)(img + row * 256 + cch * 16) = pack8(unpack8(raw[itr]) * (__expf(glast - tbl[row]))); } }
    asm volatile("s_waitcnt lgkmcnt(0)" ::: "memory");
    asm volatile("s_waitcnt lgkmcnt(0)" ::: "memory");
#pragma unroll
    for (int kb = 0; kb < 4; ++kb)
#pragma unroll
        for (int cb = 0; cb < 2; ++cb)
#pragma unroll
            for (int st = 0; st < 2; ++st) *(bf16x8*)(outp + (F_KGT + (kb * 2 + cb) * 2 + st) * 1024) = tr_frag(a0, 32 * kb, cb, st);
    asm volatile("s_waitcnt lgkmcnt(0)" ::: "memory");
    __builtin_amdgcn_sched_barrier(0);
    { bf16x8 vraw[16];
#pragma unroll
      for (int itr = 0; itr < 16; ++itr) { const int ci = itr * 64 + lane, row = ci >> 4, cch = ci & 15; vraw[itr] = *(const bf16x8*)(vbase + (unsigned)(row * DN_CONV + cch * 8)); }
#pragma unroll
      for (int itr = 0; itr < 16; ++itr) { const int ci = itr * 64 + lane, row = ci >> 4, cch = ci & 15;
        *(LAS bf16x8*)(img + row * 256 + cch * 16) = pack8(unpack8(vraw[itr]) * tbl[64 + row]); } }
    asm volatile("s_waitcnt lgkmcnt(0)" ::: "memory");
    float* dup = DU + (size_t)u * DU_UNIT + lane * 16;
#pragma unroll
    for (int dvb = 0; dvb < 4; ++dvb)
#pragma unroll
        for (int cb = 0; cb < 2; ++cb) { f32x16 acc = {};
            if (cb == 0) { acc = DN_MFMA(Rp[0][0], tr_frag(a0, 32 * dvb, 0, 0), acc); acc = DN_MFMA(Rp[0][1], tr_frag(a0, 32 * dvb, 0, 1), acc); }
            else { acc = DN_MFMA(Rp[1][0], tr_frag(a0, 32 * dvb, 0, 0), acc); acc = DN_MFMA(Rp[1][1], tr_frag(a0, 32 * dvb, 0, 1), acc);
                   acc = DN_MFMA(Rp[2][0], tr_frag(a0, 32 * dvb, 1, 0), acc); acc = DN_MFMA(Rp[2][1], tr_frag(a0, 32 * dvb, 1, 1), acc); }
            float* d = dup + (dvb * 2 + cb) * 1024;
#pragma unroll
            for (int g4 = 0; g4 < 4; ++g4) *(f32x4*)(d + 4 * g4) = (f32x4){acc[4 * g4], acc[4 * g4 + 1], acc[4 * g4 + 2], acc[4 * g4 + 3]}; }
    __builtin_amdgcn_sched_barrier(0);
#pragma unroll
    for (int cb = 0; cb < 2; ++cb) { const float eg = __expf(gcol[cb]); const bf16* qrow = qbase + (unsigned)((32 * cb + r) * DN_CONV + 4 * h);
        u32x2 lo[8], hi[8];
#pragma unroll
        for (int f = 0; f < 8; ++f) { lo[f] = *(const u32x2*)(qrow + 16 * f); hi[f] = *(const u32x2*)(qrow + 16 * f + 8); }
#pragma unroll
        for (int f = 0; f < 8; ++f) {
            const f32x8 v = {bf_lo(lo[f].x) * eg, bf_hi(lo[f].x) * eg, bf_lo(lo[f].y) * eg, bf_hi(lo[f].y) * eg, bf_lo(hi[f].x) * eg, bf_hi(hi[f].x) * eg, bf_lo(hi[f].y) * eg, bf_hi(hi[f].y) * eg};
            *(bf16x8*)(outp + (F_QG + cb * 8 + f) * 1024) = pack8(v); } }
    asm volatile("s_waitcnt lgkmcnt(0)" ::: "memory");
}
__device__ __forceinline__ void prep_phase(const Ctx& c, const bf16* DNC, const float* GG, const float* BETA, unsigned char* DNP, float* DU, float* EGL) {
    int lane = threadIdx.x & 63; asm volatile("" : "+v"(lane));
    LAS unsigned char* img = c.lds + c.wave * 16384; LAS float* tbl = (LAS float*)(c.lds + LDSCTL_OFF + 1024 + c.wave * 1024);
    for (int u = c.gw; u < NB * DN_VH * 64; u += c.NW) { int l2 = lane; asm volatile("" : "+v"(l2));
        prep_unit(u, DNC, GG, BETA, DNP, DU, EGL, img, tbl, l2); }
}

#define DN_BAR() do { asm volatile("s_waitcnt vmcnt(0) lgkmcnt(0)" ::: "memory"); __builtin_amdgcn_s_barrier(); asm volatile("" ::: "memory"); } while (0)
#define DN_BAR_L() do { asm volatile("s_waitcnt lgkmcnt(0)" ::: "memory"); __builtin_amdgcn_s_barrier(); asm volatile("" ::: "memory"); } while (0)
__device__ __forceinline__ void scan_head(int bh, LAS unsigned char* lds, const unsigned char* DNP, const float* DU, const float* EGL, const float* norm_w, const bf16* ZS, bf16* ODN) {
    int tid = threadIdx.x; asm volatile("" : "+v"(tid));
    const int lane = tid & 63, wave = __builtin_amdgcn_readfirstlane(tid >> 6), r = lane & 31, h = lane >> 5;
    LAS float* red = (LAS float*)(lds + 2 * UNIT_BYTES);
    LAS float* nwl = red + 512;
    const int b = bh >> 5, hv = bh & 31;
    const unsigned char* src = DNP + (size_t)bh * 64 * UNIT_BYTES;
    if (tid < 128) nwl[tid] = norm_w[tid];
    if (wave >= 4) {
        const int lt = tid - 256;
        const bool tailw = wave < 6;
        u32x4 ra[14], rb[14];
#define DN_LOADSET(R, chunk) do { const u32x4* s_ = (const u32x4*)(src + (size_t)(chunk) * UNIT_BYTES) + lt; \
            _Pragma("unroll") for (int i = 0; i < 13; ++i) R[i] = s_[i * 256]; if (tailw) R[13] = s_[13 * 256]; } while (0)
#define DN_STORESET(R, chunk) do { LAS u32x4* d_ = (LAS u32x4*)(lds + ((chunk) & 1) * UNIT_BYTES) + lt; \
            _Pragma("unroll") for (int i = 0; i < 13; ++i) d_[i * 256] = R[i]; if (tailw) d_[13 * 256] = R[13]; } while (0)
        DN_LOADSET(ra, 0); DN_LOADSET(rb, 1);
        for (int jc = 0; jc < 64; jc += 2) {
            DN_STORESET(ra, jc); if (jc + 2 < 64) DN_LOADSET(ra, jc + 2);
            DN_BAR_L();
            DN_STORESET(rb, jc + 1); if (jc + 3 < 64) DN_LOADSET(rb, jc + 3);
            DN_BAR_L();
        }
#undef DN_LOADSET
#undef DN_STORESET
        DN_BAR_L();
    } else {
        const int dvb = wave;
        f32x16 S[4] = {}, OT[2] = {}, UN[2];
        u32x2 zq[2][4] = {};
        const float* dup = DU + (size_t)bh * 64 * DU_UNIT + dvb * 2048 + lane * 16;
        const float eglv = EGL[bh * 64 + lane];
        const size_t orow0 = (size_t)b * T * 4096 + hv * 128 + 32 * dvb + 4 * h;
#pragma unroll
        for (int cb = 0; cb < 2; ++cb)
#pragma unroll
            for (int g4 = 0; g4 < 4; ++g4) { const f32x4 v = *(const f32x4*)(dup + cb * 1024 + 4 * g4); UN[cb][4 * g4] = v[0]; UN[cb][4 * g4 + 1] = v[1]; UN[cb][4 * g4 + 2] = v[2]; UN[cb][4 * g4 + 3] = v[3]; }
        for (int n = 0; n < 64; ++n) {
            DN_BAR_L();
            if (n > 0) {
                const LAS float* rp = red + ((n - 1) & 1) * 256;
#pragma unroll
                for (int cb = 0; cb < 2; ++cb) { const int cc = 32 * cb + r; const float ss = rp[cc] + rp[64 + cc] + rp[128 + cc] + rp[192 + cc];
                    const float rs = rsqrtf(ss * (1.0f / 128.0f) + EPS); bf16* op = ODN + orow0 + (size_t)((n - 1) * 64 + cc) * 4096;
#pragma unroll
                    for (int g4 = 0; g4 < 4; ++g4) { const u32x2 z = zq[cb][g4]; const f32x4 nw = *(const LAS f32x4*)(nwl + 32 * dvb + 8 * g4 + 4 * h);
                        u32x2 w; w.x = pk2(OT[cb][4 * g4] * rs * nw[0] * bf_lo(z.x), OT[cb][4 * g4 + 1] * rs * nw[1] * bf_hi(z.x));
                        w.y = pk2(OT[cb][4 * g4 + 2] * rs * nw[2] * bf_lo(z.y), OT[cb][4 * g4 + 3] * rs * nw[3] * bf_hi(z.y));
                        *(u32x2*)(op + 8 * g4) = w; } } }
            const float egl = __shfl(eglv, n);
            const LAS unsigned char* fb = lds + (n & 1) * UNIT_BYTES + lane * 16;
#define DN_F(idx) (*(const LAS bf16x8*)(fb + (idx) * 1024))
            bf16x8 Sp[4][2];
#pragma unroll
            for (int kb = 0; kb < 4; ++kb) { Sp[kb][0] = pack_step<0>(S[kb]); Sp[kb][1] = pack_step<1>(S[kb]); }
            f32x16 VN[2] = {UN[0], UN[1]};
#pragma unroll
            for (int cb = 0; cb < 2; ++cb)
#pragma unroll
                for (int kb = 0; kb < 4; ++kb) { VN[cb] = DN_MFMA(DN_F(F_NW + (cb * 4 + kb) * 2 + 0), Sp[kb][0], VN[cb]); VN[cb] = DN_MFMA(DN_F(F_NW + (cb * 4 + kb) * 2 + 1), Sp[kb][1], VN[cb]); }
            __builtin_amdgcn_sched_barrier(0);
            bf16x8 VNp[2][2];
#pragma unroll
            for (int cb = 0; cb < 2; ++cb) { VNp[cb][0] = pack_step<0>(VN[cb]); VNp[cb][1] = pack_step<1>(VN[cb]); }
            { const float* d = dup + (size_t)(n < 63 ? n + 1 : n) * DU_UNIT;
#pragma unroll
              for (int cb = 0; cb < 2; ++cb)
#pragma unroll
                for (int g4 = 0; g4 < 4; ++g4) { const f32x4 v = *(const f32x4*)(d + cb * 1024 + 4 * g4); UN[cb][4 * g4] = v[0]; UN[cb][4 * g4 + 1] = v[1]; UN[cb][4 * g4 + 2] = v[2]; UN[cb][4 * g4 + 3] = v[3]; } }
            __builtin_amdgcn_sched_barrier(0);
#pragma unroll
            for (int cb = 0; cb < 2; ++cb) { f32x16 acc = {};
#pragma unroll
                for (int kb = 0; kb < 4; ++kb) { acc = DN_MFMA(Sp[kb][0], DN_F(F_QG + (cb * 4 + kb) * 2 + 0), acc); acc = DN_MFMA(Sp[kb][1], DN_F(F_QG + (cb * 4 + kb) * 2 + 1), acc); }
                if (cb == 0) { acc = DN_MFMA(VNp[0][0], DN_F(F_AT + 0), acc); acc = DN_MFMA(VNp[0][1], DN_F(F_AT + 1), acc); }
                else { acc = DN_MFMA(VNp[0][0], DN_F(F_AT + 2), acc); acc = DN_MFMA(VNp[0][1], DN_F(F_AT + 3), acc); acc = DN_MFMA(VNp[1][0], DN_F(F_AT + 4), acc); acc = DN_MFMA(VNp[1][1], DN_F(F_AT + 5), acc); }
                OT[cb] = acc; }
            __builtin_amdgcn_sched_barrier(0);
#pragma unroll
            for (int cb = 0; cb < 2; ++cb)
#pragma unroll
                for (int g4 = 0; g4 < 4; ++g4) zq[cb][g4] = *(const u32x2*)(ZS + orow0 + (size_t)(n * 64 + 32 * cb + r) * 4096 + 8 * g4);
#pragma unroll
            for (int kb = 0; kb < 4; ++kb) { f32x16 acc = S[kb] * egl;
#pragma unroll
                for (int cb = 0; cb < 2; ++cb) { acc = DN_MFMA(DN_F(F_KGT + (kb * 2 + cb) * 2 + 0), VNp[cb][0], acc); acc = DN_MFMA(DN_F(F_KGT + (kb * 2 + cb) * 2 + 1), VNp[cb][1], acc); }
                S[kb] = acc; }
#undef DN_F
            __builtin_amdgcn_sched_barrier(0);
            LAS float* wp = red + (n & 1) * 256 + dvb * 64;
#pragma unroll
            for (int cb = 0; cb < 2; ++cb) { float ss = 0.f;
#pragma unroll
                for (int rr = 0; rr < 16; ++rr) ss += OT[cb][rr] * OT[cb][rr];
                ss += __shfl_xor(ss, 32);
                if (h == 0) wp[32 * cb + r] = ss; }
        }
        DN_BAR_L();
        {   const LAS float* rp = red + 256;
#pragma unroll
            for (int cb = 0; cb < 2; ++cb) { const int cc = 32 * cb + r; const float ss = rp[cc] + rp[64 + cc] + rp[128 + cc] + rp[192 + cc];
                const float rs = rsqrtf(ss * (1.0f / 128.0f) + EPS); bf16* op = ODN + orow0 + (size_t)(63 * 64 + cc) * 4096;
#pragma unroll
                for (int g4 = 0; g4 < 4; ++g4) { const u32x2 z = zq[cb][g4]; const f32x4 nw = *(const LAS f32x4*)(nwl + 32 * dvb + 8 * g4 + 4 * h);
                    u32x2 w; w.x = pk2(OT[cb][4 * g4] * rs * nw[0] * bf_lo(z.x), OT[cb][4 * g4 + 1] * rs * nw[1] * bf_hi(z.x));
                    w.y = pk2(OT[cb][4 * g4 + 2] * rs * nw[2] * bf_lo(z.y), OT[cb][4 * g4 + 3] * rs * nw[3] * bf_hi(z.y));
                    *(u32x2*)(op + 8 * g4) = w; } } }
    }
}
#undef DN_BAR
#undef DN_BAR_L
}

constexpr size_t al256(size_t x) { return (x + 255) & ~(size_t)255; }
constexpr size_t WS_CTL = 0, CTL_ZERO_BYTES = 1u << 20;
constexpr int CW_BAR = 4096, CW_FOXQ = 8192;
constexpr size_t WS_WIN = CTL_ZERO_BYTES;
constexpr size_t WS_WBRDN = WS_WIN + al256((size_t)DEPTH * NBIG * D * 2);
constexpr size_t WS_WBRFOX = WS_WBRDN + al256((size_t)DEPTH * D * 4096 * 2);
constexpr size_t WS_WOUT = WS_WBRFOX + al256((size_t)DEPTH * D * D * 2);
constexpr size_t WS_WGU = WS_WOUT + al256((size_t)DEPTH * D * D * 2);
constexpr size_t WS_WDOWN = WS_WGU + al256((size_t)DEPTH * 2 * FF * D * 2);
constexpr size_t WS_WSM = WS_WDOWN + al256((size_t)DEPTH * D * FF * 2);
constexpr size_t WS_MOD = WS_WSM + al256((size_t)DEPTH * 96 * D * 2);
constexpr size_t WS_H = WS_MOD + al256((size_t)DEPTH * 2 * 6 * D * 4);
constexpr size_t WS_DNRAW = WS_H + al256((size_t)M * D * 2);
constexpr size_t WS_DNC = WS_DNRAW + al256((size_t)M * 8192 * 2);
constexpr size_t WS_ZS = WS_DNC + al256((size_t)M * 8192 * 2);
constexpr size_t WS_FQKV = WS_ZS + al256((size_t)M * 4096 * 2);
constexpr size_t WS_MG = WS_FQKV + al256((size_t)M * 6144 * 2);
constexpr size_t WS_BAF = WS_MG + al256((size_t)M * 4096 * 2);
constexpr size_t WS_BETA = WS_BAF + al256((size_t)M * NSM * 4);
constexpr size_t WS_GG = WS_BETA + al256((size_t)M * 32 * 4);
constexpr size_t WS_LOGF = WS_GG + al256((size_t)M * 32 * 4);
constexpr size_t WS_FC = WS_LOGF + al256((size_t)M * 16 * 4);
constexpr size_t WS_ODNRAW = WS_FC + al256((size_t)M * 16 * 4);
constexpr size_t WS_ODN = WS_ODNRAW + al256((size_t)M * 4096 * 4);
constexpr size_t WS_OFOX = WS_ODN + al256((size_t)M * 4096 * 2);
constexpr size_t WS_YDN = WS_OFOX + al256((size_t)M * 2048 * 2);
constexpr size_t WS_MM = WS_YDN + al256((size_t)M * D * 4);
constexpr size_t WS_Y = WS_MM + al256((size_t)M * D * 2);
constexpr size_t WS_HID = WS_Y + al256((size_t)M * D * 4);
constexpr size_t WS_DNP = WS_HID + al256((size_t)M * FF * 2);
constexpr size_t WS_EGL = WS_DNP + al256((size_t)NB * DN_VH * 64 * dn::UNIT_BYTES);
constexpr size_t WS_END = WS_EGL + al256((size_t)NB * DN_VH * 64 * 4);
constexpr size_t WS_DU = WS_ODNRAW;

struct Params { const float* in[17]; float* out; unsigned char* ws; };

__global__ void __launch_bounds__(512, 2) mega_fwd(Params p) {
    extern __shared__ __attribute__((aligned(16))) unsigned char lds_raw[];
    Ctx c; c.lds = (LAS unsigned char*)lds_raw; c.wave = __builtin_amdgcn_readfirstlane((int)threadIdx.x >> 6);
    c.G = gridDim.x; c.gw = blockIdx.x * 8 + c.wave; c.NW = c.G * 8;
    for (int u = threadIdx.x; u < (LDS_BYTES - LDSCTL_OFF) / 4; u += 512) ((LAS unsigned*)(c.lds + LDSCTL_OFF))[u] = 0u;
    __syncthreads();
    typedef __attribute__((address_space(4))) const Params* KParams;
    const KParams kp0 = (KParams)__builtin_amdgcn_kernarg_segment_ptr();
    unsigned char* ws = p.ws;
    XcdBarrier bar = xcd_barrier_post((unsigned*)(ws + WS_CTL) + CW_BAR, (volatile LAS unsigned*)(c.lds + MISC_OFF) + 8);
#define GRID_BAR() do { XcdBarrier b2_ = bar; asm volatile("" : "+s"(b2_.x), "+s"(b2_.bar)); xcd_barrier(b2_); } while (0)
#define PH_BEGIN KParams kp = kp0; asm volatile("" : "+s"(kp)); unsigned char* wsl = kp->ws; Ctx cl = c; asm volatile("" : "+s"(cl.G), "+s"(cl.gw), "+s"(cl.NW));
#define WSP(type, off) ((type*)(wsl + (off)))

    for (int l = 0; l < DEPTH; ++l) { PH_BEGIN
        ph_transpose(cl, kp->in[5] + (size_t)l * D * NIN, D, NIN, NBIG, WSP(bf16, WS_WIN) + (size_t)l * NBIG * D, 1);
        ph_transpose(cl, kp->in[11] + (size_t)l * 4096 * D, 4096, D, D, WSP(bf16, WS_WBRDN) + (size_t)l * D * 4096, 0);
        ph_transpose(cl, kp->in[12] + (size_t)l * D * D, D, D, D, WSP(bf16, WS_WBRFOX) + (size_t)l * D * D, 0);
        ph_transpose(cl, kp->in[13] + (size_t)l * D * D, D, D, D, WSP(bf16, WS_WOUT) + (size_t)l * D * D, 0);
        ph_transpose(cl, kp->in[14] + (size_t)l * D * FF, D, FF, FF, WSP(bf16, WS_WGU) + (size_t)l * 2 * FF * D, 2);
        ph_transpose(cl, kp->in[15] + (size_t)l * D * FF, D, FF, FF, WSP(bf16, WS_WGU) + (size_t)l * 2 * FF * D, 3);
        ph_transpose(cl, kp->in[16] + (size_t)l * FF * D, FF, D, D, WSP(bf16, WS_WDOWN) + (size_t)l * D * FF, 0);
    }
    { PH_BEGIN ph_wsmall(cl, kp->in[5], WSP(bf16, WS_WSM)); }
    __syncthreads();
    { PH_BEGIN ph_adaln(cl, kp->in[1], kp->in[2], kp->in[3], WSP(float, WS_MOD)); }
    GRID_BAR();
    { PH_BEGIN RowArgs a{}; a.xin = kp->in[0]; a.x = kp->out; a.gn = kp->in[4]; a.scale = WSP(float, WS_MOD) + 1 * D; a.shift = WSP(float, WS_MOD); a.H = WSP(bf16, WS_H);
      a.has_y = 0; a.has_h = 1; ph_rowpass(cl, a); }
    GRID_BAR();

    for (int l = 0; l < DEPTH; ++l) {
        { PH_BEGIN ph_smallproj(cl, WSP(bf16, WS_H), WSP(bf16, WS_WSM) + (size_t)l * 96 * D, WSP(float, WS_BAF)); }
        __syncthreads();
        { PH_BEGIN pg8::Gemm g{WSP(bf16, WS_H), WSP(bf16, WS_WIN) + (size_t)l * NBIG * D, M, NBIG, D, 0}; pg8::StaticOrder S; S.init(M, NBIG, cl.G, (int)blockIdx.x);
          pg8::EpiInProj E{WSP(bf16, WS_DNRAW), WSP(bf16, WS_ZS), WSP(bf16, WS_FQKV), WSP(bf16, WS_MG)};
          pg8::gemm_phase<pg8::EpiInProj, pg8::StaticOrder, true, true>(cl.lds, g, S, E); }
        GRID_BAR();
        { PH_BEGIN ph_conv(cl, WSP(bf16, WS_DNRAW), kp->in[6] + (size_t)l * 8192 * 4, WSP(bf16, WS_DNC)); }
        { PH_BEGIN ph_gates(cl, WSP(float, WS_BAF), kp->in[7] + l * 32, kp->in[8] + l * 32, kp->in[10] + l * 16, WSP(float, WS_BETA), WSP(float, WS_GG), WSP(float, WS_LOGF)); }
        GRID_BAR();
        { PH_BEGIN ph_fcum(cl, WSP(float, WS_LOGF), WSP(float, WS_FC)); }
        { PH_BEGIN dn::prep_phase(cl, WSP(bf16, WS_DNC), WSP(float, WS_GG), WSP(float, WS_BETA), WSP(unsigned char, WS_DNP), WSP(float, WS_DU), WSP(float, WS_EGL)); }
        GRID_BAR();
        { PH_BEGIN for (int bh = blockIdx.x; bh < NB * DN_VH; bh += cl.G) { __syncthreads();
            dn::scan_head(bh, cl.lds, WSP(unsigned char, WS_DNP), WSP(float, WS_DU), WSP(float, WS_EGL), kp->in[9] + l * 128, WSP(bf16, WS_ZS), WSP(bf16, WS_ODN)); } }
        { PH_BEGIN fox::fox_phase((char*)lds_raw, (unsigned*)(wsl + WS_CTL) + CW_FOXQ + l * 512, (int)(xb_xcc_id() & 7u), WSP(bf16, WS_FQKV), WSP(bf16, WS_OFOX), WSP(float, WS_FC)); }
        GRID_BAR();
        { PH_BEGIN pg8::Gemm g{WSP(bf16, WS_ODN), WSP(bf16, WS_WBRDN) + (size_t)l * D * 4096, M, D, 4096, 0}; pg8::StaticOrder S; S.init(M, D, cl.G, (int)blockIdx.x); pg8::EpiBf16P E{WSP(bf16, WS_YDN), D, 0};
          pg8::gemm_phase<pg8::EpiBf16P, pg8::StaticOrder, true, true>(cl.lds, g, S, E); }
        __syncthreads();
        { PH_BEGIN pg8::Gemm g{WSP(bf16, WS_OFOX), WSP(bf16, WS_WBRFOX) + (size_t)l * D * D, M, D, D, 0}; pg8::StaticOrder S; S.init(M, D, cl.G, (int)blockIdx.x); pg8::EpiMerge E{WSP(bf16, WS_YDN), WSP(bf16, WS_MG), WSP(bf16, WS_MM)};
          pg8::gemm_phase<pg8::EpiMerge, pg8::StaticOrder, true, true>(cl.lds, g, S, E); }
        GRID_BAR();
        { PH_BEGIN pg8::Gemm g{WSP(bf16, WS_MM), WSP(bf16, WS_WOUT) + (size_t)l * D * D, M, D, D, 0}; pg8::StaticOrder S; S.init(M, D, cl.G, (int)blockIdx.x); pg8::EpiBf16P E{WSP(bf16, WS_Y), D, 0};
          pg8::gemm_phase<pg8::EpiBf16P, pg8::StaticOrder, true, true>(cl.lds, g, S, E); }
        GRID_BAR();
        { PH_BEGIN const float* mod = WSP(float, WS_MOD) + (size_t)l * 2 * 6 * D; const float* gl = kp->in[4] + (size_t)l * 4 * D;
          RowArgs a{}; a.xin = kp->out; a.x = kp->out; a.Y = WSP(bf16, WS_Y); a.gy = gl + 1 * D; a.gate = mod + 2 * D; a.gn = gl + 2 * D; a.scale = mod + 4 * D; a.shift = mod + 3 * D; a.H = WSP(bf16, WS_H); a.has_y = 1; a.has_h = 1;
          ph_rowpass(cl, a); }
        GRID_BAR();
        { PH_BEGIN pg8::Gemm g{WSP(bf16, WS_H), WSP(bf16, WS_WGU) + (size_t)l * 2 * FF * D, M, 2 * FF, D, 0}; pg8::StaticOrder S; S.init(M, 2 * FF, cl.G, (int)blockIdx.x); pg8::EpiSwiGLU E{WSP(bf16, WS_HID), FF, 0};
          pg8::gemm_phase<pg8::EpiSwiGLU, pg8::StaticOrder, true, true>(cl.lds, g, S, E); }
        GRID_BAR();
        { PH_BEGIN pg8::Gemm g{WSP(bf16, WS_HID), WSP(bf16, WS_WDOWN) + (size_t)l * D * FF, M, D, FF, 0}; pg8::StaticOrder S; S.init(M, D, cl.G, (int)blockIdx.x); pg8::EpiBf16P E{WSP(bf16, WS_Y), D, 0};
          pg8::gemm_phase<pg8::EpiBf16P, pg8::StaticOrder, true, true>(cl.lds, g, S, E); }
        GRID_BAR();
        { PH_BEGIN const float* mod = WSP(float, WS_MOD) + (size_t)l * 2 * 6 * D; const float* gl = kp->in[4] + (size_t)l * 4 * D;
          RowArgs a{}; a.xin = kp->out; a.x = kp->out; a.Y = WSP(bf16, WS_Y); a.gy = gl + 3 * D; a.gate = mod + 5 * D; a.has_y = 1;
          if (l + 1 < DEPTH) { const float* mod2 = mod + 2 * 6 * D; const float* gl2 = gl + 4 * D;
              a.gn = gl2; a.scale = mod2 + 1 * D; a.shift = mod2; a.H = WSP(bf16, WS_H); a.has_h = 1; }
          ph_rowpass(cl, a); }
        if (l + 1 < DEPTH) GRID_BAR();
    }
#undef PH_BEGIN
#undef WSP
#undef GRID_BAR
}

extern "C" void kernel_launch(void* const* d_in, const int* in_sizes, int n_in, void* d_out, int out_size, void* d_ws, size_t ws_size, hipStream_t stream) {
    static int grid = 0;
    if (grid == 0) {
        if (n_in != 17 || out_size != M * D || ws_size < WS_END) { fprintf(stderr, "kernel_launch: bad shapes / workspace (need %zu, have %zu)\n", (size_t)WS_END, ws_size); grid = -1; return; }
        int dev = 0, cus = 0, per_cu = 0;
        if (hipGetDevice(&dev) != hipSuccess || hipDeviceGetAttribute(&cus, hipDeviceAttributeMultiprocessorCount, dev) != hipSuccess) { grid = -1; return; }
        if (hipFuncSetAttribute((const void*)mega_fwd, hipFuncAttributeMaxDynamicSharedMemorySize, LDS_BYTES) != hipSuccess) { fprintf(stderr, "kernel_launch: hipFuncSetAttribute failed\n"); grid = -1; return; }
        if (hipOccupancyMaxActiveBlocksPerMultiprocessor(&per_cu, (const void*)mega_fwd, 512, LDS_BYTES) != hipSuccess || per_cu < 1) { fprintf(stderr, "kernel_launch: occupancy query reports %d workgroups per CU\n", per_cu); }
        (void)hipGetLastError();
        grid = cus;
    }
    if (grid < 0) return;
    if (hipMemsetAsync((char*)d_ws + WS_CTL, 0, CTL_ZERO_BYTES, stream) != hipSuccess) return;
    Params p{};
    for (int i = 0; i < 17; ++i) p.in[i] = (const float*)d_in[i];
    p.out = (float*)d_out; p.ws = (unsigned char*)d_ws;
    hipLaunchKernelGGL(mega_fwd, dim3(grid), dim3(512), LDS_BYTES, stream, p);
}
```
